# Optimizing an MI355X kernel written in HIP

```python
import math
import jax, jax.numpy as jnp
from jax import lax
import numpy as np

D_MODEL = 4096
BATCH = 16
SEQ = 256
DEPTH = 1
DEC_BATCH = 8
DEC_SEQ = 1024
PAST_LEN = 512

GRID_W = 64
HEAD_DIM = 128
N_HEADS_A = 16
N_KV_A = 4
G_A = N_HEADS_A // N_KV_A
N_HEADS_B = 16
N_KV_B = 4
G_B = N_HEADS_B // N_KV_B
DIFF_DIM = HEAD_DIM // 2
WINDOW = 128
BLOCK = 128
D_FF = 4 * D_MODEL
ROPE_BASE = 10000.0
EPS = 1e-6
NEG = -1e30
WIDTH_A = N_HEADS_A * HEAD_DIM
WIDTH_B = N_HEADS_B * HEAD_DIM
IN_SPLITS = [WIDTH_A, N_KV_A * HEAD_DIM, N_KV_A * HEAD_DIM,
             WIDTH_B, N_KV_B * HEAD_DIM, N_KV_B * HEAD_DIM]
D_IN = sum(IN_SPLITS)

kernel_name = "hybrid_swa_sink_diffattn_dit_step"


def rms_norm(x, g):
    xf = x.astype(jnp.float32)
    y = xf * lax.rsqrt(jnp.mean(xf * xf, axis=-1, keepdims=True) + EPS)
    return (y * g.astype(jnp.float32)).astype(x.dtype)


def modulation(cvec, p, l):
    m = jax.nn.silu(cvec) @ p["w_mod"][l] + p["b_mod"][l]
    return jnp.split(m, 6, axis=-1)


def axial_angles(T, dim):
    rows = T // GRID_W
    row = jnp.repeat(jnp.arange(rows), GRID_W).astype(jnp.float32)
    col = jnp.tile(jnp.arange(GRID_W), rows).astype(jnp.float32)
    n = dim // 4
    freq = ROPE_BASE ** (-jnp.arange(n, dtype=jnp.float32) / n)
    return jnp.concatenate([row[:, None] * freq, col[:, None] * freq], axis=-1)


def rope_axial(x, ang):
    dim = x.shape[-1]
    n = dim // 4
    T = x.shape[1]
    xr = x.astype(jnp.float32).reshape(*x.shape[:-1], 2, 2, n)
    x1, x2 = xr[..., 0, :], xr[..., 1, :]
    a = ang.reshape((1, T) + (1,) * (x.ndim - 3) + (2, n))
    cos, sin = jnp.cos(a), jnp.sin(a)
    out = jnp.stack([x1 * cos - x2 * sin, x2 * cos + x1 * sin], axis=-2)
    return out.reshape(x.shape).astype(x.dtype)


def to_blocks(x):
    B, T = x.shape[:2]
    return jnp.moveaxis(x.reshape(B, T // BLOCK, BLOCK, *x.shape[2:]), 1, 0)


def from_blocks(y):
    nb, B, Q = y.shape[:3]
    return jnp.moveaxis(y, 0, 1).reshape(B, nb * Q, -1)


def project(h, p, l):
    B, T = h.shape[:2]
    P = h @ p["w_in"][l]
    q_a, k_a, v_a, q_b, k_b, v_b = jnp.split(P, np.cumsum(IN_SPLITS)[:-1].tolist(), axis=-1)
    q_a = rms_norm(q_a.reshape(B, T, N_KV_A, G_A, HEAD_DIM), p["qnorm_a_g"][l])
    k_a = rms_norm(k_a.reshape(B, T, N_KV_A, HEAD_DIM), p["knorm_a_g"][l])
    v_a = v_a.reshape(B, T, N_KV_A, HEAD_DIM)
    q_b = rms_norm(q_b.reshape(B, T, N_KV_B, G_B, 2, DIFF_DIM), p["qnorm_b_g"][l])
    k_b = rms_norm(k_b.reshape(B, T, N_KV_B, 2, DIFF_DIM), p["knorm_b_g"][l])
    v_b = v_b.reshape(B, T, N_KV_B, HEAD_DIM)
    return q_a, k_a, v_a, q_b, k_b, v_b


def gqa_sink_block(qb, k, v, mask, sink):
    s = jnp.einsum("bqkgd,bskd->bkgqs", qb, k,
                   preferred_element_type=jnp.float32) * (HEAD_DIM ** -0.5)
    if mask is not None:
        s = jnp.where(mask, s, NEG)
    sink_col = jnp.broadcast_to(sink.astype(jnp.float32)[None, :, :, None, None],
                                s.shape[:-1] + (1,))
    pr = jax.nn.softmax(jnp.concatenate([s, sink_col], axis=-1), axis=-1)[..., :-1]
    return jnp.einsum("bkgqs,bskd->bqkgd", pr.astype(v.dtype), v)


def diff_block(qb, k, v, lam, g, out_scale):
    s = jnp.einsum("bqkgcd,bskcd->bkgcqs", qb, k,
                   preferred_element_type=jnp.float32) * (DIFF_DIM ** -0.5)
    pr = jax.nn.softmax(s, axis=-1)
    a = pr[:, :, :, 0] - lam * pr[:, :, :, 1]
    o = jnp.einsum("bkgqs,bskd->bqkgd", a.astype(v.dtype), v)
    return rms_norm(o, g) * out_scale


def diff_lambda(p, l):
    lam_init = 0.8 - 0.6 * math.exp(-0.3 * l)
    lq1 = p["lam_q1"][l].astype(jnp.float32); lk1 = p["lam_k1"][l].astype(jnp.float32)
    lq2 = p["lam_q2"][l].astype(jnp.float32); lk2 = p["lam_k2"][l].astype(jnp.float32)
    lam = jnp.exp(jnp.sum(lq1 * lk1)) - jnp.exp(jnp.sum(lq2 * lk2)) + lam_init
    return lam, 1.0 - lam_init


def layer(x, cvec, p, l, ctx_kv):
    B, T = x.shape[:2]
    sh1, sc1, gt1, sh2, sc2, gt2 = modulation(cvec, p, l)
    h = rms_norm(x, p["norm1_g"][l]) * (1.0 + sc1) + sh1
    q_a, k_a, v_a, q_b, k_b, v_b = project(h, p, l)
    sink = p["sink_a"][l].reshape(N_KV_A, G_A)
    lam, out_scale = diff_lambda(p, l)
    sub_g = p["subln_g"][l]
    if ctx_kv is None:
        new_kv = (k_a, v_a, k_b, v_b)
        o_a = lax.map(lambda qb: gqa_sink_block(qb, k_a, v_a, None, sink), to_blocks(q_a))
        o_b = lax.map(lambda qb: diff_block(qb, k_b, v_b, lam, sub_g, out_scale), to_blocks(q_b))
    else:
        new_kv = None
        ck_a, cv_a, ck_b, cv_b = ctx_kv
        L = ck_a.shape[1]
        ang_a = axial_angles(T, HEAD_DIM)
        ang_b = axial_angles(T, DIFF_DIM)
        q_a = rope_axial(q_a, ang_a); k_a = rope_axial(k_a, ang_a)
        q_b = rope_axial(q_b, ang_b); k_b = rope_axial(k_b, ang_b)
        nb = T // BLOCK

        def windows(t):
            tp = jnp.pad(t, [(0, 0), (BLOCK, BLOCK)] + [(0, 0)] * (t.ndim - 2))
            tp = tp.reshape(B, nb + 2, BLOCK, *t.shape[2:])
            w = jnp.concatenate([tp[:, :-2], tp[:, 1:-1], tp[:, 2:]], axis=2)
            return jnp.moveaxis(w, 1, 0)

        qpos = jnp.arange(nb)[:, None, None] * BLOCK + jnp.arange(BLOCK)[None, :, None]
        kpos = (jnp.arange(nb)[:, None, None] - 1) * BLOCK + jnp.arange(3 * BLOCK)[None, None, :]
        mask = (jnp.abs(kpos - qpos) <= WINDOW) & (kpos >= 0) & (kpos < T)
        ctx_mask = jnp.ones((BLOCK, L), dtype=bool)

        def a_fn(args):
            qb, kw, vw, mw = args
            kk = jnp.concatenate([kw, ck_a], axis=1)
            vv = jnp.concatenate([vw, cv_a], axis=1)
            mm = jnp.concatenate([mw, ctx_mask], axis=1)
            return gqa_sink_block(qb, kk, vv, mm, sink)

        o_a = lax.map(a_fn, (to_blocks(q_a), windows(k_a), windows(v_a), mask))
        k_all = jnp.concatenate([k_b, ck_b], axis=1)
        v_all = jnp.concatenate([v_b, cv_b], axis=1)
        o_b = lax.map(lambda qb: diff_block(qb, k_all, v_all, lam, sub_g, out_scale), to_blocks(q_b))
    o = jnp.concatenate([from_blocks(o_a), from_blocks(o_b)], axis=-1) @ p["w_out"][l]
    x = x + gt1 * o
    h2 = rms_norm(x, p["norm2_g"][l]) * (1.0 + sc2) + sh2
    f = jnp.square(jax.nn.relu(h2 @ p["w_fc1"][l])) @ p["w_fc2"][l]
    x = x + gt2 * f
    return x, new_kv


def setup_inputs(seed: int = 0) -> dict:
    key = jax.random.key(seed)
    ks = jax.random.split(key, 32)
    f32 = jnp.float32

    def nrm(k, shape, scale=1.0):
        return jax.random.normal(k, shape, f32) * scale

    return {
        "x_prompt": nrm(ks[0], (BATCH, SEQ, D_MODEL)),
        "x_sample": nrm(ks[1], (DEC_BATCH, DEC_SEQ, D_MODEL)),
        "cache_a_k": nrm(ks[2], (DEC_BATCH, DEPTH, PAST_LEN, N_KV_A, HEAD_DIM)),
        "cache_a_v": nrm(ks[3], (DEC_BATCH, DEPTH, PAST_LEN, N_KV_A, HEAD_DIM)),
        "cache_b_k": nrm(ks[4], (DEC_BATCH, DEPTH, PAST_LEN, N_KV_B, 2, DIFF_DIM)),
        "cache_b_v": nrm(ks[5], (DEC_BATCH, DEPTH, PAST_LEN, N_KV_B, HEAD_DIM)),
        "c": nrm(ks[6], (DEC_BATCH, D_MODEL)),
        "c_ctx": nrm(ks[7], (D_MODEL,)),
        "w_mod": nrm(ks[8], (DEPTH, D_MODEL, 6 * D_MODEL), D_MODEL ** -0.5),
        "b_mod": nrm(ks[9], (DEPTH, 6 * D_MODEL), 0.02),
        "norm1_g": 1.0 + nrm(ks[10], (DEPTH, D_MODEL), 0.02),
        "w_in": nrm(ks[11], (DEPTH, D_MODEL, D_IN), D_MODEL ** -0.5),
        "qnorm_a_g": 1.0 + nrm(ks[12], (DEPTH, HEAD_DIM), 0.02),
        "knorm_a_g": 1.0 + nrm(ks[13], (DEPTH, HEAD_DIM), 0.02),
        "qnorm_b_g": 1.0 + nrm(ks[14], (DEPTH, DIFF_DIM), 0.02),
        "knorm_b_g": 1.0 + nrm(ks[15], (DEPTH, DIFF_DIM), 0.02),
        "sink_a": nrm(ks[16], (DEPTH, N_HEADS_A), 0.5),
        "lam_q1": nrm(ks[17], (DEPTH, DIFF_DIM), 0.1),
        "lam_k1": nrm(ks[18], (DEPTH, DIFF_DIM), 0.1),
        "lam_q2": nrm(ks[19], (DEPTH, DIFF_DIM), 0.1),
        "lam_k2": nrm(ks[20], (DEPTH, DIFF_DIM), 0.1),
        "subln_g": 1.0 + nrm(ks[21], (DEPTH, HEAD_DIM), 0.02),
        "w_out": nrm(ks[22], (DEPTH, D_MODEL, D_MODEL), D_MODEL ** -0.5),
        "norm2_g": 1.0 + nrm(ks[23], (DEPTH, D_MODEL), 0.02),
        "w_fc1": nrm(ks[24], (DEPTH, D_MODEL, D_FF), D_MODEL ** -0.5),
        "w_fc2": nrm(ks[25], (DEPTH, D_FF, D_MODEL), D_FF ** -0.5),
    }


def reference(x_prompt, x_sample, cache_a_k, cache_a_v, cache_b_k, cache_b_v, c, c_ctx,
              w_mod, b_mod, norm1_g, w_in, qnorm_a_g, knorm_a_g, qnorm_b_g, knorm_b_g,
              sink_a, lam_q1, lam_k1, lam_q2, lam_k2, subln_g, w_out, norm2_g, w_fc1, w_fc2):
    p = dict(w_mod=w_mod, b_mod=b_mod, norm1_g=norm1_g, w_in=w_in,
             qnorm_a_g=qnorm_a_g, knorm_a_g=knorm_a_g, qnorm_b_g=qnorm_b_g, knorm_b_g=knorm_b_g,
             sink_a=sink_a, lam_q1=lam_q1, lam_k1=lam_k1, lam_q2=lam_q2, lam_k2=lam_k2,
             subln_g=subln_g, w_out=w_out, norm2_g=norm2_g, w_fc1=w_fc1, w_fc2=w_fc2)
    xp = x_prompt
    cvec_ctx = c_ctx[None, None, :]
    ka_l, va_l, kb_l, vb_l = [], [], [], []
    for l in range(DEPTH):
        xp, (ka, va, kb, vb) = layer(xp, cvec_ctx, p, l, None)
        ka_l.append(ka); va_l.append(va); kb_l.append(kb); vb_l.append(vb)
    new_a_k = jnp.stack(ka_l, axis=1)
    new_a_v = jnp.stack(va_l, axis=1)
    new_b_k = jnp.stack(kb_l, axis=1)
    new_b_v = jnp.stack(vb_l, axis=1)
    xs = x_sample
    cvec = c[:, None, :]
    for l in range(DEPTH):
        ctx_kv = (cache_a_k[:, l], cache_a_v[:, l], cache_b_k[:, l], cache_b_v[:, l])
        xs, _ = layer(xs, cvec, p, l, ctx_kv)
    return (xp, xs, new_a_k, new_a_v, new_b_k, new_b_v)
```

```cpp
#include <hip/hip_runtime.h>
#include <cstdio>
#include <cstdint>
namespace pg8 {
#define PG8_LAS __attribute__((address_space(3)))
typedef unsigned short bf16_t;
typedef short bf16x8 __attribute__((ext_vector_type(8)));
typedef float f32x4 __attribute__((ext_vector_type(4)));
typedef unsigned u32x4 __attribute__((ext_vector_type(4)));
constexpr int BM = 256, BK = 64, HALF = 128, HTB = HALF * BK * 2  , STAGE_BYTES = 8 * HTB, NXCD = 8, WGM = 8;

__host__ __device__ __forceinline__ int lds_byte(int r, int c) { const int st = (r >> 4) * 2 + (c >> 5), rr = r & 15, cc = c & 31, ob = rr * 64 + cc * 2; return st * 1024 + (ob ^ (((ob >> 9) & 1) << 5)); }
__host__ __device__ __forceinline__ void stage_rc(int b, int& R, int& C) { const int st = b / 1024, sb = b % 1024, swz = sb ^ (((sb >> 9) & 1) << 5); R = (st >> 1) * 16 + swz / 64; C = (st & 1) * 32 + (swz % 64) / 2; }
__host__ __device__ __forceinline__ int perm32(int rho) { const int n = rho >> 4, i = rho & 15; return 8 * (i >> 2) + 4 * n + (i & 3); }

struct Unit { int pm, pn; };
struct Gemm { const bf16_t* A; const bf16_t* Bt; int M, N, K; };

struct StaticOrder {
    int nM, nN, nwg, G, c;
    __host__ __device__ void init(int M, int N, int G_, int c_) { nM = M / BM; nN = N / BM; nwg = nM * nN; G = G_; c = c_; }
    __host__ __device__ bool next(int i, Unit& u) const {
        const long L = (long)i * G + c; if (L >= nwg) return false;
        int wgid = (int)L; { const int q = nwg / NXCD, r = nwg % NXCD, xcd = wgid % NXCD, off = wgid / NXCD; wgid = (xcd < r ? xcd * (q + 1) : r * (q + 1) + (xcd - r) * q) + off; }
        const int nig = WGM * nN, gid = wgid / nig, fm = gid * WGM, gsz = (nM - fm) < WGM ? (nM - fm) : WGM;
        u.pm = fm + ((wgid % nig) % gsz); u.pn = (wgid % nig) / gsz; return true;
    }
    __device__ __forceinline__ void a_ready(const Unit&) const {}
    __device__ __forceinline__ void done(const Unit&) const {}
};

__device__ __forceinline__ unsigned cvt_pk_bf16(float lo, float hi) { unsigned r; asm volatile("v_cvt_pk_bf16_f32 %0, %1, %2" : "=v"(r) : "v"(lo), "v"(hi)); return r; }

template <int ACT> struct EpiBf16 {
    static constexpr bool PERM = true, AFTER_DRAIN = false;
    bf16_t* O; int ldc;
    __device__ __forceinline__ void operator()(const f32x4 (&acc)[2][2][4][2], const Unit& u, int wr, int wc, int fr, int fq) const {
        const int row0 = u.pm * BM + wr * 64 + fr; const int col0 = u.pn * BM + wc * 32 + 8 * fq;
#pragma unroll
        for (int ai = 0; ai < 2; ++ai)
#pragma unroll
            for (int m = 0; m < 4; ++m) { bf16_t* rowp = O + (size_t)(row0 + ai * HALF + m * 16) * ldc + col0;
#pragma unroll
                for (int bj = 0; bj < 2; ++bj) { f32x4 v0 = acc[ai][bj][m][0], v1 = acc[ai][bj][m][1];
                    if (ACT == 1) {
#pragma unroll
                        for (int j = 0; j < 4; ++j) { const float a = fmaxf(v0[j], 0.f), b = fmaxf(v1[j], 0.f); v0[j] = a * a; v1[j] = b * b; } }
                    u32x4 w; w.x = cvt_pk_bf16(v0[0], v0[1]); w.y = cvt_pk_bf16(v0[2], v0[3]); w.z = cvt_pk_bf16(v1[0], v1[1]); w.w = cvt_pk_bf16(v1[2], v1[3]);
                    *(u32x4*)(rowp + bj * HALF) = w; } }
    }
};
struct EpiResid {
    static constexpr bool PERM = false, AFTER_DRAIN = false;
    const float* base0; const float* base1; float* out; int ldc; int split; const float* gate; int gate_stride; const float* gate_ctx;
    __device__ __forceinline__ void operator()(const f32x4 (&acc)[2][2][4][2], const Unit& u, int wr, int wc, int fr, int fq) const {
        const int rloc = wr * 64 + fr, col0 = u.pn * BM + wc * 32 + 4 * fq;
        const float* bt = (u.pm < split) ? base0 + (size_t)u.pm * BM * ldc : base1 + (size_t)(u.pm - split) * BM * ldc;
        const float* gv = (u.pm < split) ? gate_ctx : gate + (size_t)((u.pm - split) >> 2) * gate_stride;
        float* ot = out + (size_t)u.pm * BM * ldc;
        f32x4 g[2][2];
#pragma unroll
        for (int bj = 0; bj < 2; ++bj)
#pragma unroll
            for (int n = 0; n < 2; ++n) g[bj][n] = *(const f32x4*)(gv + col0 + bj * HALF + n * 16);
#pragma unroll
        for (int ai = 0; ai < 2; ++ai)
#pragma unroll
            for (int m = 0; m < 4; ++m) { const size_t off = (size_t)(rloc + ai * HALF + m * 16) * ldc + col0;
#pragma unroll
                for (int bj = 0; bj < 2; ++bj)
#pragma unroll
                    for (int n = 0; n < 2; ++n) { const f32x4 bs = *(const f32x4*)(bt + off + bj * HALF + n * 16); *(f32x4*)(ot + off + bj * HALF + n * 16) = bs + g[bj][n] * acc[ai][bj][m][n]; }
                asm volatile("" ::: "memory"); }
    }
};

struct EpiNull {
    static constexpr bool PERM = true, AFTER_DRAIN = false;
    __device__ __forceinline__ void operator()(const f32x4 (&acc)[2][2][4][2], const Unit& u, int wr, int wc, int fr, int fq) const {
#pragma unroll
        for (int ai = 0; ai < 2; ++ai)
#pragma unroll
            for (int bj = 0; bj < 2; ++bj)
#pragma unroll
                for (int m = 0; m < 4; ++m)
#pragma unroll
                    for (int n = 0; n < 2; ++n) asm volatile("" :: "v"(acc[ai][bj][m][n]));
    }
};

template <class Epi, class Sched, bool ALIGN_EPI = false, bool SP2 = false>
__device__ __forceinline__ void gemm_phase(PG8_LAS unsigned char* lds, const Gemm g, const Sched& S, const Epi& E) {
    int tid_ = threadIdx.x; asm volatile("" : "+v"(tid_));
    const int tid = tid_, wid = __builtin_amdgcn_readfirstlane(tid >> 6), lane = tid & 63, wr = wid >> 2, wc = wid & 3, fr = lane & 15, fq = lane >> 4;
    const int K = g.K, nt = K / BK;
    unsigned voffA[2], voffB[2];
#pragma unroll
    for (int i = 0; i < 2; ++i) { int R, C; stage_rc(tid * 16 + i * 8192, R, C); const int Rb = Epi::PERM ? ((R & ~31) + perm32(R & 31)) : R;
        voffA[i] = (unsigned)(R * K + C) * 2u; voffB[i] = (unsigned)(Rb * K + C) * 2u; }
    const size_t kstep = (size_t)(BK * 2);
    const size_t hstep = (size_t)HALF * K * 2;
    const size_t tstep = 2 * hstep;
    const unsigned ldsw = (unsigned)wid * 1024u;
    const int aoff = lds_byte(wr * 64 + fr, fq * 8), boff = lds_byte(wc * 32 + fr, fq * 8);
#define PG8_SA(b, h) (((b) * 2 + (h)) * HTB)
#define PG8_SB(b, h) ((4 + (b) * 2 + (h)) * HTB)
#define PG8_STAGE(bufoff, gbase, voff) do { _Pragma("unroll") for (int _i = 0; _i < 2; ++_i) \
        __builtin_amdgcn_global_load_lds((const unsigned*)((const char*)(gbase) + (voff)[_i]), (PG8_LAS unsigned*)(lds + (bufoff) + ldsw + _i * 8192), 16, 0, 0); } while (0)
#define PG8_LDA(dst, b, h) do { _Pragma("unroll") for (int m = 0; m < 4; ++m) _Pragma("unroll") for (int k = 0; k < 2; ++k) dst[m][k] = *(const PG8_LAS bf16x8*)(lds + PG8_SA(b, h) + aoff + m * 2048 + k * 1024); } while (0)
#define PG8_LDB(dst, b, h) do { _Pragma("unroll") for (int n = 0; n < 2; ++n) _Pragma("unroll") for (int k = 0; k < 2; ++k) dst[n][k] = *(const PG8_LAS bf16x8*)(lds + PG8_SB(b, h) + boff + n * 2048 + k * 1024); } while (0)
#define PG8_MMA(ai, bj, At, Bt) do { __builtin_amdgcn_s_setprio(1); _Pragma("unroll") for (int m = 0; m < 4; ++m) _Pragma("unroll") for (int n = 0; n < 2; ++n) _Pragma("unroll") for (int k = 0; k < 2; ++k) \
        acc[ai][bj][m][n] = __builtin_amdgcn_mfma_f32_16x16x32_bf16(Bt[n][k], At[m][k], acc[ai][bj][m][n], 0, 0, 0); __builtin_amdgcn_s_setprio(0); } while (0)
#define PG8_WAIT_V(n) asm volatile("s_waitcnt vmcnt(" #n ")" ::: "memory")
#define PG8_WAIT_L(n) asm volatile("s_waitcnt lgkmcnt(" #n ")" ::: "memory")
#define PG8_BAR __builtin_amdgcn_s_barrier()
#define PG8_SCHED __builtin_amdgcn_sched_barrier(0)
    Unit cur, nxt; int ui = 0;
    if (!S.next(0, cur)) return;
    f32x4 acc[2][2][4][2];
#pragma unroll
    for (int a = 0; a < 2; ++a)
#pragma unroll
        for (int b = 0; b < 2; ++b)
#pragma unroll
            for (int m = 0; m < 4; ++m)
#pragma unroll
                for (int n = 0; n < 2; ++n) acc[a][b][m][n] = (f32x4){0.f, 0.f, 0.f, 0.f};
    bf16x8 At[4][2], B0[2][2], B1[2][2];
    const char* cA = (const char*)g.A + (size_t)cur.pm * tstep; const char* cB = (const char*)g.Bt + (size_t)cur.pn * tstep;
    S.a_ready(cur);
    if constexpr (SP2) {
        PG8_STAGE(PG8_SB(0, 0), cB, voffB); PG8_STAGE(PG8_SB(0, 1), cB + hstep, voffB); PG8_STAGE(PG8_SA(0, 0), cA, voffA); PG8_STAGE(PG8_SA(0, 1), cA + hstep, voffA);
        if (wr == 1) PG8_BAR;
        PG8_WAIT_V(2); PG8_BAR;
        PG8_STAGE(PG8_SB(1, 0), cB + kstep, voffB); PG8_STAGE(PG8_SA(1, 0), cA + kstep, voffA); PG8_STAGE(PG8_SB(1, 1), cB + hstep + kstep, voffB);
        PG8_WAIT_V(6); PG8_BAR;
    } else {
        PG8_STAGE(PG8_SB(0, 0), cB, voffB); PG8_STAGE(PG8_SA(0, 0), cA, voffA); PG8_STAGE(PG8_SB(0, 1), cB + hstep, voffB); PG8_STAGE(PG8_SA(0, 1), cA + hstep, voffA);
        if (wr == 1) PG8_BAR;
        PG8_WAIT_V(4); PG8_BAR;
        PG8_STAGE(PG8_SB(1, 0), cB + kstep, voffB); PG8_STAGE(PG8_SA(1, 0), cA + kstep, voffA); PG8_STAGE(PG8_SB(1, 1), cB + hstep + kstep, voffB);
        PG8_WAIT_V(6); PG8_BAR;
    }
    for (;;) {
        const bool has_next = S.next(ui + 1, nxt);
        const char* nA = has_next ? (const char*)g.A + (size_t)nxt.pm * tstep : cA; const char* nB = has_next ? (const char*)g.Bt + (size_t)nxt.pn * tstep : cB;
        for (int t = 0; t < nt; t += 2) {
            const bool last = (t == nt - 2);
            const char* a1 = cA + (size_t)(t + 1) * kstep;
            const char* a2 = last ? nA : cA + (size_t)(t + 2) * kstep; const char* b2 = last ? nB : cB + (size_t)(t + 2) * kstep;
            const char* a3 = a2 + kstep; const char* b3 = b2 + kstep;
            if (last && has_next) S.a_ready(nxt);
            if constexpr (SP2) {
            PG8_LDB(B0, 0, 0); PG8_LDB(B1, 0, 1); PG8_SCHED; PG8_LDA(At, 0, 0); PG8_STAGE(PG8_SA(1, 1), a1 + hstep, voffA);
            PG8_WAIT_V(8); PG8_WAIT_L(0); PG8_BAR; PG8_MMA(0, 0, At, B0); PG8_MMA(0, 1, At, B1); PG8_BAR; PG8_SCHED;
            PG8_LDA(At, 0, 1); PG8_STAGE(PG8_SB(0, 0), b2, voffB); PG8_STAGE(PG8_SB(0, 1), b2 + hstep, voffB); PG8_STAGE(PG8_SA(0, 0), a2, voffA);
            PG8_WAIT_V(8); PG8_WAIT_L(0); PG8_BAR; PG8_MMA(1, 0, At, B0); PG8_MMA(1, 1, At, B1); PG8_BAR; PG8_SCHED;
            PG8_LDB(B0, 1, 0); PG8_LDB(B1, 1, 1); PG8_SCHED; PG8_LDA(At, 1, 0); PG8_STAGE(PG8_SA(0, 1), a2 + hstep, voffA);
            PG8_WAIT_V(8); PG8_WAIT_L(0); PG8_BAR; PG8_MMA(0, 0, At, B0); PG8_MMA(0, 1, At, B1); PG8_BAR; PG8_SCHED;
            PG8_LDA(At, 1, 1); PG8_STAGE(PG8_SB(1, 0), b3, voffB); PG8_STAGE(PG8_SB(1, 1), b3 + hstep, voffB); PG8_STAGE(PG8_SA(1, 0), a3, voffA);
            PG8_WAIT_V(8); PG8_WAIT_L(0); PG8_BAR; PG8_MMA(1, 0, At, B0); PG8_MMA(1, 1, At, B1); PG8_BAR; PG8_SCHED;
            } else {
            PG8_LDB(B0, 0, 0); PG8_SCHED; PG8_LDA(At, 0, 0); PG8_STAGE(PG8_SA(1, 1), a1 + hstep, voffA);
            PG8_WAIT_L(8); PG8_BAR; PG8_WAIT_L(0); PG8_MMA(0, 0, At, B0); PG8_BAR; PG8_SCHED;
            PG8_LDB(B1, 0, 1); PG8_STAGE(PG8_SB(0, 0), b2, voffB);
            PG8_BAR; PG8_WAIT_L(0); PG8_MMA(0, 1, At, B1); PG8_BAR;
            PG8_LDA(At, 0, 1); PG8_STAGE(PG8_SA(0, 0), a2, voffA);
            PG8_BAR; PG8_WAIT_L(0); PG8_MMA(1, 0, At, B0); PG8_BAR; PG8_SCHED;
            PG8_STAGE(PG8_SB(0, 1), b2 + hstep, voffB);
            PG8_WAIT_V(6); PG8_BAR; PG8_MMA(1, 1, At, B1); PG8_BAR;
            PG8_LDB(B0, 1, 0); PG8_SCHED; PG8_LDA(At, 1, 0); PG8_STAGE(PG8_SA(0, 1), a2 + hstep, voffA);
            PG8_WAIT_L(8); PG8_BAR; PG8_WAIT_L(0); PG8_MMA(0, 0, At, B0); PG8_BAR; PG8_SCHED;
            PG8_LDB(B1, 1, 1); PG8_STAGE(PG8_SB(1, 0), b3, voffB);
            PG8_BAR; PG8_WAIT_L(0); PG8_MMA(0, 1, At, B1); PG8_BAR;
            PG8_LDA(At, 1, 1); PG8_STAGE(PG8_SA(1, 0), a3, voffA);
            PG8_BAR; PG8_WAIT_L(0); PG8_MMA(1, 0, At, B0); PG8_BAR; PG8_SCHED;
            PG8_STAGE(PG8_SB(1, 1), b3 + hstep, voffB);
            PG8_WAIT_V(6); PG8_BAR; PG8_MMA(1, 1, At, B1); PG8_BAR;
            }
        }
        if constexpr (ALIGN_EPI) { if (wr == 0) PG8_BAR; }
        if constexpr (!Epi::AFTER_DRAIN) { E(acc, cur, wr, wc, fr, fq); S.done(cur); }
        if (!has_next) break;
#pragma unroll
        for (int a = 0; a < 2; ++a)
#pragma unroll
            for (int b = 0; b < 2; ++b)
#pragma unroll
                for (int m = 0; m < 4; ++m)
#pragma unroll
                    for (int n = 0; n < 2; ++n) acc[a][b][m][n] = (f32x4){0.f, 0.f, 0.f, 0.f};
        cur = nxt; cA = nA; cB = nB; ++ui;
        if constexpr (ALIGN_EPI) { if (wr == 1) PG8_BAR; }
    }
    PG8_WAIT_V(0);
    if constexpr (!ALIGN_EPI) { if (wr == 0) PG8_BAR; }
    PG8_BAR;
    if constexpr (Epi::AFTER_DRAIN) { E.fused(acc, cur, wr, wc, fr, fq, lds, wid, lane); S.done(cur); }
#undef PG8_SA
#undef PG8_SB
#undef PG8_STAGE
#undef PG8_LDA
#undef PG8_LDB
#undef PG8_MMA
#undef PG8_WAIT_V
#undef PG8_WAIT_L
#undef PG8_BAR
#undef PG8_SCHED
}
}
namespace att {
#ifdef ATT_NOMASK
constexpr bool defined_NOMASK = true;
#else
constexpr bool defined_NOMASK = false;
#endif
typedef unsigned short bf16_t;
using bf16x8 = __attribute__((ext_vector_type(8))) short;
using s16x4  = __attribute__((ext_vector_type(4))) short;
using f32x16 = __attribute__((ext_vector_type(16))) float;
using u32x4  = __attribute__((ext_vector_type(4))) unsigned;
constexpr int KVBLK = 64;
constexpr int SHM_V = 16384, SHM_K = 16384;
constexpr int LDS_WS = 2 * SHM_V + 2 * SHM_K;
constexpr int LDS_X = LDS_WS + 8 * 64 * 4;
constexpr int LDS_MISC = LDS_X + 4 * 32 * 128 * 4;
constexpr int LDS_BYTES = LDS_MISC + 64;
constexpr float LOG2E = 1.4426950408889634f;
#define GASQ __attribute__((address_space(1)))
#define KSWZ(row, colB) ((row) * 256 + ((colB) ^ (((row) & 7) << 4)))
#define SBAR() __builtin_amdgcn_sched_barrier(0)
__device__ __forceinline__ int crow(int r, int hi) { return (r & 3) + 8 * (r >> 2) + 4 * hi; }
__device__ __forceinline__ unsigned cvtpk(float lo, float hi) { unsigned r; asm volatile("v_cvt_pk_bf16_f32 %0, %1, %2" : "=v"(r) : "v"(lo), "v"(hi)); return r; }

#ifndef ATT_SDEPTH0
#define ATT_SDEPTH0 1
#endif
#ifndef ATT_QLDS0
#define ATT_QLDS0 1
#endif
template <int MODE> struct Cfg {
    static constexpr float SCALE = (MODE == 0) ? 0.088388347648318440f : 0.125f;
    static constexpr float C = SCALE * LOG2E;
    static constexpr float THRS = 8.f / SCALE;
    static constexpr int ND0 = (MODE == 0) ? 8 : 4;
    static constexpr int SDEPTH = (MODE == 0) ? ATT_SDEPTH0 : 2;
    static constexpr bool QLDS = (MODE == 0) && (ATT_QLDS0 != 0);
};

template <int MODE>
__device__ __forceinline__ void partialSM(f32x16& p0, f32x16& p1, float& m_reg, float& mn, float& alpha) {
  constexpr float C = Cfg<MODE>::C;
  float pmax = p0[0];
#pragma unroll
  for (int r = 1; r < 16; ++r) pmax = fmaxf(pmax, p0[r]);
#pragma unroll
  for (int r = 0; r < 16; ++r) pmax = fmaxf(pmax, p1[r]);
  { auto rr = __builtin_amdgcn_permlane32_swap(__float_as_uint(pmax), __float_as_uint(pmax), false, false);
    pmax = fmaxf(__uint_as_float(rr[0]), __uint_as_float(rr[1])); }
  if (__builtin_expect(__all(pmax - m_reg <= Cfg<MODE>::THRS), 1)) { mn = m_reg; alpha = 1.f; }
  else { mn = fmaxf(m_reg, pmax); alpha = __builtin_amdgcn_exp2f((m_reg - mn) * C); m_reg = mn; }
  const float mnC = -mn * C;
#pragma unroll
  for (int r = 0; r < 16; ++r) p0[r] = fmaf(p0[r], C, mnC);
#pragma unroll
  for (int r = 0; r < 16; ++r) p1[r] = fmaf(p1[r], C, mnC);
#pragma unroll
  for (int r = 0; r < 16; ++r) p0[r] = __builtin_amdgcn_exp2f(p0[r]);
}
__device__ __forceinline__ void finishSM(f32x16& p0, f32x16& p1, float alpha, float& l_reg, bf16x8& pa0, bf16x8& pa1, bf16x8& pa2, bf16x8& pa3) {
#pragma unroll
  for (int r = 0; r < 16; ++r) p1[r] = __builtin_amdgcn_exp2f(p1[r]);
  float ps = 0;
#pragma unroll
  for (int r = 0; r < 16; ++r) ps += p0[r];
#pragma unroll
  for (int r = 0; r < 16; ++r) ps += p1[r];
  { auto rr = __builtin_amdgcn_permlane32_swap(__float_as_uint(ps), __float_as_uint(ps), false, false);
    ps = __uint_as_float(rr[0]) + __uint_as_float(rr[1]); }
  l_reg = l_reg * alpha + ps;
#define PK4(P, BASE, OUT) do { unsigned a0 = cvtpk(P[BASE + 0], P[BASE + 1]), a1 = cvtpk(P[BASE + 2], P[BASE + 3]);   \
    unsigned b0 = cvtpk(P[BASE + 4], P[BASE + 5]), b1 = cvtpk(P[BASE + 6], P[BASE + 7]);                              \
    auto r0 = __builtin_amdgcn_permlane32_swap(a0, b0, false, false); auto r1 = __builtin_amdgcn_permlane32_swap(a1, b1, false, false); \
    u32x4 w = {r0[0], r1[0], r0[1], r1[1]}; OUT = *reinterpret_cast<bf16x8*>(&w); } while (0)
  PK4(p0, 0, pa0); PK4(p0, 8, pa1); PK4(p1, 0, pa2); PK4(p1, 8, pa3);
#undef PK4
}
template <int MODE, bool QLDS>
__device__ __forceinline__ void qkt(f32x16& p0, f32x16& p1, const char* Ks, const bf16x8* qr, const char* qs, int r32, int hi, int comp) {
  p0 = f32x16{}; p1 = f32x16{};
  int rb = r32; asm volatile("" : "+v"(rb));
  const int swz = (rb & 7) << 4, rowb = rb * 256 + comp * 128;
  const char* a0 = Ks + rowb + ((0 * 32 + hi * 16) ^ swz); const char* a1 = Ks + rowb + ((1 * 32 + hi * 16) ^ swz);
  const char* a2 = Ks + rowb + ((2 * 32 + hi * 16) ^ swz); const char* a3 = Ks + rowb + ((3 * 32 + hi * 16) ^ swz);
#pragma unroll
  for (int d0 = 0; d0 < Cfg<MODE>::ND0; ++d0) { const int dl = d0 & 3, dh = d0 >> 2; const char* ap = (dl == 0 ? a0 : dl == 1 ? a1 : dl == 2 ? a2 : a3) + dh * 128;
    bf16x8 b0 = *reinterpret_cast<const bf16x8*>(ap);
    bf16x8 b1 = *reinterpret_cast<const bf16x8*>(ap + 8192);
    bf16x8 q; if constexpr (QLDS) q = *reinterpret_cast<const bf16x8*>(qs + d0 * 1024); else q = qr[d0];
    p0 = __builtin_amdgcn_mfma_f32_32x32x16_bf16(b0, q, p0, 0, 0, 0);
    p1 = __builtin_amdgcn_mfma_f32_32x32x16_bf16(b1, q, p1, 0, 0, 0); }
}
__device__ __forceinline__ int v_st(int k, int c) { const int kk = (k & ~0xC) | ((k & 4) << 1) | ((k & 8) >> 1); return ((kk >> 3) * 4 + (c >> 5)) * 512 + ((kk & 7) * 32 + (c & 31)) * 2; }
__device__ __forceinline__ int v_rd_base(int lane) { return ((lane & 3) << 3) | (((lane >> 2) & 3) << 6) | (((lane >> 4) & 1) << 5) | (((lane >> 5) & 1) << 8); }
constexpr int v_rd_off(int d0, int ks, int half) { return d0 * 512 + ks * 4096 + half * 2048; }
template <int OFF> __device__ __forceinline__ s16x4 tr_read(int vb) {
  s16x4 r; asm volatile("ds_read_b64_tr_b16 %0, %1 offset:%2" : "=&v"(r) : "v"(vb), "i"(OFF) : "memory"); return r;
}
template <int D0> __device__ __forceinline__ void pv_one(f32x16& od, int vb, bf16x8 pa0, bf16x8 pa1, bf16x8 pa2, bf16x8 pa3) {
  const s16x4 l0 = tr_read<v_rd_off(D0, 0, 0)>(vb), h0 = tr_read<v_rd_off(D0, 0, 1)>(vb), l1 = tr_read<v_rd_off(D0, 1, 0)>(vb), h1 = tr_read<v_rd_off(D0, 1, 1)>(vb);
  const s16x4 l2 = tr_read<v_rd_off(D0, 2, 0)>(vb), h2 = tr_read<v_rd_off(D0, 2, 1)>(vb), l3 = tr_read<v_rd_off(D0, 3, 0)>(vb), h3 = tr_read<v_rd_off(D0, 3, 1)>(vb);
  asm volatile("s_waitcnt lgkmcnt(0)" ::: "memory"); SBAR();
#define PK(L, H) (bf16x8){L[0], L[1], L[2], L[3], H[0], H[1], H[2], H[3]}
  od = __builtin_amdgcn_mfma_f32_32x32x16_bf16(pa0, PK(l0, h0), od, 0, 0, 0);
  od = __builtin_amdgcn_mfma_f32_32x32x16_bf16(pa1, PK(l1, h1), od, 0, 0, 0);
  od = __builtin_amdgcn_mfma_f32_32x32x16_bf16(pa2, PK(l2, h2), od, 0, 0, 0);
  od = __builtin_amdgcn_mfma_f32_32x32x16_bf16(pa3, PK(l3, h3), od, 0, 0, 0);
#undef PK
}
__device__ __forceinline__ void pv_d0(f32x16* o, int vb, bf16x8 pa0, bf16x8 pa1, bf16x8 pa2, bf16x8 pa3) {
  pv_one<0>(o[0], vb, pa0, pa1, pa2, pa3); pv_one<1>(o[1], vb, pa0, pa1, pa2, pa3); pv_one<2>(o[2], vb, pa0, pa1, pa2, pa3); pv_one<3>(o[3], vb, pa0, pa1, pa2, pa3);
}

struct UnitArgs {
    const bf16_t* Qb; int ldq;
    const bf16_t* Kh; const bf16_t* Vh;
    bf16_t* Ob; int ldo;
    int NT;
    int jwin, wadd;
    int masked, t0;
    float sinkl2;
    float lam;
    const float* subg;
};

template <int MODE>
__device__ __forceinline__ void attn_unit(const UnitArgs& A, char* lds) {
  constexpr float C = Cfg<MODE>::C; constexpr int ND0 = Cfg<MODE>::ND0;
  int tid_ = threadIdx.x; asm volatile("" : "+v"(tid_));
  const int tid = tid_, wid = tid >> 6, lane = tid & 63, r32 = lane & 31, hi = lane >> 5;
  const int wq = (MODE == 0) ? wid : (wid & 3), comp = (MODE == 0) ? 0 : (wid >> 2);
  char* V_lds = lds; char* K_lds = lds + 2 * SHM_V;
  float* ws = (float*)(lds + LDS_WS) + wid * 64; float* li_l = ws; float* al_l = ws + 32;
  constexpr bool QLDS = Cfg<MODE>::QLDS;
  __syncthreads();
  float m_reg = -1e30f, l_reg = 0; f32x16 o[4] = {}; bf16x8 qr[QLDS ? 1 : ND0];
  char* qs = lds + LDS_X + wid * 8192 + lane * 16;
  const bf16_t* Qw = A.Qb + (long)(wq * 32 + r32) * A.ldq + comp * 64 + hi * 8;
  if constexpr (QLDS) {
#pragma unroll
    for (int d0 = 0; d0 < ND0; ++d0) *reinterpret_cast<bf16x8*>(qs + d0 * 1024) = *reinterpret_cast<const bf16x8*>(Qw + d0 * 16);
  } else {
#pragma unroll
    for (int d0 = 0; d0 < ND0; ++d0) qr[d0] = *reinterpret_cast<const bf16x8*>(Qw + d0 * 16);
  }
  const int sr = tid >> 4, sc = (tid & 15) * 8, vst0 = v_st(sr, sc), vst1 = v_st(32 + sr, sc);
  const int vb0 = (int)(uintptr_t)V_lds + v_rd_base(lane);
  const unsigned loff0 = (unsigned)(sr * 128 + sc) * 2u, loff1 = loff0 + 32u * 256u;
  const bf16_t* Kh = A.Kh; const bf16_t* Vh = A.Vh; const int NT = A.NT, jwin = A.jwin, wadd = A.wadd;
  constexpr int SDEPTH = Cfg<MODE>::SDEPTH;
  struct { bf16x8 vs0, vs1, ks0, ks1; } sr_[SDEPTH];
#define KOFF(j) (64 * (j) + (((j) >= jwin) ? wadd : 0))
#define SLOAD(i, k0) do { const size_t _kb = (size_t)(k0) * 256; const char* _vp = (const char*)Vh + _kb; const char* _kp = (const char*)Kh + _kb; \
    sr_[i].vs0 = *(const GASQ bf16x8*)(_vp + loff0); sr_[i].vs1 = *(const GASQ bf16x8*)(_vp + loff1); \
    sr_[i].ks0 = *(const GASQ bf16x8*)(_kp + loff0); sr_[i].ks1 = *(const GASQ bf16x8*)(_kp + loff1); } while (0)
#define SWRITE(b, i) do { *(bf16x8*)(V_lds + (b) * SHM_V + vst0) = sr_[i].vs0;          \
    *(bf16x8*)(V_lds + (b) * SHM_V + vst1) = sr_[i].vs1; const int kc = sc * 2;               \
    *(bf16x8*)(K_lds + (b) * SHM_K + KSWZ(sr, kc)) = sr_[i].ks0;                       \
    *(bf16x8*)(K_lds + (b) * SHM_K + KSWZ(32 + sr, kc)) = sr_[i].ks1; } while (0)
#define SWAIT() do { if constexpr (SDEPTH == 2) asm volatile("s_waitcnt vmcnt(4)" ::: "memory"); else asm volatile("s_waitcnt vmcnt(0)" ::: "memory"); } while (0)
#define RESC(a) do { if (__any((a) < 1.f)) { if (hi == 0) al_l[r32] = (a); asm volatile("s_waitcnt lgkmcnt(0)" ::: "memory"); \
    _Pragma("unroll") for (int d = 0; d < 4; ++d) _Pragma("unroll") for (int r = 0; r < 16; ++r) o[d][r] *= al_l[crow(r, hi)]; } } while (0)
#define MASKT(P0, P1, j) do { if (MODE == 0 && !defined_NOMASK && A.masked && (j) >= jwin) { const int kp0 = KOFF(j) - 512, qw0 = A.t0 + wq * 32; \
    if (kp0 < qw0 + 31 - 128 || kp0 + 63 > qw0 + 128) { const int dkb = kp0 - qw0 - r32 + 4 * hi + 128; \
      _Pragma("unroll") for (int r = 0; r < 16; ++r) { const int cr = (r & 3) + 8 * (r >> 2); if ((unsigned)(dkb + cr) > 256u) P0[r] = -1e30f; if ((unsigned)(dkb + cr + 32) > 256u) P1[r] = -1e30f; } } } } while (0)
  f32x16 pA0, pA1, pB0, pB1; float mnA, mnB, alA, alB; bf16x8 pa0, pa1, pa2, pa3;
  constexpr int SE = 0, SO = SDEPTH - 1;
  SLOAD(SE, KOFF(0)); asm volatile("s_waitcnt vmcnt(0)" ::: "memory"); SWRITE(0, SE); __syncthreads();
  qkt<MODE, QLDS>(pA0, pA1, K_lds, qr, qs, r32, hi, comp); MASKT(pA0, pA1, 0); partialSM<MODE>(pA0, pA1, m_reg, mnA, alA);
  SLOAD(SO, KOFF(1)); if constexpr (SDEPTH == 2) { if (2 < NT) SLOAD(SE, KOFF(2)); }
  SWAIT(); SWRITE(1, SO); __syncthreads();
  for (int j = 1; j + 1 < NT; j += 2) {
    SBAR(); qkt<MODE, QLDS>(pB0, pB1, K_lds + SHM_K, qr, qs, r32, hi, comp);
    finishSM(pA0, pA1, alA, l_reg, pa0, pa1, pa2, pa3); SBAR();
    SLOAD(SO, KOFF(j + SDEPTH)); SBAR();
    pv_d0(o, vb0, pa0, pa1, pa2, pa3); MASKT(pB0, pB1, j); partialSM<MODE>(pB0, pB1, m_reg, mnB, alB);
    __syncthreads(); SWAIT(); SWRITE(0, SE);
    RESC(alB); __syncthreads();
    SBAR(); qkt<MODE, QLDS>(pA0, pA1, K_lds, qr, qs, r32, hi, comp);
    finishSM(pB0, pB1, alB, l_reg, pa0, pa1, pa2, pa3); SBAR();
    if (SDEPTH == 1 || j + 3 < NT) SLOAD(SE, KOFF(j + 1 + SDEPTH)); SBAR();
    pv_d0(o, vb0 + SHM_V, pa0, pa1, pa2, pa3); MASKT(pA0, pA1, j + 1); partialSM<MODE>(pA0, pA1, m_reg, mnA, alA);
    __syncthreads(); SWAIT(); SWRITE(1, SO);
    RESC(alA); __syncthreads();
  }
  SBAR(); qkt<MODE, QLDS>(pB0, pB1, K_lds + SHM_K, qr, qs, r32, hi, comp);
  finishSM(pA0, pA1, alA, l_reg, pa0, pa1, pa2, pa3); SBAR();
  pv_d0(o, vb0, pa0, pa1, pa2, pa3); MASKT(pB0, pB1, NT - 1); partialSM<MODE>(pB0, pB1, m_reg, mnB, alB);
  __syncthreads(); RESC(alB);
  finishSM(pB0, pB1, alB, l_reg, pa0, pa1, pa2, pa3); SBAR();
  pv_d0(o, vb0 + SHM_V, pa0, pa1, pa2, pa3);
  if (MODE == 0) l_reg += __builtin_amdgcn_exp2f(A.sinkl2 - m_reg * C);
  if (hi == 0) li_l[r32] = l_reg;
  asm volatile("s_waitcnt lgkmcnt(0)" ::: "memory");
  float rli[16];
#pragma unroll
  for (int r = 0; r < 16; ++r) rli[r] = __builtin_amdgcn_rcpf(li_l[crow(r, hi)]);
  bf16_t* Ow = A.Ob + (long)(wq * 32) * A.ldo;
  const int odd = lane & 1;
  if (MODE == 0) {
#pragma unroll
    for (int d0 = 0; d0 < 4; ++d0)
#pragma unroll
      for (int rp = 0; rp < 8; ++rp) {
        const float a = o[d0][2 * rp] * rli[2 * rp], b = o[d0][2 * rp + 1] * rli[2 * rp + 1];
        const float send = odd ? a : b; const float recv = __shfl_xor(send, 1);
        const float lo = odd ? recv : a, hh = odd ? b : recv;
        const int row = crow(2 * rp + odd, hi);
        *(unsigned*)(Ow + (long)row * A.ldo + d0 * 32 + (r32 & ~1)) = cvtpk(lo, hh);
      }
  } else {
    float* X = (float*)(lds + LDS_X) + wq * (32 * 128);
    if (comp == 1) {
      const float lam = A.lam;
#pragma unroll
      for (int d0 = 0; d0 < 4; ++d0)
#pragma unroll
        for (int r = 0; r < 16; ++r) X[crow(r, hi) * 128 + d0 * 32 + r32] = o[d0][r] * rli[r] * lam;
    }
    __syncthreads();
    if (comp == 0) {
      float rs[16];
#pragma unroll
      for (int r = 0; r < 16; ++r) { float ss = 0.f;
#pragma unroll
        for (int d0 = 0; d0 < 4; ++d0) { const float v = o[d0][r] * rli[r] - X[crow(r, hi) * 128 + d0 * 32 + r32]; o[d0][r] = v; ss += v * v; }
        ss += __shfl_xor(ss, 1); ss += __shfl_xor(ss, 2); ss += __shfl_xor(ss, 4); ss += __shfl_xor(ss, 8); ss += __shfl_xor(ss, 16);
        rs[r] = __builtin_amdgcn_rsqf(ss * (1.f / 128.f) + 1e-6f) * 0.8f; }
#pragma unroll
      for (int d0 = 0; d0 < 4; ++d0) { const float g = A.subg[d0 * 32 + r32];
#pragma unroll
        for (int rp = 0; rp < 8; ++rp) {
          const float a = o[d0][2 * rp] * rs[2 * rp] * g, b = o[d0][2 * rp + 1] * rs[2 * rp + 1] * g;
          const float send = odd ? a : b; const float recv = __shfl_xor(send, 1);
          const float lo = odd ? recv : a, hh = odd ? b : recv;
          const int row = crow(2 * rp + odd, hi);
          *(unsigned*)(Ow + (long)row * A.ldo + d0 * 32 + (r32 & ~1)) = cvtpk(lo, hh);
        } }
    }
  }
#undef KOFF
#undef SLOAD
#undef SWRITE
#undef SWAIT
#undef RESC
#undef MASKT
}
#undef KSWZ
#undef GASQ
#undef SBAR
}

#define GAS __attribute__((address_space(1)))
#define LAS __attribute__((address_space(3)))
typedef unsigned short bf16;
typedef unsigned v4u __attribute__((ext_vector_type(4)));
typedef float f32x4 __attribute__((ext_vector_type(4)));
typedef short bf16x8 __attribute__((ext_vector_type(8)));
typedef GAS unsigned gu32;
typedef GAS unsigned long long gu64;
#define RLX_AGENT __ATOMIC_RELAXED, __HIP_MEMORY_SCOPE_AGENT
#define LDS_WAIT() asm volatile("s_waitcnt lgkmcnt(0)" ::: "memory")
#define VM_WAIT() asm volatile("s_waitcnt vmcnt(0)" ::: "memory")
__device__ __forceinline__ unsigned long long rt() { return __builtin_amdgcn_s_memrealtime(); }
__device__ __forceinline__ unsigned f2bf(float f) { unsigned u = __builtin_bit_cast(unsigned, f); return (u + 0x7fffu + ((u >> 16) & 1u)) >> 16; }
__device__ __forceinline__ unsigned pk2(float lo, float hi) { return f2bf(lo) | (f2bf(hi) << 16); }

#define XB_TMO      128
#define XB_XCNT(j)  (256  + 64 * (j))
#define XB_XSUB(j)  (1280 + 64 * (j))
#define XB_XGEN(j)  (2304 + 64 * (j))
#define XB_TOP      3328
#define XB_TOPGEN   3392
#define XCD_BAR_WORDS 3456
#define XB_SPIN_CAP (1u << 18)

__device__ __forceinline__ unsigned xb_ld(unsigned* p)              { return __hip_atomic_load(p, __ATOMIC_RELAXED, __HIP_MEMORY_SCOPE_AGENT); }
__device__ __forceinline__ unsigned xb_add(unsigned* p, unsigned v) { return __hip_atomic_fetch_add(p, v, __ATOMIC_RELAXED, __HIP_MEMORY_SCOPE_AGENT); }
__device__ __forceinline__ unsigned xb_xcc_id() { return (unsigned)__builtin_amdgcn_s_getreg((3 << 11) | 20) & 0xFu; }
#define XB_SPIN(cond, bar) do { unsigned _sp = 0; while (cond) { __builtin_amdgcn_s_sleep(1); \
    if ((++_sp & 255u) == 0u) { if (xb_ld(&(bar)[XB_TMO])) break; if (_sp > XB_SPIN_CAP) { atomicAdd(&(bar)[XB_TMO], 1u); break; } } } } while (0)

struct XcdBarrier {
    unsigned* bar; unsigned x;
    volatile LAS unsigned* st;
};

__device__ __forceinline__ XcdBarrier xcd_barrier_post(unsigned* bar, volatile LAS unsigned* st) {
    XcdBarrier b; b.bar = bar; b.x = xb_xcc_id(); b.st = st;
    if (threadIdx.x == 0) (void)xb_add(&bar[XB_XCNT(b.x)], 1u);
    return b;
}
__device__ __forceinline__ void xcd_barrier_complete(unsigned* bar, unsigned x, unsigned& nloc, unsigned& nx) {
    const unsigned G = gridDim.x * gridDim.y * gridDim.z;
    unsigned sum, cnt, mine, sp = 0u;
    for (;;) {
        sum = 0u; cnt = 0u; mine = 0u;
#pragma unroll
        for (unsigned j = 0; j < 16; ++j) { const unsigned c = xb_ld(&bar[XB_XCNT(j)]); sum += c; cnt += (c > 0u) ? 1u : 0u; mine = (j == x) ? c : mine; }
        if (sum == G) break;
        __builtin_amdgcn_s_sleep(1);
        if ((++sp & 255u) == 0u) { if (xb_ld(&bar[XB_TMO])) break; if (sp > XB_SPIN_CAP) { atomicAdd(&bar[XB_TMO], 1u); break; } }
    }
    nloc = mine > 0u ? mine : 1u; nx = cnt > 0u ? cnt : 1u;
}

__device__ __forceinline__ void xcd_barrier(const XcdBarrier& b) {
    asm volatile("s_waitcnt vmcnt(0)" ::: "memory");
    __syncthreads();
    if (threadIdx.x == 0) {
        unsigned* bar = b.bar;
        __builtin_amdgcn_s_waitcnt(0);
        unsigned nloc = b.st[0], nx = b.st[1];
        if (nloc == 0u) { xcd_barrier_complete(bar, b.x, nloc, nx); b.st[0] = nloc; b.st[1] = nx; }
        const unsigned old = xb_add(&bar[XB_XSUB(b.x)], 1u);
        const unsigned gen = old / nloc;
        if (old + 1u == (gen + 1u) * nloc) {
            __builtin_amdgcn_fence(__ATOMIC_RELEASE, "agent");
            asm volatile("s_waitcnt vmcnt(0)" ::: "memory");
            const unsigned og = xb_add(&bar[XB_TOP], 1u);
            const unsigned tg = og / nx;
            if (og + 1u == (tg + 1u) * nx) xb_add(&bar[XB_TOPGEN], 1u);
            else XB_SPIN(xb_ld(&bar[XB_TOPGEN]) == tg, bar);
            __builtin_amdgcn_fence(__ATOMIC_ACQUIRE, "agent");
            xb_add(&bar[XB_XGEN(b.x)], 1u);
            asm volatile("s_waitcnt vmcnt(0)" ::: "memory");
        } else {
            XB_SPIN(xb_ld(&bar[XB_XGEN(b.x)]) == gen, bar);
            __builtin_amdgcn_fence(__ATOMIC_ACQUIRE, "agent");
            asm volatile("s_waitcnt vmcnt(0)" ::: "memory");
        }
    }
    __syncthreads();
}
#ifndef MK_N_LAUNCHES
#define MK_N_LAUNCHES 1
#endif
constexpr int NPH = 9;
constexpr int N_LAUNCHES = MK_N_LAUNCHES;
constexpr int NWAVES = 8;

constexpr int DM = 4096, DIN = 6144, DFF = 16384, NMOD = 6 * DM;
constexpr int NB_P = 16, T_P = 256, NB_S = 8, T_S = 1024, LCTX = 512;
constexpr int M_P = NB_P * T_P, M_S = NB_S * T_S, MTOK = M_P + M_S;
constexpr int KSPLIT = 8;
constexpr int KVL = LCTX + T_S;
constexpr float EPS = 1e-6f;

constexpr size_t MiB = 1u << 20;
constexpr size_t WS_CTL = 0, CTL_ZERO_BYTES = 1 * MiB;
constexpr size_t WS_MODP = 1 * MiB;
constexpr size_t WS_MODF = 8 * MiB;
constexpr size_t WS_WIN = 16 * MiB, WS_WOUT = 64 * MiB, WS_WFC1 = 96 * MiB, WS_WFC2 = 224 * MiB;
constexpr size_t WS_H = 352 * MiB;
constexpr size_t WS_P = 448 * MiB;
constexpr size_t WS_O = 592 * MiB;
constexpr size_t WS_KVL = 688 * MiB, KVL_SZ = (size_t)NB_S * 4 * KVL * 128 * 2;
constexpr size_t WS_KVP = 736 * MiB, KVP_SZ = (size_t)NB_P * 4 * T_P * 128 * 2;
constexpr size_t WS_U = 752 * MiB;
constexpr size_t WS_END = 1136 * MiB;
static_assert(WS_MODP + (size_t)KSPLIT * 9 * NMOD * 4 <= WS_MODF && WS_MODF + (size_t)9 * NMOD * 4 <= WS_WIN, "ws map");
static_assert(KVL_SZ == 12 * MiB && KVP_SZ == 4 * MiB && WS_U + (size_t)MTOK * DFF * 2 == WS_END, "ws map");
constexpr int CW_Q = 64;
constexpr int CW_BAR = 4096;

constexpr int RING_BYTES = 131072;
constexpr int MISC_OFF = 143360;
constexpr int LDS_BYTES = 147456;
static_assert(att::LDS_BYTES <= MISC_OFF && RING_BYTES <= MISC_OFF && MISC_OFF + 128 <= LDS_BYTES, "LDS map");

__device__ __forceinline__ float wave_sum(float v) {
#pragma unroll
    for (int o = 1; o < 64; o <<= 1) v += __shfl_xor(v, o);
    return v;
}
__device__ __forceinline__ float bf2f(unsigned short b) { return __uint_as_float(((unsigned)b) << 16); }

__device__ __forceinline__ int fresh_tid() { int t = threadIdx.x; asm volatile("" : "+v"(t)); return t; }
struct Args { const float* in[26]; float* out; unsigned char* ws; int ph_lo, ph_hi; };

__device__ __forceinline__ void p0_transpose_item(const float* W, int K, int N, bf16* WT, LAS float* scr, int item, int lane) {
    const int nblk = N / 32, kb = item / nblk, nb = item % nblk, k0 = 64 * kb, n0 = 32 * nb;
#pragma unroll 8
    for (int i = 0; i < 32; ++i) { const int kk = 2 * i + (lane >> 5); scr[kk * 33 + (lane & 31)] = W[(size_t)(k0 + kk) * N + n0 + (lane & 31)]; }
    LDS_WAIT(); asm volatile("" ::: "memory");
    const int c = lane & 7;
#pragma unroll
    for (int j = 0; j < 4; ++j) { const int n = (lane >> 3) + 8 * j; const LAS float* s = scr + (8 * c) * 33 + n;
        v4u o; o.x = pk2(s[0 * 33], s[1 * 33]); o.y = pk2(s[2 * 33], s[3 * 33]); o.z = pk2(s[4 * 33], s[5 * 33]); o.w = pk2(s[6 * 33], s[7 * 33]);
        *(GAS v4u*)(WT + (size_t)(n0 + n) * K + k0 + 8 * c) = o; }
    LDS_WAIT(); asm volatile("" ::: "memory");
}
__device__ __forceinline__ void p0_mod_item(const float* cmat, const float* cctx, const float* Wm, float* part, int item, int lane) {
    const int cc = item % 96, kq = item / 96;
    f32x4 acc[9];
#pragma unroll
    for (int r = 0; r < 9; ++r) acc[r] = (f32x4){0.f, 0.f, 0.f, 0.f};
    const GAS f32x4* wp = (const GAS f32x4*)(Wm + (size_t)(kq * 512) * NMOD + cc * 256) + lane;
    for (int k0 = 0; k0 < 512; k0 += 64) {
        float sv[9];
#pragma unroll
        for (int r = 0; r < 9; ++r) { const float cv = (r < 8) ? cmat[r * DM + kq * 512 + k0 + lane] : cctx[kq * 512 + k0 + lane]; sv[r] = cv / (1.f + __expf(-cv)); }
        for (int i0 = 0; i0 < 64; i0 += 8) {
            f32x4 w[8];
#pragma unroll
            for (int i = 0; i < 8; ++i) w[i] = wp[(size_t)(k0 + i0 + i) * (NMOD / 4)];
#pragma unroll
            for (int i = 0; i < 8; ++i)
#pragma unroll
                for (int r = 0; r < 9; ++r) { const float s = __uint_as_float(__builtin_amdgcn_readlane(__float_as_uint(sv[r]), i0 + i)); acc[r] += w[i] * s; }
        }
    }
#pragma unroll
    for (int r = 0; r < 9; ++r) *((GAS f32x4*)(part + (size_t)(kq * 9 + r) * NMOD + cc * 256) + lane) = acc[r];
}

template <int WHICH>
__device__ __forceinline__ void norm_phase(const Args& a, LAS unsigned char* lds, int vcu, int G, int wave) {
    const int tid = fresh_tid(), lane = tid & 63;
    LAS float* Gv = (LAS float*)lds; LAS float* Sv = Gv + DM;
    const float* bmod = a.in[9]; const float* part = (const float*)(a.ws + WS_MODP); float* modf = (float*)(a.ws + WS_MODF);
    const float* gn = WHICH == 0 ? a.in[10] : a.in[23];
    bf16* H = (bf16*)(a.ws + WS_H);
    if (WHICH == 0) {
        const int per = (9 * NMOD + G - 1) / G;
        for (int e = vcu * per + tid; e < (vcu + 1) * per && e < 9 * NMOD; e += NWAVES * 64) {
            float s = bmod[e % NMOD];
#pragma unroll
            for (int p = 0; p < KSPLIT; ++p) s += part[(size_t)p * 9 * NMOD + e];
            modf[e] = s; }
    }
    const int rows_per = (MTOK + G - 1) / G; int m = vcu * rows_per; const int mend = (m + rows_per < MTOK) ? m + rows_per : MTOK;
    while (m < mend) {
        const int r = (m < M_P) ? 8 : (m - M_P) / T_S;
        const int bnd = (m < M_P) ? M_P : M_P + (r + 1) * T_S; const int send = bnd < mend ? bnd : mend;
        __syncthreads();
        for (int c = tid; c < DM; c += NWAVES * 64) {
            float sh, sc;
            if (WHICH == 0) { sh = bmod[c]; sc = bmod[DM + c];
#pragma unroll
                for (int p = 0; p < KSPLIT; ++p) { sh += part[((size_t)p * 9 + r) * NMOD + c]; sc += part[((size_t)p * 9 + r) * NMOD + DM + c]; } }
            else { sh = modf[(size_t)r * NMOD + 3 * DM + c]; sc = modf[(size_t)r * NMOD + 4 * DM + c]; }
            Gv[c] = gn[c] * (1.f + sc); Sv[c] = sh; }
        __syncthreads();
#define NP_ROWPTR(mm_) ((const GAS f32x4*)((WHICH == 0) ? (((mm_) < M_P) ? a.in[0] + (size_t)(mm_) * DM : a.in[1] + (size_t)((mm_) - M_P) * DM) : a.out + (size_t)(mm_) * DM) + lane)
#define NP_LOAD(V, mm_) do { const GAS f32x4* xr_ = NP_ROWPTR(mm_); _Pragma("unroll") for (int j = 0; j < 16; ++j) V[j] = xr_[64 * j]; } while (0)
#define NP_PROC(V, mm_) do { float s_ = 0.f; _Pragma("unroll") for (int j = 0; j < 16; ++j) s_ += (V[j].x * V[j].x + V[j].y * V[j].y) + (V[j].z * V[j].z + V[j].w * V[j].w); \
            const float rstd_ = __builtin_amdgcn_rsqf(wave_sum(s_) * (1.f / DM) + EPS); \
            GAS unsigned long long* o8_ = (GAS unsigned long long*)(H + (size_t)(mm_) * DM) + lane; \
            _Pragma("unroll") for (int j = 0; j < 16; ++j) { const f32x4 g_ = *(const LAS f32x4*)(Gv + 4 * lane + 256 * j), sh_ = *(const LAS f32x4*)(Sv + 4 * lane + 256 * j); \
                const f32x4 y_ = V[j] * rstd_ * g_ + sh_; \
                o8_[64 * j] = (unsigned long long)pk2(y_.x, y_.y) | ((unsigned long long)pk2(y_.z, y_.w) << 32); if ((j & 3) == 3) __builtin_amdgcn_sched_barrier(0); } } while (0)
        {
            f32x4 va[16], vb[16];
            int mm = m + wave;
            if (mm < send) NP_LOAD(va, mm);
            while (mm < send) {
                const int m1 = mm + NWAVES, m2 = mm + 2 * NWAVES;
                if (m1 < send) NP_LOAD(vb, m1);
                NP_PROC(va, mm);
                if (m2 < send) NP_LOAD(va, m2);
                if (m1 < send) NP_PROC(vb, m1);
                mm = m2;
            }
        }
#undef NP_ROWPTR
#undef NP_LOAD
#undef NP_PROC
        m = send;
    }
    __syncthreads();
}

__device__ __forceinline__ void qk_item(const Args& a, const v4u raw, int it, int lane, bf16* P, float* onew, const LAS float* c128, const LAS float* s128, const LAS float* c64, const LAS float* s64) {
    const int sub = lane & 15, sg = lane >> 4;
    const int m = it / 12, grp = it - m * 12; bf16* src = P + (size_t)m * DIN + grp * 512 + lane * 8;
        float x[8];
        x[0] = __uint_as_float(raw.x << 16); x[1] = __uint_as_float(raw.x & 0xffff0000u); x[2] = __uint_as_float(raw.y << 16); x[3] = __uint_as_float(raw.y & 0xffff0000u);
        x[4] = __uint_as_float(raw.z << 16); x[5] = __uint_as_float(raw.z & 0xffff0000u); x[6] = __uint_as_float(raw.w << 16); x[7] = __uint_as_float(raw.w & 0xffff0000u);
        const bool lat = m >= M_P; const int t = lat ? (m - M_P) % T_S : m % T_P; const int b = lat ? (m - M_P) / T_S : m / T_P;
        const bool is_v = (grp == 5 || grp == 11);
        const bool is_a = grp < 6;
        if (!is_v) {
            float ss = 0.f;
#pragma unroll
            for (int e = 0; e < 8; ++e) ss += x[e] * x[e];
            ss += __shfl_xor(ss, 1); ss += __shfl_xor(ss, 2); ss += __shfl_xor(ss, 4);
            if (is_a) ss += __shfl_xor(ss, 8);
            const float rstd = __builtin_amdgcn_rsqf(ss * (is_a ? (1.f / 128.f) : (1.f / 64.f)) + EPS);
            const float* gp = (grp < 4) ? a.in[12] : (grp == 4) ? a.in[13] : (grp < 10) ? a.in[14] : a.in[15];
            const int goff = is_a ? sub * 8 : (sub & 7) * 8;
            const f32x4 g0 = *(const GAS f32x4*)(gp + goff), g1 = *(const GAS f32x4*)(gp + goff + 4);
            x[0] *= rstd * g0.x; x[1] *= rstd * g0.y; x[2] *= rstd * g0.z; x[3] *= rstd * g0.w; x[4] *= rstd * g1.x; x[5] *= rstd * g1.y; x[6] *= rstd * g1.z; x[7] *= rstd * g1.w;
            if (lat) {
                float px[8];
                if (is_a) {
#pragma unroll
                    for (int e = 0; e < 8; ++e) px[e] = __shfl_xor(x[e], 4);
                    const int axis = (sub >> 3) & 1, half = (sub >> 2) & 1, i0 = (sub & 3) * 8, pos = axis ? (t & 63) : (t >> 6);
#pragma unroll
                    for (int e = 0; e < 8; ++e) { const float cs = c128[pos * 32 + i0 + e], sn = s128[pos * 32 + i0 + e]; x[e] = half ? (x[e] * cs + px[e] * sn) : (x[e] * cs - px[e] * sn); }
                } else {
#pragma unroll
                    for (int e = 0; e < 8; ++e) px[e] = __shfl_xor(x[e], 2);
                    const int s8 = sub & 7, axis = (s8 >> 2) & 1, half = (s8 >> 1) & 1, i0 = (s8 & 1) * 8, pos = axis ? (t & 63) : (t >> 6);
#pragma unroll
                    for (int e = 0; e < 8; ++e) { const float cs = c64[pos * 16 + i0 + e], sn = s64[pos * 16 + i0 + e]; x[e] = half ? (x[e] * cs + px[e] * sn) : (x[e] * cs - px[e] * sn); }
                }
            }
        }
        v4u ob; ob.x = pk2(x[0], x[1]); ob.y = pk2(x[2], x[3]); ob.z = pk2(x[4], x[5]); ob.w = pk2(x[6], x[7]);
        const bool is_q = (grp < 4) || (grp >= 6 && grp < 10);
        if (is_q) { *(GAS v4u*)src = ob; }
        else {
            const int which = (grp == 4) ? 0 : (grp == 5) ? 1 : (grp == 10) ? 2 : 3;
            const int kv = sg;
            if (lat) { *(GAS v4u*)((bf16*)(a.ws + WS_KVL + (size_t)which * KVL_SZ) + ((size_t)(b * 4 + kv) * KVL + LCTX + t) * 128 + sub * 8) = ob; }
            else { *(GAS v4u*)((bf16*)(a.ws + WS_KVP + (size_t)which * KVP_SZ) + ((size_t)(b * 4 + kv) * T_P + t) * 128 + sub * 8) = ob;
                GAS f32x4* of = (GAS f32x4*)(onew + (size_t)which * M_P * 512 + (size_t)m * 512 + kv * 128 + sub * 8);
                of[0] = (f32x4){x[0], x[1], x[2], x[3]}; of[1] = (f32x4){x[4], x[5], x[6], x[7]}; }
        }

}
__device__ __forceinline__ void qk_phase(const Args& a, LAS unsigned char* lds, int vcu, int G, int wave) {
    const int tid = fresh_tid(), lane = tid & 63;
    LAS float* c128 = (LAS float*)lds; LAS float* s128 = c128 + 2048; LAS float* c64 = s128 + 2048; LAS float* s64 = c64 + 1024;
    for (int e = tid; e < 2048; e += NWAVES * 64) { const int pos = e >> 5, i = e & 31; const float f = exp2f(-(float)i * (13.287712379549449f / 32.f)); float sn, cs; sincosf((float)pos * f, &sn, &cs); c128[e] = cs; s128[e] = sn; }
    for (int e = tid; e < 1024; e += NWAVES * 64) { const int pos = e >> 4, i = e & 15; const float f = exp2f(-(float)i * (13.287712379549449f / 16.f)); float sn, cs; sincosf((float)pos * f, &sn, &cs); c64[e] = cs; s64[e] = sn; }
    __syncthreads();
    bf16* P = (bf16*)(a.ws + WS_P);
    float* onew = a.out + (size_t)MTOK * DM;
    const int gw = vcu * NWAVES + wave, NGW = G * NWAVES;
#define QK_SRC(it_) (P + (size_t)((it_) / 12) * DIN + ((it_) % 12) * 512 + lane * 8)
    for (int it = gw; it < MTOK * 12; it += 4 * NGW) {
        const int it1 = it + NGW, it2 = it + 2 * NGW, it3 = it + 3 * NGW;
        v4u r0, r1 = {0u, 0u, 0u, 0u}, r2 = {0u, 0u, 0u, 0u}, r3 = {0u, 0u, 0u, 0u};
        r0 = *(const GAS v4u*)QK_SRC(it);
        if (it1 < MTOK * 12) r1 = *(const GAS v4u*)QK_SRC(it1);
        if (it2 < MTOK * 12) r2 = *(const GAS v4u*)QK_SRC(it2);
        if (it3 < MTOK * 12) r3 = *(const GAS v4u*)QK_SRC(it3);
        qk_item(a, r0, it, lane, P, onew, c128, s128, c64, s64);
        if (it1 < MTOK * 12) qk_item(a, r1, it1, lane, P, onew, c128, s128, c64, s64);
        if (it2 < MTOK * 12) qk_item(a, r2, it2, lane, P, onew, c128, s128, c64, s64);
        if (it3 < MTOK * 12) qk_item(a, r3, it3, lane, P, onew, c128, s128, c64, s64);
    }
#undef QK_SRC
    __syncthreads();
}

__device__ __forceinline__ void attn_phase(const Args& a, unsigned char* lds_g, int G, int wave) {
    const int lane = fresh_tid() & 63;
    const bf16* P = (const bf16*)(a.ws + WS_P); bf16* O = (bf16*)(a.ws + WS_O);
    const bf16* KA_l = (const bf16*)(a.ws + WS_KVL); const bf16* VA_l = (const bf16*)(a.ws + WS_KVL + KVL_SZ); const bf16* KB_l = (const bf16*)(a.ws + WS_KVL + 2 * KVL_SZ); const bf16* VB_l = (const bf16*)(a.ws + WS_KVL + 3 * KVL_SZ);
    const bf16* KA_p = (const bf16*)(a.ws + WS_KVP); const bf16* VA_p = (const bf16*)(a.ws + WS_KVP + KVP_SZ); const bf16* KB_p = (const bf16*)(a.ws + WS_KVP + 2 * KVP_SZ); const bf16* VB_p = (const bf16*)(a.ws + WS_KVP + 3 * KVP_SZ);
    float* misc = (float*)(lds_g + att::LDS_MISC);
    if (wave == 0) { const float p1 = a.in[17][lane] * a.in[18][lane], p2 = a.in[19][lane] * a.in[20][lane];
        const float s1 = wave_sum(p1), s2 = wave_sum(p2); if (lane == 0) misc[0] = __expf(s1) - __expf(s2) + 0.2f; }
    __syncthreads();
    const float lam = misc[0];
    const int nper = G / 8;
    const int c = blockIdx.x, x = c % 8, j = c / 8;
    att::UnitArgs U;
#ifndef ATT_NO_MODE1
    for (int u = c; u < NB_S * 16 * 8 + NB_P * 16 * 2; u += G) {
        const bool lat = u < NB_S * 16 * 8; const int uu = lat ? u : u - NB_S * 16 * 8; const int i = uu / G;
        int gid, g, qb;
        if (lat) { if (G == 256) { gid = i * 8 + x; g = j >> 3; qb = j & 7; } else { gid = uu >> 5; g = (uu >> 3) & 3; qb = uu & 7; } }
        else     { if (G == 256) { gid = (i * 8 + x) * 4 + (j >> 3); g = (j >> 1) & 3; qb = j & 1; } else { gid = uu >> 3; g = (uu >> 1) & 3; qb = uu & 1; } }
        const int b = gid >> 2, kv = gid & 3, h = kv * 4 + g; const int m0 = lat ? M_P + b * T_S + qb * 128 : b * T_P + qb * 128;
        const size_t kvoff = lat ? (size_t)(b * 4 + kv) * KVL * 128 : (size_t)(b * 4 + kv) * T_P * 128;
        U.Qb = P + (size_t)m0 * DIN + 3072 + h * 128; U.ldq = DIN; U.Kh = (lat ? KB_l : KB_p) + kvoff; U.Vh = (lat ? VB_l : VB_p) + kvoff;
        U.Ob = O + (size_t)m0 * DM + 2048 + h * 128; U.ldo = DM; U.NT = lat ? KVL / 64 : T_P / 64; U.jwin = 1 << 30; U.wadd = 0; U.masked = 0; U.t0 = 0; U.sinkl2 = 0.f; U.lam = lam; U.subg = a.in[21];
        att::attn_unit<1>(U, (char*)lds_g);
    }
#endif
#ifndef ATT_NO_MODE0
    for (int u = c; u < NB_S * 16 * 4 + NB_P * 16; u += G) {
        const bool lat = u < NB_S * 16 * 4; const int uu = lat ? u : u - NB_S * 16 * 4; const int i = uu / G;
        int gid, g, qb2;
        if (lat) { if (G == 256) { gid = (i * 8 + x) * 2 + (j >> 4); g = (j >> 2) & 3; qb2 = j & 3; } else { gid = uu >> 4; g = (uu >> 2) & 3; qb2 = uu & 3; } }
        else     { if (G == 256) { gid = x * 8 + (j >> 2); g = j & 3; qb2 = 0; } else { gid = uu >> 2; g = uu & 3; qb2 = 0; } }
        const int b = gid >> 2, kv = gid & 3, h = kv * 4 + g; const int t0 = qb2 * 256, m0 = lat ? M_P + b * T_S + t0 : b * T_P;
        const int wstart = (t0 - 128 > 0) ? t0 - 128 : 0, wend = (t0 + 384 < T_S) ? t0 + 384 : T_S;
        const size_t kvoff = lat ? (size_t)(b * 4 + kv) * KVL * 128 : (size_t)(b * 4 + kv) * T_P * 128;
        U.Qb = P + (size_t)m0 * DIN + h * 128; U.ldq = DIN; U.Kh = (lat ? KA_l : KA_p) + kvoff; U.Vh = (lat ? VA_l : VA_p) + kvoff;
        U.Ob = O + (size_t)m0 * DM + h * 128; U.ldo = DM; U.NT = lat ? 8 + (wend - wstart) / 64 : T_P / 64; U.jwin = lat ? 8 : (1 << 30); U.wadd = lat ? wstart : 0; U.masked = lat ? 1 : 0; U.t0 = t0;
        U.sinkl2 = a.in[16][h] * att::LOG2E; U.lam = 0.f; U.subg = nullptr;
        att::attn_unit<0>(U, (char*)lds_g);
    }
#endif
    __syncthreads();
}


__device__ __forceinline__ void p0_phase(const Args& args, LAS unsigned char* ldsl, gu32* ctl, int qword, int vcu, int G, int wave) {
    const int lane = fresh_tid() & 63;
        LAS float* scr = (LAS float*)(ldsl + wave * 16384);
        if (wave < 3 && vcu * 3 + wave < 96 * KSPLIT && G == 256) p0_mod_item(args.in[6], args.in[7], args.in[8], (float*)(args.ws + WS_MODP), vcu * 3 + wave, lane);
        if (G != 256) { for (int it = vcu * NWAVES + wave; it < 96 * KSPLIT; it += G * NWAVES) p0_mod_item(args.in[6], args.in[7], args.in[8], (float*)(args.ws + WS_MODP), it, lane); }
        constexpr int I_IN = (DM / 64) * (DIN / 32), I_OUT = (DM / 64) * (DM / 32), I_FC1 = (DM / 64) * (DFF / 32), I_FC2 = (DFF / 64) * (DM / 32);
        constexpr int NITEMS = I_IN + I_OUT + I_FC1 + I_FC2;
        for (;;) {
            unsigned base = 0; if (lane == 0) base = __hip_atomic_fetch_add(ctl + qword, 4u, RLX_AGENT);
            base = __builtin_amdgcn_readfirstlane(base);
            if (base >= (unsigned)NITEMS) break;
            for (int q = 0; q < 4; ++q) { int r = (int)base + q; if (r >= NITEMS) break;
                if (r < I_IN) { p0_transpose_item(args.in[11], DM, DIN, (bf16*)(args.ws + WS_WIN), scr, r, lane); continue; } r -= I_IN;
                if (r < I_OUT) { p0_transpose_item(args.in[22], DM, DM, (bf16*)(args.ws + WS_WOUT), scr, r, lane); continue; } r -= I_OUT;
                if (r < I_FC1) { p0_transpose_item(args.in[24], DM, DFF, (bf16*)(args.ws + WS_WFC1), scr, r, lane); continue; } r -= I_FC1;
                p0_transpose_item(args.in[25], DFF, DM, (bf16*)(args.ws + WS_WFC2), scr, r, lane); }
        }
        for (int it = vcu * NWAVES + wave; it < 4 * 4096; it += G * NWAVES) {
            const int tsr = it >> 12, w = it & 4095; const size_t e = ((size_t)w * 64 + lane) * 8;
            const float* src = args.in[2 + tsr] + e; const f32x4 v0 = *(const GAS f32x4*)src, v1 = *(const GAS f32x4*)(src + 4);
            const int d = (int)(e & 127), kv = (int)((e >> 7) & 3), key = (int)((e >> 9) & 511), b = (int)(e >> 18);
            v4u o; o.x = pk2(v0.x, v0.y); o.y = pk2(v0.z, v0.w); o.z = pk2(v1.x, v1.y); o.w = pk2(v1.z, v1.w);
            *(GAS v4u*)((bf16*)(args.ws + WS_KVL + tsr * KVL_SZ) + ((size_t)(b * 4 + kv) * KVL + key) * 128 + d) = o; }
}
__device__ __forceinline__ void p2_phase(const Args& args, LAS unsigned char* ldsl, int G, int bx) {
    pg8::Gemm g{(const pg8::bf16_t*)(args.ws + WS_H), (const pg8::bf16_t*)(args.ws + WS_WIN), MTOK, DIN, DM}; pg8::StaticOrder S; S.init(MTOK, DIN, G, bx);
    pg8::EpiBf16<0> E{(pg8::bf16_t*)(args.ws + WS_P), DIN};
    pg8::gemm_phase<pg8::EpiBf16<0>, pg8::StaticOrder, true, true>(ldsl, g, S, E);
}
__device__ __forceinline__ void p5_phase(const Args& args, LAS unsigned char* ldsl, int G, int bx) {
    pg8::Gemm g{(const pg8::bf16_t*)(args.ws + WS_O), (const pg8::bf16_t*)(args.ws + WS_WOUT), MTOK, DM, DM}; pg8::StaticOrder S; S.init(MTOK, DM, G, bx);
    const float* modf = (const float*)(args.ws + WS_MODF);
    pg8::EpiResid E{args.in[0], args.in[1], args.out, DM, M_P / 256, modf + 2 * DM, NMOD, modf + (size_t)8 * NMOD + 2 * DM};
    pg8::gemm_phase<pg8::EpiResid, pg8::StaticOrder, true, true>(ldsl, g, S, E);
}
__device__ __forceinline__ void p7_phase(const Args& args, LAS unsigned char* ldsl, int G, int bx) {
    pg8::Gemm g{(const pg8::bf16_t*)(args.ws + WS_H), (const pg8::bf16_t*)(args.ws + WS_WFC1), MTOK, DFF, DM}; pg8::StaticOrder S; S.init(MTOK, DFF, G, bx);
    pg8::EpiBf16<1> E{(pg8::bf16_t*)(args.ws + WS_U), DFF};
    pg8::gemm_phase<pg8::EpiBf16<1>, pg8::StaticOrder, true, true>(ldsl, g, S, E);
}
__device__ __forceinline__ void p7_null_phase(const Args& args, LAS unsigned char* ldsl, int G, int bx) {
    pg8::Gemm g{(const pg8::bf16_t*)(args.ws + WS_H), (const pg8::bf16_t*)(args.ws + WS_WFC1), MTOK, DFF, DM}; pg8::StaticOrder S; S.init(MTOK, DFF, G, bx);
    pg8::EpiNull E{};
    pg8::gemm_phase<pg8::EpiNull, pg8::StaticOrder, true, true>(ldsl, g, S, E);
}
__device__ __forceinline__ void p8_null_phase(const Args& args, LAS unsigned char* ldsl, int G, int bx) {
    pg8::Gemm g{(const pg8::bf16_t*)(args.ws + WS_U), (const pg8::bf16_t*)(args.ws + WS_WFC2), MTOK, DM, DFF}; pg8::StaticOrder S; S.init(MTOK, DM, G, bx);
    pg8::EpiNull E{};
    pg8::gemm_phase<pg8::EpiNull, pg8::StaticOrder, true, true>(ldsl, g, S, E);
}
__device__ __forceinline__ void p8_phase(const Args& args, LAS unsigned char* ldsl, int G, int bx) {
    pg8::Gemm g{(const pg8::bf16_t*)(args.ws + WS_U), (const pg8::bf16_t*)(args.ws + WS_WFC2), MTOK, DM, DFF}; pg8::StaticOrder S; S.init(MTOK, DM, G, bx);
    const float* modf = (const float*)(args.ws + WS_MODF);
    pg8::EpiResid E{args.out, args.out + (size_t)M_P * DM, args.out, DM, M_P / 256, modf + 5 * DM, NMOD, modf + (size_t)8 * NMOD + 5 * DM};
    pg8::gemm_phase<pg8::EpiResid, pg8::StaticOrder, true, true>(ldsl, g, S, E);
}

__global__ void __launch_bounds__(NWAVES * 64, 2) fwd_kernel(Args args) {
    extern __shared__ __attribute__((aligned(16))) unsigned char lds[];
    LAS unsigned char* ldsl = (LAS unsigned char*)lds;
    volatile LAS unsigned* MISC = (volatile LAS unsigned*)(ldsl + MISC_OFF);
    const int tid = threadIdx.x, wave = __builtin_amdgcn_readfirstlane(tid >> 6);
    const int G = gridDim.x; const int bx = blockIdx.x; const int vcu = (G % 8 == 0) ? (bx % 8) * (G / 8) + bx / 8 : bx;
    gu32* ctl = (gu32*)(args.ws + WS_CTL);
    for (int u = tid; u < (LDS_BYTES - MISC_OFF) / 4; u += NWAVES * 64) ((LAS unsigned*)(ldsl + MISC_OFF))[u] = 0u;
    __syncthreads();
    XcdBarrier bar; bar.bar = (unsigned*)(ctl + CW_BAR); bar.x = 0; bar.st = nullptr;
    if (N_LAUNCHES == 1) bar = xcd_barrier_post((unsigned*)(ctl + CW_BAR), MISC + 8);
    const int lo = args.ph_lo, hi = args.ph_hi;
#ifndef PHASE_MASK
#define PHASE_MASK 0x1ff
#endif
#define IN(k) ((((PHASE_MASK) >> (k)) & 1) && lo <= (k) && (k) < hi)
#define SEAM(k) do { if (IN(k) && IN((k) + 1)) xcd_barrier(bar); } while (0)

#ifndef PROBE_REPEAT
#define PROBE_REPEAT (-1)
#endif
#if defined(PROBE_TIME)
    unsigned long long pt0 = 0, pt1 = 0;
#define PT_BEGIN(k) do { if (PROBE_TIME == (k)) pt0 = wall_clock64(); } while (0)
#define PT_END(k) do { if (PROBE_TIME == (k)) pt1 = wall_clock64(); } while (0)
#else
#define PT_BEGIN(k) do { } while (0)
#define PT_END(k) do { } while (0)
#endif
#define REP(k, call) do { if (PROBE_REPEAT == (k)) { call; xcd_barrier(bar); } } while (0)
    PT_BEGIN(0);
    if (IN(0)) p0_phase(args, ldsl, ctl, CW_Q, vcu, G, wave);
    SEAM(0); PT_END(0); REP(0, p0_phase(args, ldsl, ctl, CW_Q + 64, vcu, G, wave));
    PT_BEGIN(1);
    if (IN(1)) norm_phase<0>(args, ldsl, vcu, G, wave);
    SEAM(1); PT_END(1); REP(1, norm_phase<0>(args, ldsl, vcu, G, wave));
    PT_BEGIN(2);
    if (IN(2)) p2_phase(args, ldsl, G, bx);
    SEAM(2); PT_END(2); REP(2, p2_phase(args, ldsl, G, bx));
    PT_BEGIN(3);
    if (IN(3)) qk_phase(args, ldsl, vcu, G, wave);
    SEAM(3); PT_END(3);
    PT_BEGIN(4);
    if (IN(4)) attn_phase(args, lds, G, wave);
    SEAM(4); PT_END(4); REP(4, attn_phase(args, lds, G, wave));
    PT_BEGIN(5);
    if (IN(5)) p5_phase(args, ldsl, G, bx);
    SEAM(5); PT_END(5); REP(5, p5_phase(args, ldsl, G, bx));
    PT_BEGIN(6);
    if (IN(6)) norm_phase<1>(args, ldsl, vcu, G, wave);
    SEAM(6); PT_END(6); REP(6, norm_phase<1>(args, ldsl, vcu, G, wave));
#if defined(PROBE_CLOCK)
    unsigned long long pc0 = 0, pr0 = 0, pc1 = 0, pr1 = 0;
    if (PROBE_CLOCK == 7) { pc0 = clock64(); pr0 = wall_clock64(); }
#endif
    PT_BEGIN(7);
    if (IN(7)) p7_phase(args, ldsl, G, bx);
#if defined(PROBE_CLOCK)
    if (PROBE_CLOCK == 7) { pc1 = clock64(); pr1 = wall_clock64(); }
#endif
    SEAM(7); PT_END(7); REP(7, p7_phase(args, ldsl, G, bx)); REP(17, p7_null_phase(args, ldsl, G, bx)); REP(18, p8_null_phase(args, ldsl, G, bx));
    PT_BEGIN(8);
    if (IN(8)) p8_phase(args, ldsl, G, bx);
#if defined(PROBE_TIME)
    PT_END(8);
    if (bx == 0 && tid == 0) { const unsigned long long t0 = wall_clock64(); while (wall_clock64() - t0 < (pt1 - pt0)) __builtin_amdgcn_s_sleep(8); }
#endif
#if defined(PROBE_CLOCK)
    if (bx == 0 && tid == 0) {
        const unsigned long long ticks = (pc1 - pc0) * 1000ull / (pr1 - pr0);
        const unsigned long long t0 = wall_clock64(); while (wall_clock64() - t0 < ticks) __builtin_amdgcn_s_sleep(8);
    }
#endif
#undef REP
#undef IN
#undef SEAM
}

extern "C" void kernel_launch(void* const* d_in, const int* in_sizes, int n_in, void* d_out, int out_size, void* d_ws, size_t ws_size, hipStream_t stream) {
    static int grid = 0;
    if (grid == 0) {
        if (n_in != 26 || in_sizes[0] != M_P * DM || in_sizes[1] != M_S * DM || out_size != MTOK * DM + 4 * M_P * 512 || ws_size < WS_END) {
            fprintf(stderr, "kernel_launch: shape mismatch (n_in %d in0 %d in1 %d out %d ws %zu, need ws >= %zu); nothing launched\n", n_in, n_in > 0 ? in_sizes[0] : -1, n_in > 1 ? in_sizes[1] : -1, out_size, ws_size, (size_t)WS_END); grid = -1; return; }
        int dev = 0, cus = 0, per_cu = 0;
        if (hipGetDevice(&dev) != hipSuccess || hipDeviceGetAttribute(&cus, hipDeviceAttributeMultiprocessorCount, dev) != hipSuccess) { grid = -1; return; }
        if (hipFuncSetAttribute((const void*)fwd_kernel, hipFuncAttributeMaxDynamicSharedMemorySize, LDS_BYTES) != hipSuccess) { fprintf(stderr, "kernel_launch: hipFuncSetAttribute failed\n"); grid = -1; return; }
        if (hipOccupancyMaxActiveBlocksPerMultiprocessor(&per_cu, (const void*)fwd_kernel, NWAVES * 64, LDS_BYTES) != hipSuccess || per_cu < 1) { fprintf(stderr, "kernel_launch: occupancy query says %d blocks per CU\n", per_cu); }
        (void)hipGetLastError();
        grid = cus;
    }
    if (grid < 0) return;
    if (hipMemsetAsync((char*)d_ws + WS_CTL, 0, CTL_ZERO_BYTES, stream) != hipSuccess) return;
    Args a{};
    for (int i = 0; i < 26; ++i) a.in[i] = (const float*)d_in[i];
    a.out = (float*)d_out; a.ws = (unsigned char*)d_ws;
    if (N_LAUNCHES == 1) { a.ph_lo = 0; a.ph_hi = NPH; hipLaunchKernelGGL(fwd_kernel, dim3(grid), dim3(NWAVES * 64), LDS_BYTES, stream, a); }
    else { for (int p = 0; p < NPH; ++p) { a.ph_lo = p; a.ph_hi = p + 1; hipLaunchKernelGGL(fwd_kernel, dim3(grid), dim3(NWAVES * 64), LDS_BYTES, stream, a); } }
    const hipError_t le = hipPeekAtLastError();
    if (le != hipSuccess) fprintf(stderr, "kernel_launch: launch failed: %s\n", hipGetErrorName(le));
}
```

```cpp
#include <hip/hip_runtime.h>
#include <cstdio>
#include <cstdint>
namespace pg8 {
#define PG8_LAS __attribute__((address_space(3)))
typedef unsigned short bf16_t;
typedef short bf16x8 __attribute__((ext_vector_type(8)));
typedef float f32x4 __attribute__((ext_vector_type(4)));
typedef unsigned u32x4 __attribute__((ext_vector_type(4)));
constexpr int BM = 256, BK = 64, HALF = 128, HTB = HALF * BK * 2  , STAGE_BYTES = 8 * HTB, NXCD = 8, WGM = 8;

__host__ __device__ __forceinline__ int lds_byte(int r, int c) { const int st = (r >> 4) * 2 + (c >> 5), rr = r & 15, cc = c & 31, ob = rr * 64 + cc * 2; return st * 1024 + (ob ^ (((ob >> 9) & 1) << 5)); }
__host__ __device__ __forceinline__ void stage_rc(int b, int& R, int& C) { const int st = b / 1024, sb = b % 1024, swz = sb ^ (((sb >> 9) & 1) << 5); R = (st >> 1) * 16 + swz / 64; C = (st & 1) * 32 + (swz % 64) / 2; }
__host__ __device__ __forceinline__ int perm32(int rho) { const int n = rho >> 4, i = rho & 15; return 8 * (i >> 2) + 4 * n + (i & 3); }

struct Unit { int pm, pn; };
struct Gemm { const bf16_t* A; const bf16_t* Bt; int M, N, K; };

struct StaticOrder {
    int nM, nN, nwg, G, c;
    __host__ __device__ void init(int M, int N, int G_, int c_) { nM = M / BM; nN = N / BM; nwg = nM * nN; G = G_; c = c_; }
    __host__ __device__ bool next(int i, Unit& u) const {
        const long L = (long)i * G + c; if (L >= nwg) return false;
        int wgid = (int)L; { const int q = nwg / NXCD, r = nwg % NXCD, xcd = wgid % NXCD, off = wgid / NXCD; wgid = (xcd < r ? xcd * (q + 1) : r * (q + 1) + (xcd - r) * q) + off; }
        const int nig = WGM * nN, gid = wgid / nig, fm = gid * WGM, gsz = (nM - fm) < WGM ? (nM - fm) : WGM;
        u.pm = fm + ((wgid % nig) % gsz); u.pn = (wgid % nig) / gsz; return true;
    }
    __device__ __forceinline__ void a_ready(const Unit&) const {}
    __device__ __forceinline__ void done(const Unit&) const {}
};

__device__ __forceinline__ unsigned cvt_pk_bf16(float lo, float hi) { unsigned r; asm volatile("v_cvt_pk_bf16_f32 %0, %1, %2" : "=v"(r) : "v"(lo), "v"(hi)); return r; }

template <int ACT, bool NT = false> struct EpiBf16 {
    static constexpr bool PERM = true, AFTER_DRAIN = false;
    bf16_t* O; int ldc;
    __device__ __forceinline__ void operator()(const f32x4 (&acc)[2][2][4][2], const Unit& u, int wr, int wc, int fr, int fq) const {
        const int row0 = u.pm * BM + wr * 64 + fr; const int col0 = u.pn * BM + wc * 32 + 8 * fq;
#pragma unroll
        for (int ai = 0; ai < 2; ++ai)
#pragma unroll
            for (int m = 0; m < 4; ++m) { bf16_t* rowp = O + (size_t)(row0 + ai * HALF + m * 16) * ldc + col0;
#pragma unroll
                for (int bj = 0; bj < 2; ++bj) { f32x4 v0 = acc[ai][bj][m][0], v1 = acc[ai][bj][m][1];
                    if (ACT == 1) {
#pragma unroll
                        for (int j = 0; j < 4; ++j) { const float a = fmaxf(v0[j], 0.f), b = fmaxf(v1[j], 0.f); v0[j] = a * a; v1[j] = b * b; } }
                    u32x4 w; w.x = cvt_pk_bf16(v0[0], v0[1]); w.y = cvt_pk_bf16(v0[2], v0[3]); w.z = cvt_pk_bf16(v1[0], v1[1]); w.w = cvt_pk_bf16(v1[2], v1[3]);
                    if (NT) __builtin_nontemporal_store(w, (u32x4*)(rowp + bj * HALF)); else *(u32x4*)(rowp + bj * HALF) = w; } }
    }
};
struct EpiResid {
    static constexpr bool PERM = false, AFTER_DRAIN = false;
    const float* base0; const float* base1; float* out; int ldc; int split; const float* gate; int gate_stride; const float* gate_ctx;
    __device__ __forceinline__ void operator()(const f32x4 (&acc)[2][2][4][2], const Unit& u, int wr, int wc, int fr, int fq) const {
        const int rloc = wr * 64 + fr, col0 = u.pn * BM + wc * 32 + 4 * fq;
        const float* bt = (u.pm < split) ? base0 + (size_t)u.pm * BM * ldc : base1 + (size_t)(u.pm - split) * BM * ldc;
        const float* gv = (u.pm < split) ? gate_ctx : gate + (size_t)((u.pm - split) >> 2) * gate_stride;
        float* ot = out + (size_t)u.pm * BM * ldc;
        f32x4 g[2][2];
#pragma unroll
        for (int bj = 0; bj < 2; ++bj)
#pragma unroll
            for (int n = 0; n < 2; ++n) g[bj][n] = *(const f32x4*)(gv + col0 + bj * HALF + n * 16);
#pragma unroll
        for (int ai = 0; ai < 2; ++ai)
#pragma unroll
            for (int m = 0; m < 4; ++m) { const size_t off = (size_t)(rloc + ai * HALF + m * 16) * ldc + col0;
#pragma unroll
                for (int bj = 0; bj < 2; ++bj)
#pragma unroll
                    for (int n = 0; n < 2; ++n) { const f32x4 bs = *(const f32x4*)(bt + off + bj * HALF + n * 16); *(f32x4*)(ot + off + bj * HALF + n * 16) = bs + g[bj][n] * acc[ai][bj][m][n]; }
                asm volatile("" ::: "memory"); }
    }
};

struct EpiNull {
    static constexpr bool PERM = true, AFTER_DRAIN = false;
    __device__ __forceinline__ void operator()(const f32x4 (&acc)[2][2][4][2], const Unit& u, int wr, int wc, int fr, int fq) const {
#pragma unroll
        for (int ai = 0; ai < 2; ++ai)
#pragma unroll
            for (int bj = 0; bj < 2; ++bj)
#pragma unroll
                for (int m = 0; m < 4; ++m)
#pragma unroll
                    for (int n = 0; n < 2; ++n) asm volatile("" :: "v"(acc[ai][bj][m][n]));
    }
};

template <class Epi, class Sched, bool ALIGN_EPI = false, bool SP2 = false>
__device__ __forceinline__ void gemm_phase(PG8_LAS unsigned char* lds, const Gemm g, const Sched& S, const Epi& E) {
    int tid_ = threadIdx.x; asm volatile("" : "+v"(tid_));
    const int tid = tid_, wid = __builtin_amdgcn_readfirstlane(tid >> 6), lane = tid & 63, wr = wid >> 2, wc = wid & 3, fr = lane & 15, fq = lane >> 4;
    const int K = g.K, nt = K / BK;
    unsigned voffA[2], voffB[2];
#pragma unroll
    for (int i = 0; i < 2; ++i) { int R, C; stage_rc(tid * 16 + i * 8192, R, C); const int Rb = Epi::PERM ? ((R & ~31) + perm32(R & 31)) : R;
        voffA[i] = (unsigned)(R * K + C) * 2u; voffB[i] = (unsigned)(Rb * K + C) * 2u; }
    const size_t kstep = (size_t)(BK * 2);
    const size_t hstep = (size_t)HALF * K * 2;
    const size_t tstep = 2 * hstep;
    const unsigned ldsw = (unsigned)wid * 1024u;
    const int aoff = lds_byte(wr * 64 + fr, fq * 8), boff = lds_byte(wc * 32 + fr, fq * 8);
#define PG8_SA(b, h) (((b) * 2 + (h)) * HTB)
#define PG8_SB(b, h) ((4 + (b) * 2 + (h)) * HTB)
#define PG8_STAGE(bufoff, gbase, voff) do { _Pragma("unroll") for (int _i = 0; _i < 2; ++_i) \
        __builtin_amdgcn_global_load_lds((const unsigned*)((const char*)(gbase) + (voff)[_i]), (PG8_LAS unsigned*)(lds + (bufoff) + ldsw + _i * 8192), 16, 0, 0); } while (0)
#define PG8_LDA(dst, b, h) do { _Pragma("unroll") for (int m = 0; m < 4; ++m) _Pragma("unroll") for (int k = 0; k < 2; ++k) dst[m][k] = *(const PG8_LAS bf16x8*)(lds + PG8_SA(b, h) + aoff + m * 2048 + k * 1024); } while (0)
#define PG8_LDB(dst, b, h) do { _Pragma("unroll") for (int n = 0; n < 2; ++n) _Pragma("unroll") for (int k = 0; k < 2; ++k) dst[n][k] = *(const PG8_LAS bf16x8*)(lds + PG8_SB(b, h) + boff + n * 2048 + k * 1024); } while (0)
#define PG8_MMA(ai, bj, At, Bt) do { __builtin_amdgcn_s_setprio(1); _Pragma("unroll") for (int m = 0; m < 4; ++m) _Pragma("unroll") for (int n = 0; n < 2; ++n) _Pragma("unroll") for (int k = 0; k < 2; ++k) \
        acc[ai][bj][m][n] = __builtin_amdgcn_mfma_f32_16x16x32_bf16(Bt[n][k], At[m][k], acc[ai][bj][m][n], 0, 0, 0); __builtin_amdgcn_s_setprio(0); } while (0)
#define PG8_WAIT_V(n) asm volatile("s_waitcnt vmcnt(" #n ")" ::: "memory")
#define PG8_WAIT_L(n) asm volatile("s_waitcnt lgkmcnt(" #n ")" ::: "memory")
#define PG8_BAR __builtin_amdgcn_s_barrier()
#define PG8_SCHED __builtin_amdgcn_sched_barrier(0)
    Unit cur, nxt; int ui = 0;
    if (!S.next(0, cur)) return;
    f32x4 acc[2][2][4][2];
#pragma unroll
    for (int a = 0; a < 2; ++a)
#pragma unroll
        for (int b = 0; b < 2; ++b)
#pragma unroll
            for (int m = 0; m < 4; ++m)
#pragma unroll
                for (int n = 0; n < 2; ++n) acc[a][b][m][n] = (f32x4){0.f, 0.f, 0.f, 0.f};
    bf16x8 At[4][2], B0[2][2], B1[2][2];
    const char* cA = (const char*)g.A + (size_t)cur.pm * tstep; const char* cB = (const char*)g.Bt + (size_t)cur.pn * tstep;
    S.a_ready(cur);
    if constexpr (SP2) {
        PG8_STAGE(PG8_SB(0, 0), cB, voffB); PG8_STAGE(PG8_SB(0, 1), cB + hstep, voffB); PG8_STAGE(PG8_SA(0, 0), cA, voffA); PG8_STAGE(PG8_SA(0, 1), cA + hstep, voffA);
        if (wr == 1) PG8_BAR;
        PG8_WAIT_V(2); PG8_BAR;
        PG8_STAGE(PG8_SB(1, 0), cB + kstep, voffB); PG8_STAGE(PG8_SA(1, 0), cA + kstep, voffA); PG8_STAGE(PG8_SB(1, 1), cB + hstep + kstep, voffB);
        PG8_WAIT_V(6); PG8_BAR;
    } else {
        PG8_STAGE(PG8_SB(0, 0), cB, voffB); PG8_STAGE(PG8_SA(0, 0), cA, voffA); PG8_STAGE(PG8_SB(0, 1), cB + hstep, voffB); PG8_STAGE(PG8_SA(0, 1), cA + hstep, voffA);
        if (wr == 1) PG8_BAR;
        PG8_WAIT_V(4); PG8_BAR;
        PG8_STAGE(PG8_SB(1, 0), cB + kstep, voffB); PG8_STAGE(PG8_SA(1, 0), cA + kstep, voffA); PG8_STAGE(PG8_SB(1, 1), cB + hstep + kstep, voffB);
        PG8_WAIT_V(6); PG8_BAR;
    }
    for (;;) {
        const bool has_next = S.next(ui + 1, nxt);
        const char* nA = has_next ? (const char*)g.A + (size_t)nxt.pm * tstep : cA; const char* nB = has_next ? (const char*)g.Bt + (size_t)nxt.pn * tstep : cB;
        for (int t = 0; t < nt; t += 2) {
            const bool last = (t == nt - 2);
            const char* a1 = cA + (size_t)(t + 1) * kstep;
            const char* a2 = last ? nA : cA + (size_t)(t + 2) * kstep; const char* b2 = last ? nB : cB + (size_t)(t + 2) * kstep;
            const char* a3 = a2 + kstep; const char* b3 = b2 + kstep;
            if (last && has_next) S.a_ready(nxt);
            if constexpr (SP2) {
            PG8_LDB(B0, 0, 0); PG8_LDB(B1, 0, 1); PG8_SCHED; PG8_LDA(At, 0, 0); PG8_STAGE(PG8_SA(1, 1), a1 + hstep, voffA);
            PG8_WAIT_V(8); PG8_WAIT_L(0); PG8_BAR; PG8_MMA(0, 0, At, B0); PG8_MMA(0, 1, At, B1); PG8_BAR; PG8_SCHED;
            PG8_LDA(At, 0, 1); PG8_STAGE(PG8_SB(0, 0), b2, voffB); PG8_STAGE(PG8_SB(0, 1), b2 + hstep, voffB); PG8_STAGE(PG8_SA(0, 0), a2, voffA);
            PG8_WAIT_V(8); PG8_WAIT_L(0); PG8_BAR; PG8_MMA(1, 0, At, B0); PG8_MMA(1, 1, At, B1); PG8_BAR; PG8_SCHED;
            PG8_LDB(B0, 1, 0); PG8_LDB(B1, 1, 1); PG8_SCHED; PG8_LDA(At, 1, 0); PG8_STAGE(PG8_SA(0, 1), a2 + hstep, voffA);
            PG8_WAIT_V(8); PG8_WAIT_L(0); PG8_BAR; PG8_MMA(0, 0, At, B0); PG8_MMA(0, 1, At, B1); PG8_BAR; PG8_SCHED;
            PG8_LDA(At, 1, 1); PG8_STAGE(PG8_SB(1, 0), b3, voffB); PG8_STAGE(PG8_SB(1, 1), b3 + hstep, voffB); PG8_STAGE(PG8_SA(1, 0), a3, voffA);
            PG8_WAIT_V(8); PG8_WAIT_L(0); PG8_BAR; PG8_MMA(1, 0, At, B0); PG8_MMA(1, 1, At, B1); PG8_BAR; PG8_SCHED;
            } else {
            PG8_LDB(B0, 0, 0); PG8_SCHED; PG8_LDA(At, 0, 0); PG8_STAGE(PG8_SA(1, 1), a1 + hstep, voffA);
            PG8_WAIT_L(8); PG8_BAR; PG8_WAIT_L(0); PG8_MMA(0, 0, At, B0); PG8_BAR; PG8_SCHED;
            PG8_LDB(B1, 0, 1); PG8_STAGE(PG8_SB(0, 0), b2, voffB);
            PG8_BAR; PG8_WAIT_L(0); PG8_MMA(0, 1, At, B1); PG8_BAR;
            PG8_LDA(At, 0, 1); PG8_STAGE(PG8_SA(0, 0), a2, voffA);
            PG8_BAR; PG8_WAIT_L(0); PG8_MMA(1, 0, At, B0); PG8_BAR; PG8_SCHED;
            PG8_STAGE(PG8_SB(0, 1), b2 + hstep, voffB);
            PG8_WAIT_V(6); PG8_BAR; PG8_MMA(1, 1, At, B1); PG8_BAR;
            PG8_LDB(B0, 1, 0); PG8_SCHED; PG8_LDA(At, 1, 0); PG8_STAGE(PG8_SA(0, 1), a2 + hstep, voffA);
            PG8_WAIT_L(8); PG8_BAR; PG8_WAIT_L(0); PG8_MMA(0, 0, At, B0); PG8_BAR; PG8_SCHED;
            PG8_LDB(B1, 1, 1); PG8_STAGE(PG8_SB(1, 0), b3, voffB);
            PG8_BAR; PG8_WAIT_L(0); PG8_MMA(0, 1, At, B1); PG8_BAR;
            PG8_LDA(At, 1, 1); PG8_STAGE(PG8_SA(1, 0), a3, voffA);
            PG8_BAR; PG8_WAIT_L(0); PG8_MMA(1, 0, At, B0); PG8_BAR; PG8_SCHED;
            PG8_STAGE(PG8_SB(1, 1), b3 + hstep, voffB);
            PG8_WAIT_V(6); PG8_BAR; PG8_MMA(1, 1, At, B1); PG8_BAR;
            }
        }
        if constexpr (ALIGN_EPI) { if (wr == 0) PG8_BAR; }
        if constexpr (!Epi::AFTER_DRAIN) { E(acc, cur, wr, wc, fr, fq); S.done(cur); }
        if (!has_next) break;
#pragma unroll
        for (int a = 0; a < 2; ++a)
#pragma unroll
            for (int b = 0; b < 2; ++b)
#pragma unroll
                for (int m = 0; m < 4; ++m)
#pragma unroll
                    for (int n = 0; n < 2; ++n) acc[a][b][m][n] = (f32x4){0.f, 0.f, 0.f, 0.f};
        cur = nxt; cA = nA; cB = nB; ++ui;
        if constexpr (ALIGN_EPI) { if (wr == 1) PG8_BAR; }
    }
    PG8_WAIT_V(0);
    if constexpr (!ALIGN_EPI) { if (wr == 0) PG8_BAR; }
    PG8_BAR;
    if constexpr (Epi::AFTER_DRAIN) { E.fused(acc, cur, wr, wc, fr, fq, lds, wid, lane); S.done(cur); }
#undef PG8_SA
#undef PG8_SB
#undef PG8_STAGE
#undef PG8_LDA
#undef PG8_LDB
#undef PG8_MMA
#undef PG8_WAIT_V
#undef PG8_WAIT_L
#undef PG8_BAR
#undef PG8_SCHED
}
}
namespace att {
#ifdef ATT_NOMASK
constexpr bool defined_NOMASK = true;
#else
constexpr bool defined_NOMASK = false;
#endif
typedef unsigned short bf16_t;
using bf16x8 = __attribute__((ext_vector_type(8))) short;
using s16x4  = __attribute__((ext_vector_type(4))) short;
using f32x16 = __attribute__((ext_vector_type(16))) float;
using u32x4  = __attribute__((ext_vector_type(4))) unsigned;
constexpr int KVBLK = 64;
constexpr int SHM_V = 16384, SHM_K = 16384;
constexpr int LDS_WS = 2 * SHM_V + 2 * SHM_K;
constexpr int LDS_X = LDS_WS + 8 * 64 * 4;
constexpr int LDS_MISC = LDS_X + 4 * 32 * 128 * 4;
constexpr int LDS_BYTES = LDS_MISC + 64;
constexpr float LOG2E = 1.4426950408889634f;
#define GASQ __attribute__((address_space(1)))
#define KSWZ(row, colB) ((row) * 256 + ((colB) ^ (((row) & 7) << 4)))
#define SBAR() __builtin_amdgcn_sched_barrier(0)
__device__ __forceinline__ int crow(int r, int hi) { return (r & 3) + 8 * (r >> 2) + 4 * hi; }
__device__ __forceinline__ unsigned cvtpk(float lo, float hi) { unsigned r; asm volatile("v_cvt_pk_bf16_f32 %0, %1, %2" : "=v"(r) : "v"(lo), "v"(hi)); return r; }

#ifndef ATT_SDEPTH0
#define ATT_SDEPTH0 1
#endif
#ifndef ATT_QLDS0
#define ATT_QLDS0 1
#endif
template <int MODE> struct Cfg {
    static constexpr float SCALE = (MODE == 0) ? 0.088388347648318440f : 0.125f;
    static constexpr float C = SCALE * LOG2E;
    static constexpr float THRS = 8.f / SCALE;
    static constexpr int ND0 = (MODE == 0) ? 8 : 4;
    static constexpr int SDEPTH = (MODE == 0) ? ATT_SDEPTH0 : 2;
    static constexpr bool QLDS = (MODE == 0) && (ATT_QLDS0 != 0);
};

template <int MODE>
__device__ __forceinline__ void partialSM(f32x16& p0, f32x16& p1, float& m_reg, float& mn, float& alpha) {
  constexpr float C = Cfg<MODE>::C;
  float pmax = p0[0];
#pragma unroll
  for (int r = 1; r < 16; ++r) pmax = fmaxf(pmax, p0[r]);
#pragma unroll
  for (int r = 0; r < 16; ++r) pmax = fmaxf(pmax, p1[r]);
  { auto rr = __builtin_amdgcn_permlane32_swap(__float_as_uint(pmax), __float_as_uint(pmax), false, false);
    pmax = fmaxf(__uint_as_float(rr[0]), __uint_as_float(rr[1])); }
  if (__builtin_expect(__all(pmax - m_reg <= Cfg<MODE>::THRS), 1)) { mn = m_reg; alpha = 1.f; }
  else { mn = fmaxf(m_reg, pmax); alpha = __builtin_amdgcn_exp2f((m_reg - mn) * C); m_reg = mn; }
  const float mnC = -mn * C;
#pragma unroll
  for (int r = 0; r < 16; ++r) p0[r] = fmaf(p0[r], C, mnC);
#pragma unroll
  for (int r = 0; r < 16; ++r) p1[r] = fmaf(p1[r], C, mnC);
#pragma unroll
  for (int r = 0; r < 16; ++r) p0[r] = __builtin_amdgcn_exp2f(p0[r]);
}
__device__ __forceinline__ void finishSM(f32x16& p0, f32x16& p1, float alpha, float& l_reg, bf16x8& pa0, bf16x8& pa1, bf16x8& pa2, bf16x8& pa3) {
#pragma unroll
  for (int r = 0; r < 16; ++r) p1[r] = __builtin_amdgcn_exp2f(p1[r]);
  float ps = 0;
#pragma unroll
  for (int r = 0; r < 16; ++r) ps += p0[r];
#pragma unroll
  for (int r = 0; r < 16; ++r) ps += p1[r];
  { auto rr = __builtin_amdgcn_permlane32_swap(__float_as_uint(ps), __float_as_uint(ps), false, false);
    ps = __uint_as_float(rr[0]) + __uint_as_float(rr[1]); }
  l_reg = l_reg * alpha + ps;
#define PK4(P, BASE, OUT) do { unsigned a0 = cvtpk(P[BASE + 0], P[BASE + 1]), a1 = cvtpk(P[BASE + 2], P[BASE + 3]);   \
    unsigned b0 = cvtpk(P[BASE + 4], P[BASE + 5]), b1 = cvtpk(P[BASE + 6], P[BASE + 7]);                              \
    auto r0 = __builtin_amdgcn_permlane32_swap(a0, b0, false, false); auto r1 = __builtin_amdgcn_permlane32_swap(a1, b1, false, false); \
    u32x4 w = {r0[0], r1[0], r0[1], r1[1]}; OUT = *reinterpret_cast<bf16x8*>(&w); } while (0)
  PK4(p0, 0, pa0); PK4(p0, 8, pa1); PK4(p1, 0, pa2); PK4(p1, 8, pa3);
#undef PK4
}
template <int MODE, bool QLDS>
__device__ __forceinline__ void qkt(f32x16& p0, f32x16& p1, const char* Ks, const bf16x8* qr, const char* qs, int r32, int hi, int comp) {
  p0 = f32x16{}; p1 = f32x16{};
  int rb = r32; asm volatile("" : "+v"(rb));
  const int swz = (rb & 7) << 4, rowb = rb * 256 + comp * 128;
  const char* a0 = Ks + rowb + ((0 * 32 + hi * 16) ^ swz); const char* a1 = Ks + rowb + ((1 * 32 + hi * 16) ^ swz);
  const char* a2 = Ks + rowb + ((2 * 32 + hi * 16) ^ swz); const char* a3 = Ks + rowb + ((3 * 32 + hi * 16) ^ swz);
#pragma unroll
  for (int d0 = 0; d0 < Cfg<MODE>::ND0; ++d0) { const int dl = d0 & 3, dh = d0 >> 2; const char* ap = (dl == 0 ? a0 : dl == 1 ? a1 : dl == 2 ? a2 : a3) + dh * 128;
    bf16x8 b0 = *reinterpret_cast<const bf16x8*>(ap);
    bf16x8 b1 = *reinterpret_cast<const bf16x8*>(ap + 8192);
    bf16x8 q; if constexpr (QLDS) q = *reinterpret_cast<const bf16x8*>(qs + d0 * 1024); else q = qr[d0];
    p0 = __builtin_amdgcn_mfma_f32_32x32x16_bf16(b0, q, p0, 0, 0, 0);
    p1 = __builtin_amdgcn_mfma_f32_32x32x16_bf16(b1, q, p1, 0, 0, 0); }
}
__device__ __forceinline__ int v_st(int k, int c) { const int kk = (k & ~0xC) | ((k & 4) << 1) | ((k & 8) >> 1); return ((kk >> 3) * 4 + (c >> 5)) * 512 + ((kk & 7) * 32 + (c & 31)) * 2; }
__device__ __forceinline__ int v_rd_base(int lane) { return ((lane & 3) << 3) | (((lane >> 2) & 3) << 6) | (((lane >> 4) & 1) << 5) | (((lane >> 5) & 1) << 8); }
constexpr int v_rd_off(int d0, int ks, int half) { return d0 * 512 + ks * 4096 + half * 2048; }
template <int OFF> __device__ __forceinline__ s16x4 tr_read(int vb) {
  s16x4 r; asm volatile("ds_read_b64_tr_b16 %0, %1 offset:%2" : "=&v"(r) : "v"(vb), "i"(OFF) : "memory"); return r;
}
template <int D0> __device__ __forceinline__ void pv_one(f32x16& od, int vb, bf16x8 pa0, bf16x8 pa1, bf16x8 pa2, bf16x8 pa3) {
  const s16x4 l0 = tr_read<v_rd_off(D0, 0, 0)>(vb), h0 = tr_read<v_rd_off(D0, 0, 1)>(vb), l1 = tr_read<v_rd_off(D0, 1, 0)>(vb), h1 = tr_read<v_rd_off(D0, 1, 1)>(vb);
  const s16x4 l2 = tr_read<v_rd_off(D0, 2, 0)>(vb), h2 = tr_read<v_rd_off(D0, 2, 1)>(vb), l3 = tr_read<v_rd_off(D0, 3, 0)>(vb), h3 = tr_read<v_rd_off(D0, 3, 1)>(vb);
  asm volatile("s_waitcnt lgkmcnt(0)" ::: "memory"); SBAR();
#define PK(L, H) (bf16x8){L[0], L[1], L[2], L[3], H[0], H[1], H[2], H[3]}
  od = __builtin_amdgcn_mfma_f32_32x32x16_bf16(pa0, PK(l0, h0), od, 0, 0, 0);
  od = __builtin_amdgcn_mfma_f32_32x32x16_bf16(pa1, PK(l1, h1), od, 0, 0, 0);
  od = __builtin_amdgcn_mfma_f32_32x32x16_bf16(pa2, PK(l2, h2), od, 0, 0, 0);
  od = __builtin_amdgcn_mfma_f32_32x32x16_bf16(pa3, PK(l3, h3), od, 0, 0, 0);
#undef PK
}
__device__ __forceinline__ void pv_d0(f32x16* o, int vb, bf16x8 pa0, bf16x8 pa1, bf16x8 pa2, bf16x8 pa3) {
  pv_one<0>(o[0], vb, pa0, pa1, pa2, pa3); pv_one<1>(o[1], vb, pa0, pa1, pa2, pa3); pv_one<2>(o[2], vb, pa0, pa1, pa2, pa3); pv_one<3>(o[3], vb, pa0, pa1, pa2, pa3);
}

struct UnitArgs {
    const bf16_t* Qb; int ldq;
    const bf16_t* Kh; const bf16_t* Vh;
    bf16_t* Ob; int ldo;
    int NT;
    int jwin, wadd;
    int masked, t0;
    float sinkl2;
    float lam;
    const float* subg;
};

template <int MODE>
__device__ __forceinline__ void attn_unit(const UnitArgs& A, char* lds) {
  constexpr float C = Cfg<MODE>::C; constexpr int ND0 = Cfg<MODE>::ND0;
  int tid_ = threadIdx.x; asm volatile("" : "+v"(tid_));
  const int tid = tid_, wid = tid >> 6, lane = tid & 63, r32 = lane & 31, hi = lane >> 5;
  const int wq = (MODE == 0) ? wid : (wid & 3), comp = (MODE == 0) ? 0 : (wid >> 2);
  char* V_lds = lds; char* K_lds = lds + 2 * SHM_V;
  float* ws = (float*)(lds + LDS_WS) + wid * 64; float* li_l = ws; float* al_l = ws + 32;
  constexpr bool QLDS = Cfg<MODE>::QLDS;
  __syncthreads();
  float m_reg = -1e30f, l_reg = 0; f32x16 o[4] = {}; bf16x8 qr[QLDS ? 1 : ND0];
  char* qs = lds + LDS_X + wid * 8192 + lane * 16;
  const bf16_t* Qw = A.Qb + (long)(wq * 32 + r32) * A.ldq + comp * 64 + hi * 8;
  if constexpr (QLDS) {
#pragma unroll
    for (int d0 = 0; d0 < ND0; ++d0) *reinterpret_cast<bf16x8*>(qs + d0 * 1024) = *reinterpret_cast<const bf16x8*>(Qw + d0 * 16);
  } else {
#pragma unroll
    for (int d0 = 0; d0 < ND0; ++d0) qr[d0] = *reinterpret_cast<const bf16x8*>(Qw + d0 * 16);
  }
  const int sr = tid >> 4, sc = (tid & 15) * 8, vst0 = v_st(sr, sc), vst1 = v_st(32 + sr, sc);
  const int vb0 = (int)(uintptr_t)V_lds + v_rd_base(lane);
  const unsigned loff0 = (unsigned)(sr * 128 + sc) * 2u, loff1 = loff0 + 32u * 256u;
  const bf16_t* Kh = A.Kh; const bf16_t* Vh = A.Vh; const int NT = A.NT, jwin = A.jwin, wadd = A.wadd;
  constexpr int SDEPTH = Cfg<MODE>::SDEPTH;
  struct { bf16x8 vs0, vs1, ks0, ks1; } sr_[SDEPTH];
#define KOFF(j) (64 * (j) + (((j) >= jwin) ? wadd : 0))
#define SLOAD(i, k0) do { const size_t _kb = (size_t)(k0) * 256; const char* _vp = (const char*)Vh + _kb; const char* _kp = (const char*)Kh + _kb; \
    sr_[i].vs0 = *(const GASQ bf16x8*)(_vp + loff0); sr_[i].vs1 = *(const GASQ bf16x8*)(_vp + loff1); \
    sr_[i].ks0 = *(const GASQ bf16x8*)(_kp + loff0); sr_[i].ks1 = *(const GASQ bf16x8*)(_kp + loff1); } while (0)
#define SWRITE(b, i) do { *(bf16x8*)(V_lds + (b) * SHM_V + vst0) = sr_[i].vs0;          \
    *(bf16x8*)(V_lds + (b) * SHM_V + vst1) = sr_[i].vs1; const int kc = sc * 2;               \
    *(bf16x8*)(K_lds + (b) * SHM_K + KSWZ(sr, kc)) = sr_[i].ks0;                       \
    *(bf16x8*)(K_lds + (b) * SHM_K + KSWZ(32 + sr, kc)) = sr_[i].ks1; } while (0)
#define SWAIT() do { if constexpr (SDEPTH == 2) asm volatile("s_waitcnt vmcnt(4)" ::: "memory"); else asm volatile("s_waitcnt vmcnt(0)" ::: "memory"); } while (0)
#define RESC(a) do { if (__any((a) < 1.f)) { if (hi == 0) al_l[r32] = (a); asm volatile("s_waitcnt lgkmcnt(0)" ::: "memory"); \
    _Pragma("unroll") for (int d = 0; d < 4; ++d) _Pragma("unroll") for (int r = 0; r < 16; ++r) o[d][r] *= al_l[crow(r, hi)]; } } while (0)
#define MASKT(P0, P1, j) do { if (MODE == 0 && !defined_NOMASK && A.masked && (j) >= jwin) { const int kp0 = KOFF(j) - 512, qw0 = A.t0 + wq * 32; \
    if (kp0 < qw0 + 31 - 128 || kp0 + 63 > qw0 + 128) { const int dkb = kp0 - qw0 - r32 + 4 * hi + 128; \
      _Pragma("unroll") for (int r = 0; r < 16; ++r) { const int cr = (r & 3) + 8 * (r >> 2); if ((unsigned)(dkb + cr) > 256u) P0[r] = -1e30f; if ((unsigned)(dkb + cr + 32) > 256u) P1[r] = -1e30f; } } } } while (0)
  f32x16 pA0, pA1, pB0, pB1; float mnA, mnB, alA, alB; bf16x8 pa0, pa1, pa2, pa3;
  constexpr int SE = 0, SO = SDEPTH - 1;
  SLOAD(SE, KOFF(0)); asm volatile("s_waitcnt vmcnt(0)" ::: "memory"); SWRITE(0, SE); __syncthreads();
  qkt<MODE, QLDS>(pA0, pA1, K_lds, qr, qs, r32, hi, comp); MASKT(pA0, pA1, 0); partialSM<MODE>(pA0, pA1, m_reg, mnA, alA);
  SLOAD(SO, KOFF(1)); if constexpr (SDEPTH == 2) { if (2 < NT) SLOAD(SE, KOFF(2)); }
  SWAIT(); SWRITE(1, SO); __syncthreads();
  for (int j = 1; j + 1 < NT; j += 2) {
    SBAR(); qkt<MODE, QLDS>(pB0, pB1, K_lds + SHM_K, qr, qs, r32, hi, comp);
    finishSM(pA0, pA1, alA, l_reg, pa0, pa1, pa2, pa3); SBAR();
    SLOAD(SO, KOFF(j + SDEPTH)); SBAR();
    pv_d0(o, vb0, pa0, pa1, pa2, pa3); MASKT(pB0, pB1, j); partialSM<MODE>(pB0, pB1, m_reg, mnB, alB);
    __syncthreads(); SWAIT(); SWRITE(0, SE);
    RESC(alB); __syncthreads();
    SBAR(); qkt<MODE, QLDS>(pA0, pA1, K_lds, qr, qs, r32, hi, comp);
    finishSM(pB0, pB1, alB, l_reg, pa0, pa1, pa2, pa3); SBAR();
    if (SDEPTH == 1 || j + 3 < NT) SLOAD(SE, KOFF(j + 1 + SDEPTH)); SBAR();
    pv_d0(o, vb0 + SHM_V, pa0, pa1, pa2, pa3); MASKT(pA0, pA1, j + 1); partialSM<MODE>(pA0, pA1, m_reg, mnA, alA);
    __syncthreads(); SWAIT(); SWRITE(1, SO);
    RESC(alA); __syncthreads();
  }
  SBAR(); qkt<MODE, QLDS>(pB0, pB1, K_lds + SHM_K, qr, qs, r32, hi, comp);
  finishSM(pA0, pA1, alA, l_reg, pa0, pa1, pa2, pa3); SBAR();
  pv_d0(o, vb0, pa0, pa1, pa2, pa3); MASKT(pB0, pB1, NT - 1); partialSM<MODE>(pB0, pB1, m_reg, mnB, alB);
  __syncthreads(); RESC(alB);
  finishSM(pB0, pB1, alB, l_reg, pa0, pa1, pa2, pa3); SBAR();
  pv_d0(o, vb0 + SHM_V, pa0, pa1, pa2, pa3);
  if (MODE == 0) l_reg += __builtin_amdgcn_exp2f(A.sinkl2 - m_reg * C);
  if (hi == 0) li_l[r32] = l_reg;
  asm volatile("s_waitcnt lgkmcnt(0)" ::: "memory");
  float rli[16];
#pragma unroll
  for (int r = 0; r < 16; ++r) rli[r] = __builtin_amdgcn_rcpf(li_l[crow(r, hi)]);
  bf16_t* Ow = A.Ob + (long)(wq * 32) * A.ldo;
  const int odd = lane & 1;
  if (MODE == 0) {
#pragma unroll
    for (int d0 = 0; d0 < 4; ++d0)
#pragma unroll
      for (int rp = 0; rp < 8; ++rp) {
        const float a = o[d0][2 * rp] * rli[2 * rp], b = o[d0][2 * rp + 1] * rli[2 * rp + 1];
        const float send = odd ? a : b; const float recv = __shfl_xor(send, 1);
        const float lo = odd ? recv : a, hh = odd ? b : recv;
        const int row = crow(2 * rp + odd, hi);
        *(unsigned*)(Ow + (long)row * A.ldo + d0 * 32 + (r32 & ~1)) = cvtpk(lo, hh);
      }
  } else {
    float* X = (float*)(lds + LDS_X) + wq * (32 * 128);
    if (comp == 1) {
      const float lam = A.lam;
#pragma unroll
      for (int d0 = 0; d0 < 4; ++d0)
#pragma unroll
        for (int r = 0; r < 16; ++r) X[crow(r, hi) * 128 + d0 * 32 + r32] = o[d0][r] * rli[r] * lam;
    }
    __syncthreads();
    if (comp == 0) {
      float rs[16];
#pragma unroll
      for (int r = 0; r < 16; ++r) { float ss = 0.f;
#pragma unroll
        for (int d0 = 0; d0 < 4; ++d0) { const float v = o[d0][r] * rli[r] - X[crow(r, hi) * 128 + d0 * 32 + r32]; o[d0][r] = v; ss += v * v; }
        ss += __shfl_xor(ss, 1); ss += __shfl_xor(ss, 2); ss += __shfl_xor(ss, 4); ss += __shfl_xor(ss, 8); ss += __shfl_xor(ss, 16);
        rs[r] = __builtin_amdgcn_rsqf(ss * (1.f / 128.f) + 1e-6f) * 0.8f; }
#pragma unroll
      for (int d0 = 0; d0 < 4; ++d0) { const float g = A.subg[d0 * 32 + r32];
#pragma unroll
        for (int rp = 0; rp < 8; ++rp) {
          const float a = o[d0][2 * rp] * rs[2 * rp] * g, b = o[d0][2 * rp + 1] * rs[2 * rp + 1] * g;
          const float send = odd ? a : b; const float recv = __shfl_xor(send, 1);
          const float lo = odd ? recv : a, hh = odd ? b : recv;
          const int row = crow(2 * rp + odd, hi);
          *(unsigned*)(Ow + (long)row * A.ldo + d0 * 32 + (r32 & ~1)) = cvtpk(lo, hh);
        } }
    }
  }
#undef KOFF
#undef SLOAD
#undef SWRITE
#undef SWAIT
#undef RESC
#undef MASKT
}
#undef KSWZ
#undef GASQ
#undef SBAR
}

#define GAS __attribute__((address_space(1)))
#define LAS __attribute__((address_space(3)))
typedef unsigned short bf16;
typedef unsigned v4u __attribute__((ext_vector_type(4)));
typedef float f32x4 __attribute__((ext_vector_type(4)));
typedef short bf16x8 __attribute__((ext_vector_type(8)));
typedef GAS unsigned gu32;
typedef GAS unsigned long long gu64;
#define RLX_AGENT __ATOMIC_RELAXED, __HIP_MEMORY_SCOPE_AGENT
#define LDS_WAIT() asm volatile("s_waitcnt lgkmcnt(0)" ::: "memory")
#define VM_WAIT() asm volatile("s_waitcnt vmcnt(0)" ::: "memory")
__device__ __forceinline__ unsigned long long rt() { return __builtin_amdgcn_s_memrealtime(); }
__device__ __forceinline__ unsigned f2bf(float f) { unsigned u = __builtin_bit_cast(unsigned, f); return (u + 0x7fffu + ((u >> 16) & 1u)) >> 16; }
__device__ __forceinline__ unsigned pk2(float lo, float hi) { return f2bf(lo) | (f2bf(hi) << 16); }

#define XB_TMO      128
#define XB_XCNT(j)  (256  + 64 * (j))
#define XB_XSUB(j)  (1280 + 64 * (j))
#define XB_XGEN(j)  (2304 + 64 * (j))
#define XB_TOP      3328
#define XB_TOPGEN   3392
#define XCD_BAR_WORDS 3456
#define XB_SPIN_CAP (1u << 18)

__device__ __forceinline__ unsigned xb_ld(unsigned* p)              { return __hip_atomic_load(p, __ATOMIC_RELAXED, __HIP_MEMORY_SCOPE_AGENT); }
__device__ __forceinline__ unsigned xb_add(unsigned* p, unsigned v) { return __hip_atomic_fetch_add(p, v, __ATOMIC_RELAXED, __HIP_MEMORY_SCOPE_AGENT); }
__device__ __forceinline__ unsigned xb_xcc_id() { return (unsigned)__builtin_amdgcn_s_getreg((3 << 11) | 20) & 0xFu; }
#define XB_SPIN(cond, bar) do { unsigned _sp = 0; while (cond) { __builtin_amdgcn_s_sleep(1); \
    if ((++_sp & 255u) == 0u) { if (xb_ld(&(bar)[XB_TMO])) break; if (_sp > XB_SPIN_CAP) { atomicAdd(&(bar)[XB_TMO], 1u); break; } } } } while (0)

struct XcdBarrier {
    unsigned* bar; unsigned x;
    volatile LAS unsigned* st;
};

__device__ __forceinline__ XcdBarrier xcd_barrier_post(unsigned* bar, volatile LAS unsigned* st) {
    XcdBarrier b; b.bar = bar; b.x = xb_xcc_id(); b.st = st;
    if (threadIdx.x == 0) (void)xb_add(&bar[XB_XCNT(b.x)], 1u);
    return b;
}
__device__ __forceinline__ void xcd_barrier_complete(unsigned* bar, unsigned x, unsigned& nloc, unsigned& nx) {
    const unsigned G = gridDim.x * gridDim.y * gridDim.z;
    unsigned sum, cnt, mine, sp = 0u;
    for (;;) {
        sum = 0u; cnt = 0u; mine = 0u;
#pragma unroll
        for (unsigned j = 0; j < 16; ++j) { const unsigned c = xb_ld(&bar[XB_XCNT(j)]); sum += c; cnt += (c > 0u) ? 1u : 0u; mine = (j == x) ? c : mine; }
        if (sum == G) break;
        __builtin_amdgcn_s_sleep(1);
        if ((++sp & 255u) == 0u) { if (xb_ld(&bar[XB_TMO])) break; if (sp > XB_SPIN_CAP) { atomicAdd(&bar[XB_TMO], 1u); break; } }
    }
    nloc = mine > 0u ? mine : 1u; nx = cnt > 0u ? cnt : 1u;
}

__device__ __forceinline__ void xcd_barrier(const XcdBarrier& b) {
    asm volatile("s_waitcnt vmcnt(0)" ::: "memory");
    __syncthreads();
    if (threadIdx.x == 0) {
        unsigned* bar = b.bar;
        __builtin_amdgcn_s_waitcnt(0);
        unsigned nloc = b.st[0], nx = b.st[1];
        if (nloc == 0u) { xcd_barrier_complete(bar, b.x, nloc, nx); b.st[0] = nloc; b.st[1] = nx; }
        const unsigned old = xb_add(&bar[XB_XSUB(b.x)], 1u);
        const unsigned gen = old / nloc;
        if (old + 1u == (gen + 1u) * nloc) {
            __builtin_amdgcn_fence(__ATOMIC_RELEASE, "agent");
            asm volatile("s_waitcnt vmcnt(0)" ::: "memory");
            const unsigned og = xb_add(&bar[XB_TOP], 1u);
            const unsigned tg = og / nx;
            if (og + 1u == (tg + 1u) * nx) xb_add(&bar[XB_TOPGEN], 1u);
            else XB_SPIN(xb_ld(&bar[XB_TOPGEN]) == tg, bar);
            __builtin_amdgcn_fence(__ATOMIC_ACQUIRE, "agent");
            xb_add(&bar[XB_XGEN(b.x)], 1u);
            asm volatile("s_waitcnt vmcnt(0)" ::: "memory");
        } else {
            XB_SPIN(xb_ld(&bar[XB_XGEN(b.x)]) == gen, bar);
            __builtin_amdgcn_fence(__ATOMIC_ACQUIRE, "agent");
            asm volatile("s_waitcnt vmcnt(0)" ::: "memory");
        }
    }
    __syncthreads();
}
#ifndef MK_N_LAUNCHES
#define MK_N_LAUNCHES 1
#endif
constexpr int NPH = 9;
constexpr int N_LAUNCHES = MK_N_LAUNCHES;
constexpr int NWAVES = 8;

constexpr int DM = 4096, DIN = 6144, DFF = 16384, NMOD = 6 * DM;
constexpr int NB_P = 16, T_P = 256, NB_S = 8, T_S = 1024, LCTX = 512;
constexpr int M_P = NB_P * T_P, M_S = NB_S * T_S, MTOK = M_P + M_S;
constexpr int KSPLIT = 8;
constexpr int KVL = LCTX + T_S;
constexpr float EPS = 1e-6f;

constexpr size_t MiB = 1u << 20;
constexpr size_t WS_CTL = 0, CTL_ZERO_BYTES = 1 * MiB;
constexpr size_t WS_MODP = 1 * MiB;
constexpr size_t WS_MODF = 8 * MiB;
constexpr size_t WS_WIN = 16 * MiB, WS_WOUT = 64 * MiB, WS_WFC1 = 96 * MiB, WS_WFC2 = 224 * MiB;
constexpr size_t WS_H = 352 * MiB;
constexpr size_t WS_P = 448 * MiB;
constexpr size_t WS_O = 592 * MiB;
constexpr size_t WS_KVL = 688 * MiB, KVL_SZ = (size_t)NB_S * 4 * KVL * 128 * 2;
constexpr size_t WS_KVP = 736 * MiB, KVP_SZ = (size_t)NB_P * 4 * T_P * 128 * 2;
constexpr size_t WS_U = 752 * MiB;
constexpr size_t WS_END = 1136 * MiB;
static_assert(WS_MODP + (size_t)KSPLIT * 9 * NMOD * 4 <= WS_MODF && WS_MODF + (size_t)9 * NMOD * 4 <= WS_WIN, "ws map");
static_assert(KVL_SZ == 12 * MiB && KVP_SZ == 4 * MiB && WS_U + (size_t)MTOK * DFF * 2 == WS_END, "ws map");
constexpr int CW_Q = 64;
constexpr int CW_BAR = 4096;

constexpr int RING_BYTES = 131072;
constexpr int MISC_OFF = 143360;
constexpr int LDS_BYTES = 147456;
static_assert(att::LDS_BYTES <= MISC_OFF && RING_BYTES <= MISC_OFF && MISC_OFF + 128 <= LDS_BYTES, "LDS map");

__device__ __forceinline__ float wave_sum(float v) {
#pragma unroll
    for (int o = 1; o < 64; o <<= 1) v += __shfl_xor(v, o);
    return v;
}
__device__ __forceinline__ float bf2f(unsigned short b) { return __uint_as_float(((unsigned)b) << 16); }

__device__ __forceinline__ int fresh_tid() { int t = threadIdx.x; asm volatile("" : "+v"(t)); return t; }
struct Args { const float* in[26]; float* out; unsigned char* ws; int ph_lo, ph_hi; };

__device__ __forceinline__ void p0_transpose_item(const float* W, int K, int N, bf16* WT, LAS float* scr, int item, int lane) {
    const int nblk = N / 32, kb = item / nblk, nb = item % nblk, k0 = 64 * kb, n0 = 32 * nb;
#pragma unroll 8
    for (int i = 0; i < 32; ++i) { const int kk = 2 * i + (lane >> 5); scr[kk * 33 + (lane & 31)] = W[(size_t)(k0 + kk) * N + n0 + (lane & 31)]; }
    LDS_WAIT(); asm volatile("" ::: "memory");
    const int c = lane & 7;
#pragma unroll
    for (int j = 0; j < 4; ++j) { const int n = (lane >> 3) + 8 * j; const LAS float* s = scr + (8 * c) * 33 + n;
        v4u o; o.x = pk2(s[0 * 33], s[1 * 33]); o.y = pk2(s[2 * 33], s[3 * 33]); o.z = pk2(s[4 * 33], s[5 * 33]); o.w = pk2(s[6 * 33], s[7 * 33]);
        *(GAS v4u*)(WT + (size_t)(n0 + n) * K + k0 + 8 * c) = o; }
    LDS_WAIT(); asm volatile("" ::: "memory");
}
__device__ __forceinline__ void mod_block_item(const Args& a, LAS unsigned char* ldsl, int cc, int kq8, int tid, int lane, int wave) {
    const float* cmat = a.in[6]; const float* cctx = a.in[7]; const float* Wm = a.in[8]; float* part = (float*)(a.ws + WS_MODP);
    f32x4 acc[9];
#pragma unroll
    for (int r = 0; r < 9; ++r) acc[r] = (f32x4){0.f, 0.f, 0.f, 0.f};
    const int krow = kq8 * 512 + wave * 64;
    const GAS f32x4* wp = (const GAS f32x4*)(Wm + (size_t)krow * NMOD + cc * 256) + lane;
    float sv[9];
#pragma unroll
    for (int r = 0; r < 9; ++r) { const float cv = (r < 8) ? cmat[r * DM + krow + lane] : cctx[krow + lane]; sv[r] = cv / (1.f + __expf(-cv)); }
    for (int i0 = 0; i0 < 64; i0 += 16) {
        f32x4 w[16];
#pragma unroll
        for (int i = 0; i < 16; ++i) w[i] = wp[(size_t)(i0 + i) * (NMOD / 4)];
#pragma unroll
        for (int i = 0; i < 16; ++i)
#pragma unroll
            for (int r = 0; r < 9; ++r) { const float s = __uint_as_float(__builtin_amdgcn_readlane(__float_as_uint(sv[r]), i0 + i)); acc[r] += w[i] * s; }
    }
    LAS f32x4* red = (LAS f32x4*)ldsl;
    __syncthreads();
#pragma unroll
    for (int r = 0; r < 9; ++r) red[(wave * 9 + r) * 64 + lane] = acc[r];
    __syncthreads();
    for (int o = tid; o < 9 * 64; o += NWAVES * 64) { const int r = o >> 6, l = o & 63; f32x4 s = red[r * 64 + l];
#pragma unroll
        for (int w2 = 1; w2 < NWAVES; ++w2) s += red[(w2 * 9 + r) * 64 + l];
        *((GAS f32x4*)(part + (size_t)(kq8 * 9 + r) * NMOD + cc * 256) + l) = s; }
    __syncthreads();
}
constexpr int BG_MOD = 64 * KSPLIT, BG_TR = ((DM / 64) * (DM / 32) + (DM / 64) * (DFF / 32) + (DFF / 64) * (DM / 32)) / 8, N_BG = BG_MOD + BG_TR;
#ifndef BG_Q2
#define BG_Q2 1536
#endif
__device__ __forceinline__ void bg_items(const Args& a, LAS unsigned char* ldsl, int lo, int hi, int start, int stride, int tid, int lane, int wave) {
    constexpr int I_OUT = (DM / 64) * (DM / 32), I_FC1 = (DM / 64) * (DFF / 32);
    LAS float* scr = (LAS float*)(ldsl + wave * 16384);
    for (int bi = lo + start; bi < hi; bi += stride) {
        if (bi < BG_MOD) { mod_block_item(a, ldsl, 32 + (bi & 63), bi >> 6, tid, lane, wave); continue; }
        int r = (bi - BG_MOD) * 8 + wave;
        if (r < I_OUT) { p0_transpose_item(a.in[22], DM, DM, (bf16*)(a.ws + WS_WOUT), scr, r, lane); continue; } r -= I_OUT;
        if (r < I_FC1) { p0_transpose_item(a.in[24], DM, DFF, (bf16*)(a.ws + WS_WFC1), scr, r, lane); continue; } r -= I_FC1;
        p0_transpose_item(a.in[25], DFF, DM, (bf16*)(a.ws + WS_WFC2), scr, r, lane);
    }
}

template <int WHICH>
__device__ __forceinline__ void norm_phase(const Args& a, LAS unsigned char* lds, int vcu, int G, int wave) {
    const int tid = fresh_tid(), lane = tid & 63;
    LAS float* Gv = (LAS float*)lds; LAS float* Sv = Gv + DM;
    const float* bmod = a.in[9]; const float* part = (const float*)(a.ws + WS_MODP); float* modf = (float*)(a.ws + WS_MODF);
    const float* gn = WHICH == 0 ? a.in[10] : a.in[23];
    bf16* H = (bf16*)(a.ws + WS_H);
    const int rows_per = (MTOK + G - 1) / G; int m = vcu * rows_per; const int mend = (m + rows_per < MTOK) ? m + rows_per : MTOK;
    while (m < mend) {
        const int r = (m < M_P) ? 8 : (m - M_P) / T_S;
        const int bnd = (m < M_P) ? M_P : M_P + (r + 1) * T_S; const int send = bnd < mend ? bnd : mend;
        __syncthreads();
        for (int c = tid; c < DM; c += NWAVES * 64) {
            float sh, sc;
            if (WHICH == 0) { sh = bmod[c]; sc = bmod[DM + c];
#pragma unroll
                for (int p = 0; p < KSPLIT; ++p) { sh += part[((size_t)p * 9 + r) * NMOD + c]; sc += part[((size_t)p * 9 + r) * NMOD + DM + c]; } }
            else { sh = modf[(size_t)r * NMOD + 3 * DM + c]; sc = modf[(size_t)r * NMOD + 4 * DM + c]; }
            Gv[c] = gn[c] * (1.f + sc); Sv[c] = sh; }
        __syncthreads();
        for (int mm = m + wave; mm < send; mm += NWAVES) {
            const float* xrow = (WHICH == 0) ? ((mm < M_P) ? a.in[0] + (size_t)mm * DM : a.in[1] + (size_t)(mm - M_P) * DM) : a.out + (size_t)mm * DM;
            const GAS f32x4* xr = (const GAS f32x4*)xrow + lane;
            f32x4 v[16]; float s = 0.f;
#pragma unroll
            for (int j = 0; j < 16; ++j) { v[j] = xr[64 * j]; s += (v[j].x * v[j].x + v[j].y * v[j].y) + (v[j].z * v[j].z + v[j].w * v[j].w); }
            const float rstd = __builtin_amdgcn_rsqf(wave_sum(s) * (1.f / DM) + EPS);
            GAS unsigned long long* o8 = (GAS unsigned long long*)(H + (size_t)mm * DM) + lane;
#pragma unroll
            for (int j = 0; j < 16; ++j) { const f32x4 g = *(const LAS f32x4*)(Gv + 4 * lane + 256 * j), sh = *(const LAS f32x4*)(Sv + 4 * lane + 256 * j);
                const f32x4 y = v[j] * rstd * g + sh;
                o8[64 * j] = (unsigned long long)pk2(y.x, y.y) | ((unsigned long long)pk2(y.z, y.w) << 32); }
        }
        m = send;
    }
    __syncthreads();
}

__device__ __forceinline__ void qk_item(const Args& a, const v4u raw, int it, int lane, bf16* P, float* onew, const LAS float* c128, const LAS float* s128, const LAS float* c64, const LAS float* s64) {
    const int sub = lane & 15, sg = lane >> 4;
    const int m = it / 12, grp = it - m * 12; bf16* src = P + (size_t)m * DIN + grp * 512 + lane * 8;
        float x[8];
        x[0] = __uint_as_float(raw.x << 16); x[1] = __uint_as_float(raw.x & 0xffff0000u); x[2] = __uint_as_float(raw.y << 16); x[3] = __uint_as_float(raw.y & 0xffff0000u);
        x[4] = __uint_as_float(raw.z << 16); x[5] = __uint_as_float(raw.z & 0xffff0000u); x[6] = __uint_as_float(raw.w << 16); x[7] = __uint_as_float(raw.w & 0xffff0000u);
        const bool lat = m >= M_P; const int t = lat ? (m - M_P) % T_S : m % T_P; const int b = lat ? (m - M_P) / T_S : m / T_P;
        const bool is_v = (grp == 5 || grp == 11);
        const bool is_a = grp < 6;
        if (!is_v) {
            float ss = 0.f;
#pragma unroll
            for (int e = 0; e < 8; ++e) ss += x[e] * x[e];
            ss += __shfl_xor(ss, 1); ss += __shfl_xor(ss, 2); ss += __shfl_xor(ss, 4);
            if (is_a) ss += __shfl_xor(ss, 8);
            const float rstd = __builtin_amdgcn_rsqf(ss * (is_a ? (1.f / 128.f) : (1.f / 64.f)) + EPS);
            const float* gp = (grp < 4) ? a.in[12] : (grp == 4) ? a.in[13] : (grp < 10) ? a.in[14] : a.in[15];
            const int goff = is_a ? sub * 8 : (sub & 7) * 8;
            const f32x4 g0 = *(const GAS f32x4*)(gp + goff), g1 = *(const GAS f32x4*)(gp + goff + 4);
            x[0] *= rstd * g0.x; x[1] *= rstd * g0.y; x[2] *= rstd * g0.z; x[3] *= rstd * g0.w; x[4] *= rstd * g1.x; x[5] *= rstd * g1.y; x[6] *= rstd * g1.z; x[7] *= rstd * g1.w;
            if (lat) {
                float px[8];
                if (is_a) {
#pragma unroll
                    for (int e = 0; e < 8; ++e) px[e] = __shfl_xor(x[e], 4);
                    const int axis = (sub >> 3) & 1, half = (sub >> 2) & 1, i0 = (sub & 3) * 8, pos = axis ? (t & 63) : (t >> 6);
#pragma unroll
                    for (int e = 0; e < 8; ++e) { const float cs = c128[pos * 32 + i0 + e], sn = s128[pos * 32 + i0 + e]; x[e] = half ? (x[e] * cs + px[e] * sn) : (x[e] * cs - px[e] * sn); }
                } else {
#pragma unroll
                    for (int e = 0; e < 8; ++e) px[e] = __shfl_xor(x[e], 2);
                    const int s8 = sub & 7, axis = (s8 >> 2) & 1, half = (s8 >> 1) & 1, i0 = (s8 & 1) * 8, pos = axis ? (t & 63) : (t >> 6);
#pragma unroll
                    for (int e = 0; e < 8; ++e) { const float cs = c64[pos * 16 + i0 + e], sn = s64[pos * 16 + i0 + e]; x[e] = half ? (x[e] * cs + px[e] * sn) : (x[e] * cs - px[e] * sn); }
                }
            }
        }
        v4u ob; ob.x = pk2(x[0], x[1]); ob.y = pk2(x[2], x[3]); ob.z = pk2(x[4], x[5]); ob.w = pk2(x[6], x[7]);
        const bool is_q = (grp < 4) || (grp >= 6 && grp < 10);
        if (is_q) { *(GAS v4u*)src = ob; }
        else {
            const int which = (grp == 4) ? 0 : (grp == 5) ? 1 : (grp == 10) ? 2 : 3;
            const int kv = sg;
            if (lat) { *(GAS v4u*)((bf16*)(a.ws + WS_KVL + (size_t)which * KVL_SZ) + ((size_t)(b * 4 + kv) * KVL + LCTX + t) * 128 + sub * 8) = ob; }
            else { *(GAS v4u*)((bf16*)(a.ws + WS_KVP + (size_t)which * KVP_SZ) + ((size_t)(b * 4 + kv) * T_P + t) * 128 + sub * 8) = ob;
                GAS f32x4* of = (GAS f32x4*)(onew + (size_t)which * M_P * 512 + (size_t)m * 512 + kv * 128 + sub * 8);
                of[0] = (f32x4){x[0], x[1], x[2], x[3]}; of[1] = (f32x4){x[4], x[5], x[6], x[7]}; }
        }

}
__device__ __forceinline__ void qk_phase(const Args& a, LAS unsigned char* lds, int vcu, int G, int wave) {
    const int tid = fresh_tid(), lane = tid & 63;
    LAS float* c128 = (LAS float*)lds; LAS float* s128 = c128 + 2048; LAS float* c64 = s128 + 2048; LAS float* s64 = c64 + 1024;
    for (int e = tid; e < 2048; e += NWAVES * 64) { const int pos = e >> 5, i = e & 31; const float f = exp2f(-(float)i * (13.287712379549449f / 32.f)); float sn, cs; sincosf((float)pos * f, &sn, &cs); c128[e] = cs; s128[e] = sn; }
    for (int e = tid; e < 1024; e += NWAVES * 64) { const int pos = e >> 4, i = e & 15; const float f = exp2f(-(float)i * (13.287712379549449f / 16.f)); float sn, cs; sincosf((float)pos * f, &sn, &cs); c64[e] = cs; s64[e] = sn; }
    __syncthreads();
    bf16* P = (bf16*)(a.ws + WS_P);
    float* onew = a.out + (size_t)MTOK * DM;
    const int gw = vcu * NWAVES + wave, NGW = G * NWAVES;
#define QK_SRC(it_) (P + (size_t)((it_) / 12) * DIN + ((it_) % 12) * 512 + lane * 8)
    for (int it = gw; it < MTOK * 12; it += 4 * NGW) {
        const int it1 = it + NGW, it2 = it + 2 * NGW, it3 = it + 3 * NGW;
        v4u r0, r1 = {0u, 0u, 0u, 0u}, r2 = {0u, 0u, 0u, 0u}, r3 = {0u, 0u, 0u, 0u};
        r0 = *(const GAS v4u*)QK_SRC(it);
        if (it1 < MTOK * 12) r1 = *(const GAS v4u*)QK_SRC(it1);
        if (it2 < MTOK * 12) r2 = *(const GAS v4u*)QK_SRC(it2);
        if (it3 < MTOK * 12) r3 = *(const GAS v4u*)QK_SRC(it3);
        qk_item(a, r0, it, lane, P, onew, c128, s128, c64, s64);
        if (it1 < MTOK * 12) qk_item(a, r1, it1, lane, P, onew, c128, s128, c64, s64);
        if (it2 < MTOK * 12) qk_item(a, r2, it2, lane, P, onew, c128, s128, c64, s64);
        if (it3 < MTOK * 12) qk_item(a, r3, it3, lane, P, onew, c128, s128, c64, s64);
    }
#undef QK_SRC
    __syncthreads();
}

__device__ __forceinline__ void attn_phase(const Args& a, unsigned char* lds_g, int G, int wave) {
    const int lane = fresh_tid() & 63;
    const bf16* P = (const bf16*)(a.ws + WS_P); bf16* O = (bf16*)(a.ws + WS_O);
    const bf16* KA_l = (const bf16*)(a.ws + WS_KVL); const bf16* VA_l = (const bf16*)(a.ws + WS_KVL + KVL_SZ); const bf16* KB_l = (const bf16*)(a.ws + WS_KVL + 2 * KVL_SZ); const bf16* VB_l = (const bf16*)(a.ws + WS_KVL + 3 * KVL_SZ);
    const bf16* KA_p = (const bf16*)(a.ws + WS_KVP); const bf16* VA_p = (const bf16*)(a.ws + WS_KVP + KVP_SZ); const bf16* KB_p = (const bf16*)(a.ws + WS_KVP + 2 * KVP_SZ); const bf16* VB_p = (const bf16*)(a.ws + WS_KVP + 3 * KVP_SZ);
    float* misc = (float*)(lds_g + att::LDS_MISC);
    if (wave == 0) { const float p1 = a.in[17][lane] * a.in[18][lane], p2 = a.in[19][lane] * a.in[20][lane];
        const float s1 = wave_sum(p1), s2 = wave_sum(p2); if (lane == 0) misc[0] = __expf(s1) - __expf(s2) + 0.2f; }
    __syncthreads();
    const float lam = misc[0];
    const int nper = G / 8;
    const int c = blockIdx.x, x = c % 8, j = c / 8;
    att::UnitArgs U;
#ifndef ATT_NO_MODE1
    for (int u = c; u < NB_S * 16 * 8 + NB_P * 16 * 2; u += G) {
        const bool lat = u < NB_S * 16 * 8; const int uu = lat ? u : u - NB_S * 16 * 8; const int i = uu / G;
        int gid, g, qb;
        if (lat) { if (G == 256) { gid = i * 8 + x; g = j >> 3; qb = j & 7; } else { gid = uu >> 5; g = (uu >> 3) & 3; qb = uu & 7; } }
        else     { if (G == 256) { gid = (i * 8 + x) * 4 + (j >> 3); g = (j >> 1) & 3; qb = j & 1; } else { gid = uu >> 3; g = (uu >> 1) & 3; qb = uu & 1; } }
        const int b = gid >> 2, kv = gid & 3, h = kv * 4 + g; const int m0 = lat ? M_P + b * T_S + qb * 128 : b * T_P + qb * 128;
        const size_t kvoff = lat ? (size_t)(b * 4 + kv) * KVL * 128 : (size_t)(b * 4 + kv) * T_P * 128;
        U.Qb = P + (size_t)m0 * DIN + 3072 + h * 128; U.ldq = DIN; U.Kh = (lat ? KB_l : KB_p) + kvoff; U.Vh = (lat ? VB_l : VB_p) + kvoff;
        U.Ob = O + (size_t)m0 * DM + 2048 + h * 128; U.ldo = DM; U.NT = lat ? KVL / 64 : T_P / 64; U.jwin = 1 << 30; U.wadd = 0; U.masked = 0; U.t0 = 0; U.sinkl2 = 0.f; U.lam = lam; U.subg = a.in[21];
        att::attn_unit<1>(U, (char*)lds_g);
    }
#endif
#ifndef ATT_NO_MODE0
    for (int u = c; u < NB_S * 16 * 4 + NB_P * 16; u += G) {
        const bool lat = u < NB_S * 16 * 4; const int uu = lat ? u : u - NB_S * 16 * 4; const int i = uu / G;
        int gid, g, qb2;
        if (lat) { if (G == 256) { gid = (i * 8 + x) * 2 + (j >> 4); g = (j >> 2) & 3; qb2 = j & 3; } else { gid = uu >> 4; g = (uu >> 2) & 3; qb2 = uu & 3; } }
        else     { if (G == 256) { gid = x * 8 + (j >> 2); g = j & 3; qb2 = 0; } else { gid = uu >> 2; g = uu & 3; qb2 = 0; } }
        const int b = gid >> 2, kv = gid & 3, h = kv * 4 + g; const int t0 = qb2 * 256, m0 = lat ? M_P + b * T_S + t0 : b * T_P;
        const int wstart = (t0 - 128 > 0) ? t0 - 128 : 0, wend = (t0 + 384 < T_S) ? t0 + 384 : T_S;
        const size_t kvoff = lat ? (size_t)(b * 4 + kv) * KVL * 128 : (size_t)(b * 4 + kv) * T_P * 128;
        U.Qb = P + (size_t)m0 * DIN + h * 128; U.ldq = DIN; U.Kh = (lat ? KA_l : KA_p) + kvoff; U.Vh = (lat ? VA_l : VA_p) + kvoff;
        U.Ob = O + (size_t)m0 * DM + h * 128; U.ldo = DM; U.NT = lat ? 8 + (wend - wstart) / 64 : T_P / 64; U.jwin = lat ? 8 : (1 << 30); U.wadd = lat ? wstart : 0; U.masked = lat ? 1 : 0; U.t0 = t0;
        U.sinkl2 = a.in[16][h] * att::LOG2E; U.lam = 0.f; U.subg = nullptr;
        att::attn_unit<0>(U, (char*)lds_g);
    }
#endif
    __syncthreads();
}


__device__ __forceinline__ void p0_phase(const Args& args, LAS unsigned char* ldsl, int vcu, int G, int wave) {
    const int tid = fresh_tid(), lane = tid & 63;
    for (int it = vcu; it < 32 * KSPLIT; it += G) mod_block_item(args, ldsl, it & 31, it >> 5, tid, lane, wave);
}
__device__ __forceinline__ void p1_extras(const Args& args, LAS unsigned char* ldsl, int vcu, int G, int wave) {
    const int lane = fresh_tid() & 63;
    LAS float* scr = (LAS float*)(ldsl + wave * 16384);
    constexpr int I_IN = (DM / 64) * (DIN / 32);
    for (int r = vcu * NWAVES + wave; r < I_IN; r += G * NWAVES) p0_transpose_item(args.in[11], DM, DIN, (bf16*)(args.ws + WS_WIN), scr, r, lane);
    for (int it = vcu * NWAVES + wave; it < 4 * 4096; it += G * NWAVES) {
        const int tsr = it >> 12, w = it & 4095; const size_t e = ((size_t)w * 64 + lane) * 8;
        const float* src = args.in[2 + tsr] + e; const f32x4 v0 = *(const GAS f32x4*)src, v1 = *(const GAS f32x4*)(src + 4);
        const int d = (int)(e & 127), kv = (int)((e >> 7) & 3), key = (int)((e >> 9) & 511), b = (int)(e >> 18);
        v4u o; o.x = pk2(v0.x, v0.y); o.y = pk2(v0.z, v0.w); o.z = pk2(v1.x, v1.y); o.w = pk2(v1.z, v1.w);
        *(GAS v4u*)((bf16*)(args.ws + WS_KVL + tsr * KVL_SZ) + ((size_t)(b * 4 + kv) * KVL + key) * 128 + d) = o; }
}
__device__ __forceinline__ void p3_extras(const Args& args, LAS unsigned char* ldsl, int vcu, int G, int q2, int wave) {
    const int tid = fresh_tid(), lane = tid & 63;
    bg_items(args, ldsl, q2, N_BG, vcu, G, tid, lane, wave);
    __syncthreads();
}
__device__ __forceinline__ void modf_rest(const Args& args, int vcu, int G) {
    const int tid = fresh_tid();
    const float* bmod = args.in[9]; const float* part = (const float*)(args.ws + WS_MODP); float* modf = (float*)(args.ws + WS_MODF);
    for (int e = vcu * (NWAVES * 64) + tid; e < 9 * 4 * DM; e += G * NWAVES * 64) { const int r = e / (4 * DM), n = 2 * DM + e % (4 * DM);
        float s = bmod[n];
#pragma unroll
        for (int p = 0; p < KSPLIT; ++p) s += part[((size_t)p * 9 + r) * NMOD + n];
        modf[(size_t)r * NMOD + n] = s; }
}
#ifndef GEMM_ALIGN
#define GEMM_ALIGN true
#endif
#ifndef GEMM_SP2
#define GEMM_SP2 true
#endif
#ifndef U_NT
#define U_NT true
#endif
constexpr int P2_G = 232;
__device__ __forceinline__ void p2_phase(const Args& args, LAS unsigned char* ldsl, int G, int bx, int wave) {
    const bool split = (G == 256);
    if (!split || bx < P2_G) {
        pg8::Gemm g{(const pg8::bf16_t*)(args.ws + WS_H), (const pg8::bf16_t*)(args.ws + WS_WIN), MTOK, DIN, DM}; pg8::StaticOrder S; S.init(MTOK, DIN, split ? P2_G : G, bx);
        pg8::EpiBf16<0> E{(pg8::bf16_t*)(args.ws + WS_P), DIN};
        pg8::gemm_phase<pg8::EpiBf16<0>, pg8::StaticOrder, GEMM_ALIGN, GEMM_SP2>(ldsl, g, S, E);
    } else {
        const int tid = fresh_tid(), lane = tid & 63;
        bg_items(args, ldsl, 0, BG_Q2, bx - P2_G, G - P2_G, tid, lane, wave);
    }
}
__device__ __forceinline__ void p5_phase(const Args& args, LAS unsigned char* ldsl, int G, int bx) {
    pg8::Gemm g{(const pg8::bf16_t*)(args.ws + WS_O), (const pg8::bf16_t*)(args.ws + WS_WOUT), MTOK, DM, DM}; pg8::StaticOrder S; S.init(MTOK, DM, G, bx);
    const float* modf = (const float*)(args.ws + WS_MODF);
    pg8::EpiResid E{args.in[0], args.in[1], args.out, DM, M_P / 256, modf + 2 * DM, NMOD, modf + (size_t)8 * NMOD + 2 * DM};
    pg8::gemm_phase<pg8::EpiResid, pg8::StaticOrder, GEMM_ALIGN, GEMM_SP2>(ldsl, g, S, E);
}
__device__ __forceinline__ void p7_phase(const Args& args, LAS unsigned char* ldsl, int G, int bx) {
    pg8::Gemm g{(const pg8::bf16_t*)(args.ws + WS_H), (const pg8::bf16_t*)(args.ws + WS_WFC1), MTOK, DFF, DM}; pg8::StaticOrder S; S.init(MTOK, DFF, G, bx);
    pg8::EpiBf16<1, U_NT> E{(pg8::bf16_t*)(args.ws + WS_U), DFF};
    pg8::gemm_phase<pg8::EpiBf16<1, U_NT>, pg8::StaticOrder, GEMM_ALIGN, GEMM_SP2>(ldsl, g, S, E);
}
__device__ __forceinline__ void p7_null_phase(const Args& args, LAS unsigned char* ldsl, int G, int bx) {
    pg8::Gemm g{(const pg8::bf16_t*)(args.ws + WS_H), (const pg8::bf16_t*)(args.ws + WS_WFC1), MTOK, DFF, DM}; pg8::StaticOrder S; S.init(MTOK, DFF, G, bx);
    pg8::EpiNull E{};
    pg8::gemm_phase<pg8::EpiNull, pg8::StaticOrder, GEMM_ALIGN, GEMM_SP2>(ldsl, g, S, E);
}
__device__ __forceinline__ void p8_null_phase(const Args& args, LAS unsigned char* ldsl, int G, int bx) {
    pg8::Gemm g{(const pg8::bf16_t*)(args.ws + WS_U), (const pg8::bf16_t*)(args.ws + WS_WFC2), MTOK, DM, DFF}; pg8::StaticOrder S; S.init(MTOK, DM, G, bx);
    pg8::EpiNull E{};
    pg8::gemm_phase<pg8::EpiNull, pg8::StaticOrder, GEMM_ALIGN, GEMM_SP2>(ldsl, g, S, E);
}
__device__ __forceinline__ void p8_phase(const Args& args, LAS unsigned char* ldsl, int G, int bx) {
    pg8::Gemm g{(const pg8::bf16_t*)(args.ws + WS_U), (const pg8::bf16_t*)(args.ws + WS_WFC2), MTOK, DM, DFF}; pg8::StaticOrder S; S.init(MTOK, DM, G, bx);
    const float* modf = (const float*)(args.ws + WS_MODF);
    pg8::EpiResid E{args.out, args.out + (size_t)M_P * DM, args.out, DM, M_P / 256, modf + 5 * DM, NMOD, modf + (size_t)8 * NMOD + 5 * DM};
    pg8::gemm_phase<pg8::EpiResid, pg8::StaticOrder, GEMM_ALIGN, GEMM_SP2>(ldsl, g, S, E);
}

__global__ void __launch_bounds__(NWAVES * 64, 2) fwd_kernel(Args args) {
    extern __shared__ __attribute__((aligned(16))) unsigned char lds[];
    LAS unsigned char* ldsl = (LAS unsigned char*)lds;
    volatile LAS unsigned* MISC = (volatile LAS unsigned*)(ldsl + MISC_OFF);
    const int tid = threadIdx.x, wave = __builtin_amdgcn_readfirstlane(tid >> 6);
    const int G = gridDim.x; const int bx = blockIdx.x; const int vcu = (G % 8 == 0) ? (bx % 8) * (G / 8) + bx / 8 : bx;
    gu32* ctl = (gu32*)(args.ws + WS_CTL);
    for (int u = tid; u < (LDS_BYTES - MISC_OFF) / 4; u += NWAVES * 64) ((LAS unsigned*)(ldsl + MISC_OFF))[u] = 0u;
    __syncthreads();
    XcdBarrier bar; bar.bar = (unsigned*)(ctl + CW_BAR); bar.x = 0; bar.st = nullptr;
    if (N_LAUNCHES == 1) bar = xcd_barrier_post((unsigned*)(ctl + CW_BAR), MISC + 8);
    const int lo = args.ph_lo, hi = args.ph_hi;
#ifndef PHASE_MASK
#define PHASE_MASK 0x1ff
#endif
#define IN(k) ((((PHASE_MASK) >> (k)) & 1) && lo <= (k) && (k) < hi)
#define SEAM(k) do { if (IN(k) && IN((k) + 1)) xcd_barrier(bar); } while (0)

#ifndef PROBE_REPEAT
#define PROBE_REPEAT (-1)
#endif
#if defined(PROBE_TIME)
    unsigned long long pt0 = 0, pt1 = 0;
#define PT_BEGIN(k) do { if (PROBE_TIME == (k)) pt0 = wall_clock64(); } while (0)
#define PT_END(k) do { if (PROBE_TIME == (k)) pt1 = wall_clock64(); } while (0)
#else
#define PT_BEGIN(k) do { } while (0)
#define PT_END(k) do { } while (0)
#endif
#define REP(k, call) do { if (PROBE_REPEAT == (k)) { call; xcd_barrier(bar); } } while (0)
    PT_BEGIN(0);
    if (IN(0)) p0_phase(args, ldsl, vcu, G, wave);
    SEAM(0); PT_END(0);
    PT_BEGIN(1);
    if (IN(1)) { norm_phase<0>(args, ldsl, vcu, G, wave); p1_extras(args, ldsl, vcu, G, wave); }
    SEAM(1); PT_END(1);
    PT_BEGIN(2);
    if (IN(2)) p2_phase(args, ldsl, G, bx, wave);
    SEAM(2); PT_END(2);
    PT_BEGIN(3);
    if (IN(3)) { p3_extras(args, ldsl, vcu, G, (G == 256) ? BG_Q2 : 0, wave); qk_phase(args, ldsl, vcu, G, wave); }
    SEAM(3); PT_END(3);
    PT_BEGIN(4);
    if (IN(4)) { modf_rest(args, vcu, G); attn_phase(args, lds, G, wave); }
    SEAM(4); PT_END(4); REP(4, attn_phase(args, lds, G, wave));
    PT_BEGIN(5);
    if (IN(5)) p5_phase(args, ldsl, G, bx);
    SEAM(5); PT_END(5); REP(5, p5_phase(args, ldsl, G, bx));
    PT_BEGIN(6);
    if (IN(6)) norm_phase<1>(args, ldsl, vcu, G, wave);
    SEAM(6); PT_END(6); REP(6, norm_phase<1>(args, ldsl, vcu, G, wave));
#if defined(PROBE_CLOCK)
    unsigned long long pc0 = 0, pr0 = 0, pc1 = 0, pr1 = 0;
    if (PROBE_CLOCK == 7) { pc0 = clock64(); pr0 = wall_clock64(); }
#endif
    PT_BEGIN(7);
    if (IN(7)) p7_phase(args, ldsl, G, bx);
#if defined(PROBE_CLOCK)
    if (PROBE_CLOCK == 7) { pc1 = clock64(); pr1 = wall_clock64(); }
#endif
    SEAM(7); PT_END(7); REP(7, p7_phase(args, ldsl, G, bx)); REP(17, p7_null_phase(args, ldsl, G, bx)); REP(18, p8_null_phase(args, ldsl, G, bx));
    PT_BEGIN(8);
    if (IN(8)) p8_phase(args, ldsl, G, bx);
#if defined(PROBE_TIME)
    PT_END(8);
    if (bx == 0 && tid == 0) { const unsigned long long t0 = wall_clock64(); while (wall_clock64() - t0 < (pt1 - pt0)) __builtin_amdgcn_s_sleep(8); }
#endif
#if defined(PROBE_CLOCK)
    if (bx == 0 && tid == 0) {
        const unsigned long long ticks = (pc1 - pc0) * 1000ull / (pr1 - pr0);
        const unsigned long long t0 = wall_clock64(); while (wall_clock64() - t0 < ticks) __builtin_amdgcn_s_sleep(8);
    }
#endif
#undef REP
#undef IN
#undef SEAM
}

extern "C" void kernel_launch(void* const* d_in, const int* in_sizes, int n_in, void* d_out, int out_size, void* d_ws, size_t ws_size, hipStream_t stream) {
    static int grid = 0;
    if (grid == 0) {
        if (n_in != 26 || in_sizes[0] != M_P * DM || in_sizes[1] != M_S * DM || out_size != MTOK * DM + 4 * M_P * 512 || ws_size < WS_END) {
            fprintf(stderr, "kernel_launch: shape mismatch (n_in %d in0 %d in1 %d out %d ws %zu, need ws >= %zu); nothing launched\n", n_in, n_in > 0 ? in_sizes[0] : -1, n_in > 1 ? in_sizes[1] : -1, out_size, ws_size, (size_t)WS_END); grid = -1; return; }
        int dev = 0, cus = 0, per_cu = 0;
        if (hipGetDevice(&dev) != hipSuccess || hipDeviceGetAttribute(&cus, hipDeviceAttributeMultiprocessorCount, dev) != hipSuccess) { grid = -1; return; }
        if (hipFuncSetAttribute((const void*)fwd_kernel, hipFuncAttributeMaxDynamicSharedMemorySize, LDS_BYTES) != hipSuccess) { fprintf(stderr, "kernel_launch: hipFuncSetAttribute failed\n"); grid = -1; return; }
        if (hipOccupancyMaxActiveBlocksPerMultiprocessor(&per_cu, (const void*)fwd_kernel, NWAVES * 64, LDS_BYTES) != hipSuccess || per_cu < 1) { fprintf(stderr, "kernel_launch: occupancy query says %d blocks per CU\n", per_cu); }
        (void)hipGetLastError();
        grid = cus;
    }
    if (grid < 0) return;
    if (hipMemsetAsync((char*)d_ws + WS_CTL, 0, CTL_ZERO_BYTES, stream) != hipSuccess) return;
    Args a{};
    for (int i = 0; i < 26; ++i) a.in[i] = (const float*)d_in[i];
    a.out = (float*)d_out; a.ws = (unsigned char*)d_ws;
    if (N_LAUNCHES == 1) { a.ph_lo = 0; a.ph_hi = NPH; hipLaunchKernelGGL(fwd_kernel, dim3(grid), dim3(NWAVES * 64), LDS_BYTES, stream, a); }
    else { for (int p = 0; p < NPH; ++p) { a.ph_lo = p; a.ph_hi = p + 1; hipLaunchKernelGGL(fwd_kernel, dim3(grid), dim3(NWAVES * 64), LDS_BYTES, stream, a); } }
    const hipError_t le = hipPeekAtLastError();
    if (le != hipSuccess) fprintf(stderr, "kernel_launch: launch failed: %s\n", hipGetErrorName(le));
}
```

```cpp
#include <hip/hip_runtime.h>
#include <cstdio>
#include <cstdint>
namespace pg8 {
#define PG8_LAS __attribute__((address_space(3)))
typedef unsigned short bf16_t;
typedef short bf16x8 __attribute__((ext_vector_type(8)));
typedef float f32x4 __attribute__((ext_vector_type(4)));
typedef unsigned u32x4 __attribute__((ext_vector_type(4)));
constexpr int BM = 256, BK = 64, HALF = 128, HTB = HALF * BK * 2  , STAGE_BYTES = 8 * HTB, NXCD = 8, WGM = 8;

__host__ __device__ __forceinline__ int lds_byte(int r, int c) { const int st = (r >> 4) * 2 + (c >> 5), rr = r & 15, cc = c & 31, ob = rr * 64 + cc * 2; return st * 1024 + (ob ^ (((ob >> 9) & 1) << 5)); }
__host__ __device__ __forceinline__ void stage_rc(int b, int& R, int& C) { const int st = b / 1024, sb = b % 1024, swz = sb ^ (((sb >> 9) & 1) << 5); R = (st >> 1) * 16 + swz / 64; C = (st & 1) * 32 + (swz % 64) / 2; }
__host__ __device__ __forceinline__ int perm32(int rho) { const int n = rho >> 4, i = rho & 15; return 8 * (i >> 2) + 4 * n + (i & 3); }

struct Unit { int pm, pn; };
struct Gemm { const bf16_t* A; const bf16_t* Bt; int M, N, K; };

struct StaticOrder {
    int nM, nN, nwg, G, c;
    __host__ __device__ void init(int M, int N, int G_, int c_) { nM = M / BM; nN = N / BM; nwg = nM * nN; G = G_; c = c_; }
    __host__ __device__ bool next(int i, Unit& u) const {
        const long L = (long)i * G + c; if (L >= nwg) return false;
        int wgid = (int)L; { const int q = nwg / NXCD, r = nwg % NXCD, xcd = wgid % NXCD, off = wgid / NXCD; wgid = (xcd < r ? xcd * (q + 1) : r * (q + 1) + (xcd - r) * q) + off; }
        const int nig = WGM * nN, gid = wgid / nig, fm = gid * WGM, gsz = (nM - fm) < WGM ? (nM - fm) : WGM;
        u.pm = fm + ((wgid % nig) % gsz); u.pn = (wgid % nig) / gsz; return true;
    }
    __device__ __forceinline__ void a_ready(const Unit&) const {}
    __device__ __forceinline__ void done(const Unit&) const {}
};

__device__ __forceinline__ unsigned cvt_pk_bf16(float lo, float hi) { unsigned r; asm volatile("v_cvt_pk_bf16_f32 %0, %1, %2" : "=v"(r) : "v"(lo), "v"(hi)); return r; }

template <int ACT, bool NT = false> struct EpiBf16 {
    static constexpr bool PERM = true, AFTER_DRAIN = false;
    bf16_t* O; int ldc;
    __device__ __forceinline__ void operator()(const f32x4 (&acc)[2][2][4][2], const Unit& u, int wr, int wc, int fr, int fq) const {
        const int row0 = u.pm * BM + wr * 64 + fr; const int col0 = u.pn * BM + wc * 32 + 8 * fq;
#pragma unroll
        for (int ai = 0; ai < 2; ++ai)
#pragma unroll
            for (int m = 0; m < 4; ++m) { bf16_t* rowp = O + (size_t)(row0 + ai * HALF + m * 16) * ldc + col0;
#pragma unroll
                for (int bj = 0; bj < 2; ++bj) { f32x4 v0 = acc[ai][bj][m][0], v1 = acc[ai][bj][m][1];
                    if (ACT == 1) {
#pragma unroll
                        for (int j = 0; j < 4; ++j) { const float a = fmaxf(v0[j], 0.f), b = fmaxf(v1[j], 0.f); v0[j] = a * a; v1[j] = b * b; } }
                    u32x4 w; w.x = cvt_pk_bf16(v0[0], v0[1]); w.y = cvt_pk_bf16(v0[2], v0[3]); w.z = cvt_pk_bf16(v1[0], v1[1]); w.w = cvt_pk_bf16(v1[2], v1[3]);
                    if (NT) __builtin_nontemporal_store(w, (u32x4*)(rowp + bj * HALF)); else *(u32x4*)(rowp + bj * HALF) = w;
#if defined(PROBE_STORE)
                    if (ACT == 1) {
                        bf16_t* dp = O + (size_t)402653184 / 2 * 0 + ((size_t)384 << 20) / 2;
                        if (PROBE_STORE == 1) *(u32x4*)(dp + (size_t)(row0 + ai * HALF + m * 16) * ldc + col0 + bj * HALF) = w;
                        else *(u32x4*)(dp + (size_t)(u.pm * BM + wr * 64 + ai * HALF + m * 16 + (fr & 7) + 8 * bj) * ldc + u.pn * BM + wc * 64 + (fr >> 3) * 32 + 8 * fq) = w;
                    }
#endif
                    } }
    }
};
#ifndef RESID_BATCH
#define RESID_BATCH 4
#endif
struct EpiResid {
    static constexpr bool PERM = false, AFTER_DRAIN = false;
    const float* base0; const float* base1; float* out; int ldc; int split; const float* gate; int gate_stride; const float* gate_ctx;
    __device__ __forceinline__ void operator()(const f32x4 (&acc)[2][2][4][2], const Unit& u, int wr, int wc, int fr, int fq) const {
        const int rloc = wr * 64 + fr, col0 = u.pn * BM + wc * 32 + 4 * fq;
        const float* bt = (u.pm < split) ? base0 + (size_t)u.pm * BM * ldc : base1 + (size_t)(u.pm - split) * BM * ldc;
        const float* gv = (u.pm < split) ? gate_ctx : gate + (size_t)((u.pm - split) >> 2) * gate_stride;
        float* ot = out + (size_t)u.pm * BM * ldc;
        f32x4 g[2][2];
#pragma unroll
        for (int bj = 0; bj < 2; ++bj)
#pragma unroll
            for (int n = 0; n < 2; ++n) g[bj][n] = *(const f32x4*)(gv + col0 + bj * HALF + n * 16);
#pragma unroll
        for (int ai = 0; ai < 2; ++ai)
#pragma unroll
            for (int m = 0; m < 4; ++m) { const size_t off = (size_t)(rloc + ai * HALF + m * 16) * ldc + col0;
#pragma unroll
                for (int bj = 0; bj < 2; ++bj)
#pragma unroll
                    for (int n = 0; n < 2; ++n) { const f32x4 bs = *(const f32x4*)(bt + off + bj * HALF + n * 16); *(f32x4*)(ot + off + bj * HALF + n * 16) = bs + g[bj][n] * acc[ai][bj][m][n]; }
                if ((m & (RESID_BATCH - 1)) == RESID_BATCH - 1) asm volatile("" ::: "memory"); }
    }
};

struct EpiNull {
    static constexpr bool PERM = true, AFTER_DRAIN = false;
    __device__ __forceinline__ void operator()(const f32x4 (&acc)[2][2][4][2], const Unit& u, int wr, int wc, int fr, int fq) const {
#pragma unroll
        for (int ai = 0; ai < 2; ++ai)
#pragma unroll
            for (int bj = 0; bj < 2; ++bj)
#pragma unroll
                for (int m = 0; m < 4; ++m)
#pragma unroll
                    for (int n = 0; n < 2; ++n) asm volatile("" :: "v"(acc[ai][bj][m][n]));
    }
};

template <class Epi, class Sched, bool ALIGN_EPI = false, bool SP2 = false>
__device__ __forceinline__ void gemm_phase(PG8_LAS unsigned char* lds, const Gemm g, const Sched& S, const Epi& E) {
    int tid_ = threadIdx.x; asm volatile("" : "+v"(tid_));
    const int tid = tid_, wid = __builtin_amdgcn_readfirstlane(tid >> 6), lane = tid & 63, wr = wid >> 2, wc = wid & 3, fr = lane & 15, fq = lane >> 4;
    const int K = g.K, nt = K / BK;
    unsigned voffA[2], voffB[2];
#pragma unroll
    for (int i = 0; i < 2; ++i) { int R, C; stage_rc(tid * 16 + i * 8192, R, C); const int Rb = Epi::PERM ? ((R & ~31) + perm32(R & 31)) : R;
        voffA[i] = (unsigned)(R * K + C) * 2u; voffB[i] = (unsigned)(Rb * K + C) * 2u; }
    const size_t kstep = (size_t)(BK * 2);
    const size_t hstep = (size_t)HALF * K * 2;
    const size_t tstep = 2 * hstep;
    const unsigned ldsw = (unsigned)wid * 1024u;
    const int aoff = lds_byte(wr * 64 + fr, fq * 8), boff = lds_byte(wc * 32 + fr, fq * 8);
#define PG8_SA(b, h) (((b) * 2 + (h)) * HTB)
#define PG8_SB(b, h) ((4 + (b) * 2 + (h)) * HTB)
#define PG8_STAGE(bufoff, gbase, voff) do { _Pragma("unroll") for (int _i = 0; _i < 2; ++_i) \
        __builtin_amdgcn_global_load_lds((const unsigned*)((const char*)(gbase) + (voff)[_i]), (PG8_LAS unsigned*)(lds + (bufoff) + ldsw + _i * 8192), 16, 0, 0); } while (0)
#define PG8_LDA(dst, b, h) do { _Pragma("unroll") for (int m = 0; m < 4; ++m) _Pragma("unroll") for (int k = 0; k < 2; ++k) dst[m][k] = *(const PG8_LAS bf16x8*)(lds + PG8_SA(b, h) + aoff + m * 2048 + k * 1024); } while (0)
#define PG8_LDB(dst, b, h) do { _Pragma("unroll") for (int n = 0; n < 2; ++n) _Pragma("unroll") for (int k = 0; k < 2; ++k) dst[n][k] = *(const PG8_LAS bf16x8*)(lds + PG8_SB(b, h) + boff + n * 2048 + k * 1024); } while (0)
#define PG8_MMA(ai, bj, At, Bt) do { __builtin_amdgcn_s_setprio(1); _Pragma("unroll") for (int m = 0; m < 4; ++m) _Pragma("unroll") for (int n = 0; n < 2; ++n) _Pragma("unroll") for (int k = 0; k < 2; ++k) \
        acc[ai][bj][m][n] = __builtin_amdgcn_mfma_f32_16x16x32_bf16(Bt[n][k], At[m][k], acc[ai][bj][m][n], 0, 0, 0); __builtin_amdgcn_s_setprio(0); } while (0)
#define PG8_WAIT_V(n) asm volatile("s_waitcnt vmcnt(" #n ")" ::: "memory")
#define PG8_WAIT_L(n) asm volatile("s_waitcnt lgkmcnt(" #n ")" ::: "memory")
#define PG8_BAR __builtin_amdgcn_s_barrier()
#define PG8_SCHED __builtin_amdgcn_sched_barrier(0)
    Unit cur, nxt; int ui = 0;
    if (!S.next(0, cur)) return;
    f32x4 acc[2][2][4][2];
#pragma unroll
    for (int a = 0; a < 2; ++a)
#pragma unroll
        for (int b = 0; b < 2; ++b)
#pragma unroll
            for (int m = 0; m < 4; ++m)
#pragma unroll
                for (int n = 0; n < 2; ++n) acc[a][b][m][n] = (f32x4){0.f, 0.f, 0.f, 0.f};
    bf16x8 At[4][2], B0[2][2], B1[2][2];
    const char* cA = (const char*)g.A + (size_t)cur.pm * tstep; const char* cB = (const char*)g.Bt + (size_t)cur.pn * tstep;
    S.a_ready(cur);
    if constexpr (SP2) {
        PG8_STAGE(PG8_SB(0, 0), cB, voffB); PG8_STAGE(PG8_SB(0, 1), cB + hstep, voffB); PG8_STAGE(PG8_SA(0, 0), cA, voffA); PG8_STAGE(PG8_SA(0, 1), cA + hstep, voffA);
        if (wr == 1) PG8_BAR;
        PG8_WAIT_V(2); PG8_BAR;
        PG8_STAGE(PG8_SB(1, 0), cB + kstep, voffB); PG8_STAGE(PG8_SA(1, 0), cA + kstep, voffA); PG8_STAGE(PG8_SB(1, 1), cB + hstep + kstep, voffB);
        PG8_WAIT_V(6); PG8_BAR;
    } else {
        PG8_STAGE(PG8_SB(0, 0), cB, voffB); PG8_STAGE(PG8_SA(0, 0), cA, voffA); PG8_STAGE(PG8_SB(0, 1), cB + hstep, voffB); PG8_STAGE(PG8_SA(0, 1), cA + hstep, voffA);
        if (wr == 1) PG8_BAR;
        PG8_WAIT_V(4); PG8_BAR;
        PG8_STAGE(PG8_SB(1, 0), cB + kstep, voffB); PG8_STAGE(PG8_SA(1, 0), cA + kstep, voffA); PG8_STAGE(PG8_SB(1, 1), cB + hstep + kstep, voffB);
        PG8_WAIT_V(6); PG8_BAR;
    }
    for (;;) {
        const bool has_next = S.next(ui + 1, nxt);
        const char* nA = has_next ? (const char*)g.A + (size_t)nxt.pm * tstep : cA; const char* nB = has_next ? (const char*)g.Bt + (size_t)nxt.pn * tstep : cB;
        for (int t = 0; t < nt; t += 2) {
            const bool last = (t == nt - 2);
            const char* a1 = cA + (size_t)(t + 1) * kstep;
            const char* a2 = last ? nA : cA + (size_t)(t + 2) * kstep; const char* b2 = last ? nB : cB + (size_t)(t + 2) * kstep;
            const char* a3 = a2 + kstep; const char* b3 = b2 + kstep;
            if (last && has_next) S.a_ready(nxt);
            if constexpr (SP2) {
            PG8_LDB(B0, 0, 0); PG8_LDB(B1, 0, 1); PG8_SCHED; PG8_LDA(At, 0, 0); PG8_STAGE(PG8_SA(1, 1), a1 + hstep, voffA);
            PG8_WAIT_V(8); PG8_WAIT_L(0); PG8_BAR; PG8_MMA(0, 0, At, B0); PG8_MMA(0, 1, At, B1); PG8_BAR; PG8_SCHED;
            PG8_LDA(At, 0, 1); PG8_STAGE(PG8_SB(0, 0), b2, voffB); PG8_STAGE(PG8_SB(0, 1), b2 + hstep, voffB); PG8_STAGE(PG8_SA(0, 0), a2, voffA);
            PG8_WAIT_V(8); PG8_WAIT_L(0); PG8_BAR; PG8_MMA(1, 0, At, B0); PG8_MMA(1, 1, At, B1); PG8_BAR; PG8_SCHED;
            PG8_LDB(B0, 1, 0); PG8_LDB(B1, 1, 1); PG8_SCHED; PG8_LDA(At, 1, 0); PG8_STAGE(PG8_SA(0, 1), a2 + hstep, voffA);
            PG8_WAIT_V(8); PG8_WAIT_L(0); PG8_BAR; PG8_MMA(0, 0, At, B0); PG8_MMA(0, 1, At, B1); PG8_BAR; PG8_SCHED;
            PG8_LDA(At, 1, 1); PG8_STAGE(PG8_SB(1, 0), b3, voffB); PG8_STAGE(PG8_SB(1, 1), b3 + hstep, voffB); PG8_STAGE(PG8_SA(1, 0), a3, voffA);
            PG8_WAIT_V(8); PG8_WAIT_L(0); PG8_BAR; PG8_MMA(1, 0, At, B0); PG8_MMA(1, 1, At, B1); PG8_BAR; PG8_SCHED;
            } else {
            PG8_LDB(B0, 0, 0); PG8_SCHED; PG8_LDA(At, 0, 0); PG8_STAGE(PG8_SA(1, 1), a1 + hstep, voffA);
            PG8_WAIT_L(8); PG8_BAR; PG8_WAIT_L(0); PG8_MMA(0, 0, At, B0); PG8_BAR; PG8_SCHED;
            PG8_LDB(B1, 0, 1); PG8_STAGE(PG8_SB(0, 0), b2, voffB);
            PG8_BAR; PG8_WAIT_L(0); PG8_MMA(0, 1, At, B1); PG8_BAR;
            PG8_LDA(At, 0, 1); PG8_STAGE(PG8_SA(0, 0), a2, voffA);
            PG8_BAR; PG8_WAIT_L(0); PG8_MMA(1, 0, At, B0); PG8_BAR; PG8_SCHED;
            PG8_STAGE(PG8_SB(0, 1), b2 + hstep, voffB);
            PG8_WAIT_V(6); PG8_BAR; PG8_MMA(1, 1, At, B1); PG8_BAR;
            PG8_LDB(B0, 1, 0); PG8_SCHED; PG8_LDA(At, 1, 0); PG8_STAGE(PG8_SA(0, 1), a2 + hstep, voffA);
            PG8_WAIT_L(8); PG8_BAR; PG8_WAIT_L(0); PG8_MMA(0, 0, At, B0); PG8_BAR; PG8_SCHED;
            PG8_LDB(B1, 1, 1); PG8_STAGE(PG8_SB(1, 0), b3, voffB);
            PG8_BAR; PG8_WAIT_L(0); PG8_MMA(0, 1, At, B1); PG8_BAR;
            PG8_LDA(At, 1, 1); PG8_STAGE(PG8_SA(1, 0), a3, voffA);
            PG8_BAR; PG8_WAIT_L(0); PG8_MMA(1, 0, At, B0); PG8_BAR; PG8_SCHED;
            PG8_STAGE(PG8_SB(1, 1), b3 + hstep, voffB);
            PG8_WAIT_V(6); PG8_BAR; PG8_MMA(1, 1, At, B1); PG8_BAR;
            }
        }
        if constexpr (ALIGN_EPI) { if (wr == 0) PG8_BAR; }
        if constexpr (!Epi::AFTER_DRAIN) { E(acc, cur, wr, wc, fr, fq); S.done(cur); }
        if (!has_next) break;
#pragma unroll
        for (int a = 0; a < 2; ++a)
#pragma unroll
            for (int b = 0; b < 2; ++b)
#pragma unroll
                for (int m = 0; m < 4; ++m)
#pragma unroll
                    for (int n = 0; n < 2; ++n) acc[a][b][m][n] = (f32x4){0.f, 0.f, 0.f, 0.f};
        cur = nxt; cA = nA; cB = nB; ++ui;
        if constexpr (ALIGN_EPI) { if (wr == 1) PG8_BAR; }
    }
    PG8_WAIT_V(0);
    if constexpr (!ALIGN_EPI) { if (wr == 0) PG8_BAR; }
    PG8_BAR;
    if constexpr (Epi::AFTER_DRAIN) { E.fused(acc, cur, wr, wc, fr, fq, lds, wid, lane); S.done(cur); }
#undef PG8_SA
#undef PG8_SB
#undef PG8_STAGE
#undef PG8_LDA
#undef PG8_LDB
#undef PG8_MMA
#undef PG8_WAIT_V
#undef PG8_WAIT_L
#undef PG8_BAR
#undef PG8_SCHED
}
}
namespace att {
#ifdef ATT_NOMASK
constexpr bool defined_NOMASK = true;
#else
constexpr bool defined_NOMASK = false;
#endif
typedef unsigned short bf16_t;
using bf16x8 = __attribute__((ext_vector_type(8))) short;
using s16x4  = __attribute__((ext_vector_type(4))) short;
using f32x16 = __attribute__((ext_vector_type(16))) float;
using u32x4  = __attribute__((ext_vector_type(4))) unsigned;
constexpr int KVBLK = 64;
constexpr int SHM_V = 16384, SHM_K = 16384;
constexpr int LDS_WS = 2 * SHM_V + 2 * SHM_K;
constexpr int LDS_X = LDS_WS + 8 * 64 * 4;
constexpr int LDS_MISC = LDS_X + 4 * 32 * 128 * 4;
constexpr int LDS_BYTES = LDS_MISC + 64;
constexpr float LOG2E = 1.4426950408889634f;
#define GASQ __attribute__((address_space(1)))
#define KSWZ(row, colB) ((row) * 256 + ((colB) ^ (((row) & 7) << 4)))
#define SBAR() __builtin_amdgcn_sched_barrier(0)
__device__ __forceinline__ int crow(int r, int hi) { return (r & 3) + 8 * (r >> 2) + 4 * hi; }
__device__ __forceinline__ unsigned cvtpk(float lo, float hi) { unsigned r; asm volatile("v_cvt_pk_bf16_f32 %0, %1, %2" : "=v"(r) : "v"(lo), "v"(hi)); return r; }

#ifndef ATT_SDEPTH0
#define ATT_SDEPTH0 2
#endif
#ifndef ATT_QLDS0
#define ATT_QLDS0 1
#endif
template <int MODE> struct Cfg {
    static constexpr float SCALE = (MODE == 0) ? 0.088388347648318440f : 0.125f;
    static constexpr float C = SCALE * LOG2E;
    static constexpr float THRS = 8.f / SCALE;
    static constexpr int ND0 = (MODE == 0) ? 8 : 4;
    static constexpr int SDEPTH = (MODE == 0) ? ATT_SDEPTH0 : 2;
    static constexpr bool QLDS = (MODE == 0) && (ATT_QLDS0 != 0);
};

template <int MODE>
__device__ __forceinline__ void partialSM(f32x16& p0, f32x16& p1, float& m_reg, float& mn, float& alpha) {
  constexpr float C = Cfg<MODE>::C;
  float pmax = p0[0];
#pragma unroll
  for (int r = 1; r < 16; ++r) pmax = fmaxf(pmax, p0[r]);
#pragma unroll
  for (int r = 0; r < 16; ++r) pmax = fmaxf(pmax, p1[r]);
  { auto rr = __builtin_amdgcn_permlane32_swap(__float_as_uint(pmax), __float_as_uint(pmax), false, false);
    pmax = fmaxf(__uint_as_float(rr[0]), __uint_as_float(rr[1])); }
  if (__builtin_expect(__all(pmax - m_reg <= Cfg<MODE>::THRS), 1)) { mn = m_reg; alpha = 1.f; }
  else { mn = fmaxf(m_reg, pmax); alpha = __builtin_amdgcn_exp2f((m_reg - mn) * C); m_reg = mn; }
  const float mnC = -mn * C;
#pragma unroll
  for (int r = 0; r < 16; ++r) p0[r] = fmaf(p0[r], C, mnC);
#pragma unroll
  for (int r = 0; r < 16; ++r) p1[r] = fmaf(p1[r], C, mnC);
#pragma unroll
  for (int r = 0; r < 16; ++r) p0[r] = __builtin_amdgcn_exp2f(p0[r]);
}
__device__ __forceinline__ void finishSM(f32x16& p0, f32x16& p1, float alpha, float& l_reg, bf16x8& pa0, bf16x8& pa1, bf16x8& pa2, bf16x8& pa3) {
#pragma unroll
  for (int r = 0; r < 16; ++r) p1[r] = __builtin_amdgcn_exp2f(p1[r]);
  float ps = 0;
#pragma unroll
  for (int r = 0; r < 16; ++r) ps += p0[r];
#pragma unroll
  for (int r = 0; r < 16; ++r) ps += p1[r];
  { auto rr = __builtin_amdgcn_permlane32_swap(__float_as_uint(ps), __float_as_uint(ps), false, false);
    ps = __uint_as_float(rr[0]) + __uint_as_float(rr[1]); }
  l_reg = l_reg * alpha + ps;
#define PK4(P, BASE, OUT) do { unsigned a0 = cvtpk(P[BASE + 0], P[BASE + 1]), a1 = cvtpk(P[BASE + 2], P[BASE + 3]);   \
    unsigned b0 = cvtpk(P[BASE + 4], P[BASE + 5]), b1 = cvtpk(P[BASE + 6], P[BASE + 7]);                              \
    auto r0 = __builtin_amdgcn_permlane32_swap(a0, b0, false, false); auto r1 = __builtin_amdgcn_permlane32_swap(a1, b1, false, false); \
    u32x4 w = {r0[0], r1[0], r0[1], r1[1]}; OUT = *reinterpret_cast<bf16x8*>(&w); } while (0)
  PK4(p0, 0, pa0); PK4(p0, 8, pa1); PK4(p1, 0, pa2); PK4(p1, 8, pa3);
#undef PK4
}
template <int MODE, bool QLDS>
__device__ __forceinline__ void qkt(f32x16& p0, f32x16& p1, const char* Ks, const bf16x8* qr, const char* qs, int r32, int hi, int comp) {
  p0 = f32x16{}; p1 = f32x16{};
  int rb = r32; asm volatile("" : "+v"(rb));
  const int swz = (rb & 7) << 4, rowb = rb * 256 + comp * 128;
  const char* a0 = Ks + rowb + ((0 * 32 + hi * 16) ^ swz); const char* a1 = Ks + rowb + ((1 * 32 + hi * 16) ^ swz);
  const char* a2 = Ks + rowb + ((2 * 32 + hi * 16) ^ swz); const char* a3 = Ks + rowb + ((3 * 32 + hi * 16) ^ swz);
#pragma unroll
  for (int d0 = 0; d0 < Cfg<MODE>::ND0; ++d0) { const int dl = d0 & 3, dh = d0 >> 2; const char* ap = (dl == 0 ? a0 : dl == 1 ? a1 : dl == 2 ? a2 : a3) + dh * 128;
    bf16x8 b0 = *reinterpret_cast<const bf16x8*>(ap);
    bf16x8 b1 = *reinterpret_cast<const bf16x8*>(ap + 8192);
    bf16x8 q; if constexpr (QLDS) q = *reinterpret_cast<const bf16x8*>(qs + d0 * 1024); else q = qr[d0];
    p0 = __builtin_amdgcn_mfma_f32_32x32x16_bf16(b0, q, p0, 0, 0, 0);
    p1 = __builtin_amdgcn_mfma_f32_32x32x16_bf16(b1, q, p1, 0, 0, 0); }
}
__device__ __forceinline__ int v_st(int k, int c) { const int kk = (k & ~0xC) | ((k & 4) << 1) | ((k & 8) >> 1); return ((kk >> 3) * 4 + (c >> 5)) * 512 + ((kk & 7) * 32 + (c & 31)) * 2; }
__device__ __forceinline__ int v_rd_base(int lane) { return ((lane & 3) << 3) | (((lane >> 2) & 3) << 6) | (((lane >> 4) & 1) << 5) | (((lane >> 5) & 1) << 8); }
constexpr int v_rd_off(int d0, int ks, int half) { return d0 * 512 + ks * 4096 + half * 2048; }
template <int OFF> __device__ __forceinline__ s16x4 tr_read(int vb) {
  s16x4 r; asm volatile("ds_read_b64_tr_b16 %0, %1 offset:%2" : "=&v"(r) : "v"(vb), "i"(OFF) : "memory"); return r;
}
template <int D0> __device__ __forceinline__ void pv_one(f32x16& od, int vb, bf16x8 pa0, bf16x8 pa1, bf16x8 pa2, bf16x8 pa3) {
  const s16x4 l0 = tr_read<v_rd_off(D0, 0, 0)>(vb), h0 = tr_read<v_rd_off(D0, 0, 1)>(vb), l1 = tr_read<v_rd_off(D0, 1, 0)>(vb), h1 = tr_read<v_rd_off(D0, 1, 1)>(vb);
  const s16x4 l2 = tr_read<v_rd_off(D0, 2, 0)>(vb), h2 = tr_read<v_rd_off(D0, 2, 1)>(vb), l3 = tr_read<v_rd_off(D0, 3, 0)>(vb), h3 = tr_read<v_rd_off(D0, 3, 1)>(vb);
  asm volatile("s_waitcnt lgkmcnt(0)" ::: "memory"); SBAR();
#define PK(L, H) (bf16x8){L[0], L[1], L[2], L[3], H[0], H[1], H[2], H[3]}
  od = __builtin_amdgcn_mfma_f32_32x32x16_bf16(pa0, PK(l0, h0), od, 0, 0, 0);
  od = __builtin_amdgcn_mfma_f32_32x32x16_bf16(pa1, PK(l1, h1), od, 0, 0, 0);
  od = __builtin_amdgcn_mfma_f32_32x32x16_bf16(pa2, PK(l2, h2), od, 0, 0, 0);
  od = __builtin_amdgcn_mfma_f32_32x32x16_bf16(pa3, PK(l3, h3), od, 0, 0, 0);
#undef PK
}
__device__ __forceinline__ void pv_d0(f32x16* o, int vb, bf16x8 pa0, bf16x8 pa1, bf16x8 pa2, bf16x8 pa3) {
  pv_one<0>(o[0], vb, pa0, pa1, pa2, pa3); pv_one<1>(o[1], vb, pa0, pa1, pa2, pa3); pv_one<2>(o[2], vb, pa0, pa1, pa2, pa3); pv_one<3>(o[3], vb, pa0, pa1, pa2, pa3);
}

struct UnitArgs {
    const bf16_t* Qb; int ldq;
    const bf16_t* Kh; const bf16_t* Vh;
    bf16_t* Ob; int ldo;
    int NT;
    int jwin, wadd;
    int masked, t0;
    float sinkl2;
    float lam;
    const float* subg;
};

template <int MODE>
__device__ __forceinline__ void attn_unit(const UnitArgs& A, char* lds) {
  constexpr float C = Cfg<MODE>::C; constexpr int ND0 = Cfg<MODE>::ND0;
  int tid_ = threadIdx.x; asm volatile("" : "+v"(tid_));
  const int tid = tid_, wid = tid >> 6, lane = tid & 63, r32 = lane & 31, hi = lane >> 5;
  const int wq = (MODE == 0) ? wid : (wid & 3), comp = (MODE == 0) ? 0 : (wid >> 2);
  char* V_lds = lds; char* K_lds = lds + 2 * SHM_V;
  float* ws = (float*)(lds + LDS_WS) + wid * 64; float* li_l = ws; float* al_l = ws + 32;
  constexpr bool QLDS = Cfg<MODE>::QLDS;
  __syncthreads();
  float m_reg = -1e30f, l_reg = 0; f32x16 o[4] = {}; bf16x8 qr[QLDS ? 1 : ND0];
  char* qs = lds + LDS_X + wid * 8192 + lane * 16;
  const bf16_t* Qw = A.Qb + (long)(wq * 32 + r32) * A.ldq + comp * 64 + hi * 8;
  if constexpr (QLDS) {
#pragma unroll
    for (int d0 = 0; d0 < ND0; ++d0) *reinterpret_cast<bf16x8*>(qs + d0 * 1024) = *reinterpret_cast<const bf16x8*>(Qw + d0 * 16);
  } else {
#pragma unroll
    for (int d0 = 0; d0 < ND0; ++d0) qr[d0] = *reinterpret_cast<const bf16x8*>(Qw + d0 * 16);
  }
  const int sr = tid >> 4, sc = (tid & 15) * 8, vst0 = v_st(sr, sc), vst1 = v_st(32 + sr, sc);
  const int vb0 = (int)(uintptr_t)V_lds + v_rd_base(lane);
  const unsigned loff0 = (unsigned)(sr * 128 + sc) * 2u, loff1 = loff0 + 32u * 256u;
  const bf16_t* Kh = A.Kh; const bf16_t* Vh = A.Vh; const int NT = A.NT, jwin = A.jwin, wadd = A.wadd;
  constexpr int SDEPTH = Cfg<MODE>::SDEPTH;
  struct { bf16x8 vs0, vs1, ks0, ks1; } sr_[SDEPTH];
#define KOFF(j) (64 * (j) + (((j) >= jwin) ? wadd : 0))
#define SLOAD(i, k0) do { const size_t _kb = (size_t)(k0) * 256; const char* _vp = (const char*)Vh + _kb; const char* _kp = (const char*)Kh + _kb; \
    sr_[i].vs0 = *(const GASQ bf16x8*)(_vp + loff0); sr_[i].vs1 = *(const GASQ bf16x8*)(_vp + loff1); \
    sr_[i].ks0 = *(const GASQ bf16x8*)(_kp + loff0); sr_[i].ks1 = *(const GASQ bf16x8*)(_kp + loff1); } while (0)
#define SWRITE(b, i) do { *(bf16x8*)(V_lds + (b) * SHM_V + vst0) = sr_[i].vs0;          \
    *(bf16x8*)(V_lds + (b) * SHM_V + vst1) = sr_[i].vs1; const int kc = sc * 2;               \
    *(bf16x8*)(K_lds + (b) * SHM_K + KSWZ(sr, kc)) = sr_[i].ks0;                       \
    *(bf16x8*)(K_lds + (b) * SHM_K + KSWZ(32 + sr, kc)) = sr_[i].ks1; } while (0)
#define SWAIT() do { if constexpr (SDEPTH == 2) asm volatile("s_waitcnt vmcnt(4)" ::: "memory"); else asm volatile("s_waitcnt vmcnt(0)" ::: "memory"); } while (0)
#define RESC(a) do { if (__any((a) < 1.f)) { if (hi == 0) al_l[r32] = (a); asm volatile("s_waitcnt lgkmcnt(0)" ::: "memory"); \
    _Pragma("unroll") for (int d = 0; d < 4; ++d) _Pragma("unroll") for (int r = 0; r < 16; ++r) o[d][r] *= al_l[crow(r, hi)]; } } while (0)
#define MASKT(P0, P1, j) do { if (MODE == 0 && !defined_NOMASK && A.masked && (j) >= jwin) { const int kp0 = KOFF(j) - 512, qw0 = A.t0 + wq * 32; \
    if (kp0 < qw0 + 31 - 128 || kp0 + 63 > qw0 + 128) { const int dkb = kp0 - qw0 - r32 + 4 * hi + 128; \
      _Pragma("unroll") for (int r = 0; r < 16; ++r) { const int cr = (r & 3) + 8 * (r >> 2); if ((unsigned)(dkb + cr) > 256u) P0[r] = -1e30f; if ((unsigned)(dkb + cr + 32) > 256u) P1[r] = -1e30f; } } } } while (0)
  f32x16 pA0, pA1, pB0, pB1; float mnA, mnB, alA, alB; bf16x8 pa0, pa1, pa2, pa3;
  constexpr int SE = 0, SO = SDEPTH - 1;
  SLOAD(SE, KOFF(0)); asm volatile("s_waitcnt vmcnt(0)" ::: "memory"); SWRITE(0, SE); __syncthreads();
  qkt<MODE, QLDS>(pA0, pA1, K_lds, qr, qs, r32, hi, comp); MASKT(pA0, pA1, 0); partialSM<MODE>(pA0, pA1, m_reg, mnA, alA);
  SLOAD(SO, KOFF(1)); if constexpr (SDEPTH == 2) { if (2 < NT) SLOAD(SE, KOFF(2)); }
  SWAIT(); SWRITE(1, SO); __syncthreads();
  for (int j = 1; j + 1 < NT; j += 2) {
    SBAR(); qkt<MODE, QLDS>(pB0, pB1, K_lds + SHM_K, qr, qs, r32, hi, comp);
    finishSM(pA0, pA1, alA, l_reg, pa0, pa1, pa2, pa3); SBAR();
    SLOAD(SO, KOFF(j + SDEPTH)); SBAR();
    pv_d0(o, vb0, pa0, pa1, pa2, pa3); MASKT(pB0, pB1, j); partialSM<MODE>(pB0, pB1, m_reg, mnB, alB);
    __syncthreads(); SWAIT(); SWRITE(0, SE);
    RESC(alB); __syncthreads();
    SBAR(); qkt<MODE, QLDS>(pA0, pA1, K_lds, qr, qs, r32, hi, comp);
    finishSM(pB0, pB1, alB, l_reg, pa0, pa1, pa2, pa3); SBAR();
    if (SDEPTH == 1 || j + 3 < NT) SLOAD(SE, KOFF(j + 1 + SDEPTH)); SBAR();
    pv_d0(o, vb0 + SHM_V, pa0, pa1, pa2, pa3); MASKT(pA0, pA1, j + 1); partialSM<MODE>(pA0, pA1, m_reg, mnA, alA);
    __syncthreads(); SWAIT(); SWRITE(1, SO);
    RESC(alA); __syncthreads();
  }
  SBAR(); qkt<MODE, QLDS>(pB0, pB1, K_lds + SHM_K, qr, qs, r32, hi, comp);
  finishSM(pA0, pA1, alA, l_reg, pa0, pa1, pa2, pa3); SBAR();
  pv_d0(o, vb0, pa0, pa1, pa2, pa3); MASKT(pB0, pB1, NT - 1); partialSM<MODE>(pB0, pB1, m_reg, mnB, alB);
  __syncthreads(); RESC(alB);
  finishSM(pB0, pB1, alB, l_reg, pa0, pa1, pa2, pa3); SBAR();
  pv_d0(o, vb0 + SHM_V, pa0, pa1, pa2, pa3);
  if (MODE == 0) l_reg += __builtin_amdgcn_exp2f(A.sinkl2 - m_reg * C);
  if (hi == 0) li_l[r32] = l_reg;
  asm volatile("s_waitcnt lgkmcnt(0)" ::: "memory");
  float rli[16];
#pragma unroll
  for (int r = 0; r < 16; ++r) rli[r] = __builtin_amdgcn_rcpf(li_l[crow(r, hi)]);
  bf16_t* Ow = A.Ob + (long)(wq * 32) * A.ldo;
  const int odd = lane & 1;
  if (MODE == 0) {
#pragma unroll
    for (int d0 = 0; d0 < 4; ++d0)
#pragma unroll
      for (int rp = 0; rp < 8; ++rp) {
        const float a = o[d0][2 * rp] * rli[2 * rp], b = o[d0][2 * rp + 1] * rli[2 * rp + 1];
        const float send = odd ? a : b; const float recv = __shfl_xor(send, 1);
        const float lo = odd ? recv : a, hh = odd ? b : recv;
        const int row = crow(2 * rp + odd, hi);
        *(unsigned*)(Ow + (long)row * A.ldo + d0 * 32 + (r32 & ~1)) = cvtpk(lo, hh);
      }
  } else {
    float* X = (float*)(lds + LDS_X) + wq * (32 * 128);
    if (comp == 1) {
      const float lam = A.lam;
#pragma unroll
      for (int d0 = 0; d0 < 4; ++d0)
#pragma unroll
        for (int r = 0; r < 16; ++r) X[crow(r, hi) * 128 + d0 * 32 + r32] = o[d0][r] * rli[r] * lam;
    }
    __syncthreads();
    if (comp == 0) {
      float rs[16];
#pragma unroll
      for (int r = 0; r < 16; ++r) { float ss = 0.f;
#pragma unroll
        for (int d0 = 0; d0 < 4; ++d0) { const float v = o[d0][r] * rli[r] - X[crow(r, hi) * 128 + d0 * 32 + r32]; o[d0][r] = v; ss += v * v; }
        ss += __shfl_xor(ss, 1); ss += __shfl_xor(ss, 2); ss += __shfl_xor(ss, 4); ss += __shfl_xor(ss, 8); ss += __shfl_xor(ss, 16);
        rs[r] = __builtin_amdgcn_rsqf(ss * (1.f / 128.f) + 1e-6f) * 0.8f; }
#pragma unroll
      for (int d0 = 0; d0 < 4; ++d0) { const float g = A.subg[d0 * 32 + r32];
#pragma unroll
        for (int rp = 0; rp < 8; ++rp) {
          const float a = o[d0][2 * rp] * rs[2 * rp] * g, b = o[d0][2 * rp + 1] * rs[2 * rp + 1] * g;
          const float send = odd ? a : b; const float recv = __shfl_xor(send, 1);
          const float lo = odd ? recv : a, hh = odd ? b : recv;
          const int row = crow(2 * rp + odd, hi);
          *(unsigned*)(Ow + (long)row * A.ldo + d0 * 32 + (r32 & ~1)) = cvtpk(lo, hh);
        } }
    }
  }
#undef KOFF
#undef SLOAD
#undef SWRITE
#undef SWAIT
#undef RESC
#undef MASKT
}
#undef KSWZ
#undef GASQ
#undef SBAR
}

#define GAS __attribute__((address_space(1)))
#define LAS __attribute__((address_space(3)))
typedef unsigned short bf16;
typedef unsigned v4u __attribute__((ext_vector_type(4)));
typedef float f32x4 __attribute__((ext_vector_type(4)));
typedef short bf16x8 __attribute__((ext_vector_type(8)));
typedef GAS unsigned gu32;
typedef GAS unsigned long long gu64;
#define RLX_AGENT __ATOMIC_RELAXED, __HIP_MEMORY_SCOPE_AGENT
#define LDS_WAIT() asm volatile("s_waitcnt lgkmcnt(0)" ::: "memory")
#define VM_WAIT() asm volatile("s_waitcnt vmcnt(0)" ::: "memory")
__device__ __forceinline__ unsigned long long rt() { return __builtin_amdgcn_s_memrealtime(); }
__device__ __forceinline__ unsigned f2bf(float f) { unsigned u = __builtin_bit_cast(unsigned, f); return (u + 0x7fffu + ((u >> 16) & 1u)) >> 16; }
__device__ __forceinline__ unsigned pk2(float lo, float hi) { return f2bf(lo) | (f2bf(hi) << 16); }

#define XB_TMO      128
#define XB_XCNT(j)  (256  + 64 * (j))
#define XB_XSUB(j)  (1280 + 64 * (j))
#define XB_XGEN(j)  (2304 + 64 * (j))
#define XB_TOP      3328
#define XB_TOPGEN   3392
#define XCD_BAR_WORDS 3456
#define XB_SPIN_CAP (1u << 18)

__device__ __forceinline__ unsigned xb_ld(unsigned* p)              { return __hip_atomic_load(p, __ATOMIC_RELAXED, __HIP_MEMORY_SCOPE_AGENT); }
__device__ __forceinline__ unsigned xb_add(unsigned* p, unsigned v) { return __hip_atomic_fetch_add(p, v, __ATOMIC_RELAXED, __HIP_MEMORY_SCOPE_AGENT); }
__device__ __forceinline__ unsigned xb_xcc_id() { return (unsigned)__builtin_amdgcn_s_getreg((3 << 11) | 20) & 0xFu; }
#define XB_SPIN(cond, bar) do { unsigned _sp = 0; while (cond) { __builtin_amdgcn_s_sleep(1); \
    if ((++_sp & 255u) == 0u) { if (xb_ld(&(bar)[XB_TMO])) break; if (_sp > XB_SPIN_CAP) { atomicAdd(&(bar)[XB_TMO], 1u); break; } } } } while (0)

struct XcdBarrier {
    unsigned* bar; unsigned x;
    volatile LAS unsigned* st;
};

__device__ __forceinline__ XcdBarrier xcd_barrier_post(unsigned* bar, volatile LAS unsigned* st) {
    XcdBarrier b; b.bar = bar; b.x = xb_xcc_id(); b.st = st;
    if (threadIdx.x == 0) (void)xb_add(&bar[XB_XCNT(b.x)], 1u);
    return b;
}
__device__ __forceinline__ void xcd_barrier_complete(unsigned* bar, unsigned x, unsigned& nloc, unsigned& nx) {
    const unsigned G = gridDim.x * gridDim.y * gridDim.z;
    unsigned sum, cnt, mine, sp = 0u;
    for (;;) {
        sum = 0u; cnt = 0u; mine = 0u;
#pragma unroll
        for (unsigned j = 0; j < 16; ++j) { const unsigned c = xb_ld(&bar[XB_XCNT(j)]); sum += c; cnt += (c > 0u) ? 1u : 0u; mine = (j == x) ? c : mine; }
        if (sum == G) break;
        __builtin_amdgcn_s_sleep(1);
        if ((++sp & 255u) == 0u) { if (xb_ld(&bar[XB_TMO])) break; if (sp > XB_SPIN_CAP) { atomicAdd(&bar[XB_TMO], 1u); break; } }
    }
    nloc = mine > 0u ? mine : 1u; nx = cnt > 0u ? cnt : 1u;
}

__device__ __forceinline__ void xcd_barrier(const XcdBarrier& b) {
    asm volatile("s_waitcnt vmcnt(0)" ::: "memory");
    __syncthreads();
    if (threadIdx.x == 0) {
        unsigned* bar = b.bar;
        __builtin_amdgcn_s_waitcnt(0);
        unsigned nloc = b.st[0], nx = b.st[1];
        if (nloc == 0u) { xcd_barrier_complete(bar, b.x, nloc, nx); b.st[0] = nloc; b.st[1] = nx; }
        const unsigned old = xb_add(&bar[XB_XSUB(b.x)], 1u);
        const unsigned gen = old / nloc;
        if (old + 1u == (gen + 1u) * nloc) {
            __builtin_amdgcn_fence(__ATOMIC_RELEASE, "agent");
            asm volatile("s_waitcnt vmcnt(0)" ::: "memory");
            const unsigned og = xb_add(&bar[XB_TOP], 1u);
            const unsigned tg = og / nx;
            if (og + 1u == (tg + 1u) * nx) xb_add(&bar[XB_TOPGEN], 1u);
            else XB_SPIN(xb_ld(&bar[XB_TOPGEN]) == tg, bar);
            __builtin_amdgcn_fence(__ATOMIC_ACQUIRE, "agent");
            xb_add(&bar[XB_XGEN(b.x)], 1u);
            asm volatile("s_waitcnt vmcnt(0)" ::: "memory");
        } else {
            XB_SPIN(xb_ld(&bar[XB_XGEN(b.x)]) == gen, bar);
            __builtin_amdgcn_fence(__ATOMIC_ACQUIRE, "agent");
            asm volatile("s_waitcnt vmcnt(0)" ::: "memory");
        }
    }
    __syncthreads();
}
#ifndef MK_N_LAUNCHES
#define MK_N_LAUNCHES 1
#endif
constexpr int NPH = 9;
constexpr int N_LAUNCHES = MK_N_LAUNCHES;
constexpr int NWAVES = 8;

constexpr int DM = 4096, DIN = 6144, DFF = 16384, NMOD = 6 * DM;
constexpr int NB_P = 16, T_P = 256, NB_S = 8, T_S = 1024, LCTX = 512;
constexpr int M_P = NB_P * T_P, M_S = NB_S * T_S, MTOK = M_P + M_S;
constexpr int KSPLIT = 8;
constexpr int KVL = LCTX + T_S;
constexpr float EPS = 1e-6f;

constexpr size_t MiB = 1u << 20;
constexpr size_t WS_CTL = 0, CTL_ZERO_BYTES = 1 * MiB;
constexpr size_t WS_MODP = 1 * MiB;
constexpr size_t WS_MODF = 8 * MiB;
constexpr size_t WS_WIN = 16 * MiB, WS_WOUT = 64 * MiB, WS_WFC1 = 96 * MiB, WS_WFC2 = 224 * MiB;
constexpr size_t WS_H = 352 * MiB;
constexpr size_t WS_P = 448 * MiB;
constexpr size_t WS_O = 592 * MiB;
constexpr size_t WS_KVL = 688 * MiB, KVL_SZ = (size_t)NB_S * 4 * KVL * 128 * 2;
constexpr size_t WS_KVP = 736 * MiB, KVP_SZ = (size_t)NB_P * 4 * T_P * 128 * 2;
constexpr size_t WS_U = 752 * MiB;
constexpr size_t WS_END = 1136 * MiB;
static_assert(WS_MODP + (size_t)KSPLIT * 9 * NMOD * 4 <= WS_MODF && WS_MODF + (size_t)9 * NMOD * 4 <= WS_WIN, "ws map");
static_assert(KVL_SZ == 12 * MiB && KVP_SZ == 4 * MiB && WS_U + (size_t)MTOK * DFF * 2 == WS_END, "ws map");
constexpr int CW_Q = 64;
constexpr int CW_BAR = 4096;

constexpr int RING_BYTES = 131072;
constexpr int MISC_OFF = 143360;
constexpr int LDS_BYTES = 147456;
static_assert(att::LDS_BYTES <= MISC_OFF && RING_BYTES <= MISC_OFF && MISC_OFF + 128 <= LDS_BYTES && 8 * 64 * 68 * 4 <= MISC_OFF, "LDS map");

__device__ __forceinline__ float wave_sum(float v) {
#pragma unroll
    for (int o = 1; o < 64; o <<= 1) v += __shfl_xor(v, o);
    return v;
}
__device__ __forceinline__ float bf2f(unsigned short b) { return __uint_as_float(((unsigned)b) << 16); }

__device__ __forceinline__ int fresh_tid() { int t = threadIdx.x; asm volatile("" : "+v"(t)); return t; }
struct Args { const float* in[26]; float* out; unsigned char* ws; int ph_lo, ph_hi; };

constexpr int TR_LDS = 64 * 68 * 4;
__device__ __forceinline__ unsigned cvtpk_rne(float lo, float hi) { unsigned r; asm volatile("v_cvt_pk_bf16_f32 %0, %1, %2" : "=v"(r) : "v"(lo), "v"(hi)); return r; }
__device__ __forceinline__ void p0_transpose_item(const float* W, int K, int N, bf16* WT, LAS float* scr, int item, int lane) {
    const int nblk = N / 64, kb = item / nblk, nb = item - kb * nblk, k0 = 64 * kb, n0 = 64 * nb;
    const int lr = lane >> 4, lc = (lane & 15) * 4;
    const GAS f32x4* src = (const GAS f32x4*)(W + (size_t)(k0 + lr) * N + n0 + lc);
    f32x4 v[16];
#pragma unroll
    for (int i = 0; i < 16; ++i) v[i] = src[(size_t)i * N];
#pragma unroll
    for (int i = 0; i < 16; ++i) { const int k = lr + 4 * i; *(LAS f32x4*)(scr + k * 68 + (lc ^ ((k >> 3) << 2))) = v[i]; }
    LDS_WAIT(); asm volatile("" ::: "memory");
    const int kc = lane & 7, nl = lane >> 3;
#pragma unroll
    for (int j = 0; j < 8; ++j) { const int n = nl + 8 * j; const LAS float* s = scr + (8 * kc) * 68 + (n ^ (kc << 2));
        v4u o; o.x = cvtpk_rne(s[0 * 68], s[1 * 68]); o.y = cvtpk_rne(s[2 * 68], s[3 * 68]); o.z = cvtpk_rne(s[4 * 68], s[5 * 68]); o.w = cvtpk_rne(s[6 * 68], s[7 * 68]);
        *(GAS v4u*)(WT + (size_t)(n0 + n) * K + k0 + 8 * kc) = o; }
    LDS_WAIT(); asm volatile("" ::: "memory");
}
__device__ __forceinline__ void mod_block_item(const Args& a, LAS unsigned char* ldsl, int cc, int kq8, int tid, int lane, int wave) {
    const float* cmat = a.in[6]; const float* cctx = a.in[7]; const float* Wm = a.in[8]; float* part = (float*)(a.ws + WS_MODP);
    f32x4 acc[9];
#pragma unroll
    for (int r = 0; r < 9; ++r) acc[r] = (f32x4){0.f, 0.f, 0.f, 0.f};
    const int krow = kq8 * 512 + wave * 64;
    const GAS f32x4* wp = (const GAS f32x4*)(Wm + (size_t)krow * NMOD + cc * 256) + lane;
    float sv[9];
#pragma unroll
    for (int r = 0; r < 9; ++r) { const float cv = (r < 8) ? cmat[r * DM + krow + lane] : cctx[krow + lane]; sv[r] = cv / (1.f + __expf(-cv)); }
    for (int i0 = 0; i0 < 64; i0 += 16) {
        f32x4 w[16];
#pragma unroll
        for (int i = 0; i < 16; ++i) w[i] = wp[(size_t)(i0 + i) * (NMOD / 4)];
#pragma unroll
        for (int i = 0; i < 16; ++i)
#pragma unroll
            for (int r = 0; r < 9; ++r) { const float s = __uint_as_float(__builtin_amdgcn_readlane(__float_as_uint(sv[r]), i0 + i)); acc[r] += w[i] * s; }
    }
    LAS f32x4* red = (LAS f32x4*)ldsl;
    __syncthreads();
#pragma unroll
    for (int r = 0; r < 9; ++r) red[(wave * 9 + r) * 64 + lane] = acc[r];
    __syncthreads();
    for (int o = tid; o < 9 * 64; o += NWAVES * 64) { const int r = o >> 6, l = o & 63; f32x4 s = red[r * 64 + l];
#pragma unroll
        for (int w2 = 1; w2 < NWAVES; ++w2) s += red[(w2 * 9 + r) * 64 + l];
        *((GAS f32x4*)(part + (size_t)(kq8 * 9 + r) * NMOD + cc * 256) + l) = s; }
    __syncthreads();
}
constexpr int BG_MOD = 64 * KSPLIT, BG_TR = ((DM / 64) * (DM / 64) + (DM / 64) * (DFF / 64) + (DFF / 64) * (DM / 64)) / 8, N_BG = BG_MOD + BG_TR;
#ifndef BG_Q2
#define BG_Q2 1024
#endif
__device__ __forceinline__ void bg_items(const Args& a, LAS unsigned char* ldsl, int lo, int hi, int start, int stride, int tid, int lane, int wave) {
    constexpr int I_OUT = (DM / 64) * (DM / 64), I_FC1 = (DM / 64) * (DFF / 64);
    LAS float* scr = (LAS float*)(ldsl + wave * TR_LDS);
    for (int bi = lo + start; bi < hi; bi += stride) {
        if (bi < BG_MOD) { mod_block_item(a, ldsl, 32 + (bi & 63), bi >> 6, tid, lane, wave); continue; }
        int r = (bi - BG_MOD) * 8 + wave;
        if (r < I_OUT) { p0_transpose_item(a.in[22], DM, DM, (bf16*)(a.ws + WS_WOUT), scr, r, lane); continue; } r -= I_OUT;
        if (r < I_FC1) { p0_transpose_item(a.in[24], DM, DFF, (bf16*)(a.ws + WS_WFC1), scr, r, lane); continue; } r -= I_FC1;
        p0_transpose_item(a.in[25], DFF, DM, (bf16*)(a.ws + WS_WFC2), scr, r, lane);
    }
}

template <int WHICH>
__device__ __forceinline__ void norm_phase(const Args& a, LAS unsigned char* lds, int vcu, int G, int wave) {
    const int tid = fresh_tid(), lane = tid & 63;
    LAS float* Gv = (LAS float*)lds; LAS float* Sv = Gv + DM;
    const float* bmod = a.in[9]; const float* part = (const float*)(a.ws + WS_MODP); float* modf = (float*)(a.ws + WS_MODF);
    const float* gn = WHICH == 0 ? a.in[10] : a.in[23];
    bf16* H = (bf16*)(a.ws + WS_H);
    const int rows_per = (MTOK + G - 1) / G; int m = vcu * rows_per; const int mend = (m + rows_per < MTOK) ? m + rows_per : MTOK;
    while (m < mend) {
        const int r = (m < M_P) ? 8 : (m - M_P) / T_S;
        const int bnd = (m < M_P) ? M_P : M_P + (r + 1) * T_S; const int send = bnd < mend ? bnd : mend;
        __syncthreads();
        for (int c = tid; c < DM; c += NWAVES * 64) {
            float sh, sc;
            if (WHICH == 0) { sh = bmod[c]; sc = bmod[DM + c];
#pragma unroll
                for (int p = 0; p < KSPLIT; ++p) { sh += part[((size_t)p * 9 + r) * NMOD + c]; sc += part[((size_t)p * 9 + r) * NMOD + DM + c]; } }
            else { sh = modf[(size_t)r * NMOD + 3 * DM + c]; sc = modf[(size_t)r * NMOD + 4 * DM + c]; }
            Gv[c] = gn[c] * (1.f + sc); Sv[c] = sh; }
        __syncthreads();
        for (int mm = m + wave; mm < send; mm += NWAVES) {
            const float* xrow = (WHICH == 0) ? ((mm < M_P) ? a.in[0] + (size_t)mm * DM : a.in[1] + (size_t)(mm - M_P) * DM) : a.out + (size_t)mm * DM;
            const GAS f32x4* xr = (const GAS f32x4*)xrow + lane;
            f32x4 v[16]; float s = 0.f;
#pragma unroll
            for (int j = 0; j < 16; ++j) { v[j] = xr[64 * j]; s += (v[j].x * v[j].x + v[j].y * v[j].y) + (v[j].z * v[j].z + v[j].w * v[j].w); }
            const float rstd = __builtin_amdgcn_rsqf(wave_sum(s) * (1.f / DM) + EPS);
            GAS unsigned long long* o8 = (GAS unsigned long long*)(H + (size_t)mm * DM) + lane;
#pragma unroll
            for (int j = 0; j < 16; ++j) { const f32x4 g = *(const LAS f32x4*)(Gv + 4 * lane + 256 * j), sh = *(const LAS f32x4*)(Sv + 4 * lane + 256 * j);
                const f32x4 y = v[j] * rstd * g + sh;
                o8[64 * j] = (unsigned long long)pk2(y.x, y.y) | ((unsigned long long)pk2(y.z, y.w) << 32); }
        }
        m = send;
    }
    __syncthreads();
}

__device__ __forceinline__ void qk_item(const Args& a, const v4u raw, int it, int lane, bf16* P, float* onew, const LAS float* c128, const LAS float* s128, const LAS float* c64, const LAS float* s64) {
    const int sub = lane & 15, sg = lane >> 4;
    const int m = it / 12, grp = it - m * 12; bf16* src = P + (size_t)m * DIN + grp * 512 + lane * 8;
        float x[8];
        x[0] = __uint_as_float(raw.x << 16); x[1] = __uint_as_float(raw.x & 0xffff0000u); x[2] = __uint_as_float(raw.y << 16); x[3] = __uint_as_float(raw.y & 0xffff0000u);
        x[4] = __uint_as_float(raw.z << 16); x[5] = __uint_as_float(raw.z & 0xffff0000u); x[6] = __uint_as_float(raw.w << 16); x[7] = __uint_as_float(raw.w & 0xffff0000u);
        const bool lat = m >= M_P; const int t = lat ? (m - M_P) % T_S : m % T_P; const int b = lat ? (m - M_P) / T_S : m / T_P;
        const bool is_v = (grp == 5 || grp == 11);
        const bool is_a = grp < 6;
        if (!is_v) {
            float ss = 0.f;
#pragma unroll
            for (int e = 0; e < 8; ++e) ss += x[e] * x[e];
            ss += __shfl_xor(ss, 1); ss += __shfl_xor(ss, 2); ss += __shfl_xor(ss, 4);
            if (is_a) ss += __shfl_xor(ss, 8);
            const float rstd = __builtin_amdgcn_rsqf(ss * (is_a ? (1.f / 128.f) : (1.f / 64.f)) + EPS);
            const float* gp = (grp < 4) ? a.in[12] : (grp == 4) ? a.in[13] : (grp < 10) ? a.in[14] : a.in[15];
            const int goff = is_a ? sub * 8 : (sub & 7) * 8;
            const f32x4 g0 = *(const GAS f32x4*)(gp + goff), g1 = *(const GAS f32x4*)(gp + goff + 4);
            x[0] *= rstd * g0.x; x[1] *= rstd * g0.y; x[2] *= rstd * g0.z; x[3] *= rstd * g0.w; x[4] *= rstd * g1.x; x[5] *= rstd * g1.y; x[6] *= rstd * g1.z; x[7] *= rstd * g1.w;
            if (lat) {
                float px[8];
                if (is_a) {
#pragma unroll
                    for (int e = 0; e < 8; ++e) px[e] = __shfl_xor(x[e], 4);
                    const int axis = (sub >> 3) & 1, half = (sub >> 2) & 1, i0 = (sub & 3) * 8, pos = axis ? (t & 63) : (t >> 6);
#pragma unroll
                    for (int e = 0; e < 8; ++e) { const float cs = c128[pos * 32 + i0 + e], sn = s128[pos * 32 + i0 + e]; x[e] = half ? (x[e] * cs + px[e] * sn) : (x[e] * cs - px[e] * sn); }
                } else {
#pragma unroll
                    for (int e = 0; e < 8; ++e) px[e] = __shfl_xor(x[e], 2);
                    const int s8 = sub & 7, axis = (s8 >> 2) & 1, half = (s8 >> 1) & 1, i0 = (s8 & 1) * 8, pos = axis ? (t & 63) : (t >> 6);
#pragma unroll
                    for (int e = 0; e < 8; ++e) { const float cs = c64[pos * 16 + i0 + e], sn = s64[pos * 16 + i0 + e]; x[e] = half ? (x[e] * cs + px[e] * sn) : (x[e] * cs - px[e] * sn); }
                }
            }
        }
        v4u ob; ob.x = pk2(x[0], x[1]); ob.y = pk2(x[2], x[3]); ob.z = pk2(x[4], x[5]); ob.w = pk2(x[6], x[7]);
        const bool is_q = (grp < 4) || (grp >= 6 && grp < 10);
        if (is_q) { *(GAS v4u*)src = ob; }
        else {
            const int which = (grp == 4) ? 0 : (grp == 5) ? 1 : (grp == 10) ? 2 : 3;
            const int kv = sg;
            if (lat) { *(GAS v4u*)((bf16*)(a.ws + WS_KVL + (size_t)which * KVL_SZ) + ((size_t)(b * 4 + kv) * KVL + LCTX + t) * 128 + sub * 8) = ob; }
            else { *(GAS v4u*)((bf16*)(a.ws + WS_KVP + (size_t)which * KVP_SZ) + ((size_t)(b * 4 + kv) * T_P + t) * 128 + sub * 8) = ob;
                GAS f32x4* of = (GAS f32x4*)(onew + (size_t)which * M_P * 512 + (size_t)m * 512 + kv * 128 + sub * 8);
                of[0] = (f32x4){x[0], x[1], x[2], x[3]}; of[1] = (f32x4){x[4], x[5], x[6], x[7]}; }
        }

}
__device__ __forceinline__ void qk_phase(const Args& a, LAS unsigned char* lds, int vcu, int G, int wave) {
    const int tid = fresh_tid(), lane = tid & 63;
    LAS float* c128 = (LAS float*)lds; LAS float* s128 = c128 + 2048; LAS float* c64 = s128 + 2048; LAS float* s64 = c64 + 1024;
    for (int e = tid; e < 2048; e += NWAVES * 64) { const int pos = e >> 5, i = e & 31; const float f = exp2f(-(float)i * (13.287712379549449f / 32.f)); float sn, cs; sincosf((float)pos * f, &sn, &cs); c128[e] = cs; s128[e] = sn; }
    for (int e = tid; e < 1024; e += NWAVES * 64) { const int pos = e >> 4, i = e & 15; const float f = exp2f(-(float)i * (13.287712379549449f / 16.f)); float sn, cs; sincosf((float)pos * f, &sn, &cs); c64[e] = cs; s64[e] = sn; }
    __syncthreads();
    bf16* P = (bf16*)(a.ws + WS_P);
    float* onew = a.out + (size_t)MTOK * DM;
    const int gw = vcu * NWAVES + wave, NGW = G * NWAVES;
#define QK_SRC(it_) (P + (size_t)((it_) / 12) * DIN + ((it_) % 12) * 512 + lane * 8)
    for (int it = gw; it < MTOK * 12; it += 4 * NGW) {
        const int it1 = it + NGW, it2 = it + 2 * NGW, it3 = it + 3 * NGW;
        v4u r0, r1 = {0u, 0u, 0u, 0u}, r2 = {0u, 0u, 0u, 0u}, r3 = {0u, 0u, 0u, 0u};
        r0 = *(const GAS v4u*)QK_SRC(it);
        if (it1 < MTOK * 12) r1 = *(const GAS v4u*)QK_SRC(it1);
        if (it2 < MTOK * 12) r2 = *(const GAS v4u*)QK_SRC(it2);
        if (it3 < MTOK * 12) r3 = *(const GAS v4u*)QK_SRC(it3);
        qk_item(a, r0, it, lane, P, onew, c128, s128, c64, s64);
        if (it1 < MTOK * 12) qk_item(a, r1, it1, lane, P, onew, c128, s128, c64, s64);
        if (it2 < MTOK * 12) qk_item(a, r2, it2, lane, P, onew, c128, s128, c64, s64);
        if (it3 < MTOK * 12) qk_item(a, r3, it3, lane, P, onew, c128, s128, c64, s64);
    }
#undef QK_SRC
    __syncthreads();
}

__device__ __forceinline__ void attn_phase(const Args& a, unsigned char* lds_g, int G, int wave) {
    const int lane = fresh_tid() & 63;
    const bf16* P = (const bf16*)(a.ws + WS_P); bf16* O = (bf16*)(a.ws + WS_O);
    const bf16* KA_l = (const bf16*)(a.ws + WS_KVL); const bf16* VA_l = (const bf16*)(a.ws + WS_KVL + KVL_SZ); const bf16* KB_l = (const bf16*)(a.ws + WS_KVL + 2 * KVL_SZ); const bf16* VB_l = (const bf16*)(a.ws + WS_KVL + 3 * KVL_SZ);
    const bf16* KA_p = (const bf16*)(a.ws + WS_KVP); const bf16* VA_p = (const bf16*)(a.ws + WS_KVP + KVP_SZ); const bf16* KB_p = (const bf16*)(a.ws + WS_KVP + 2 * KVP_SZ); const bf16* VB_p = (const bf16*)(a.ws + WS_KVP + 3 * KVP_SZ);
    float* misc = (float*)(lds_g + att::LDS_MISC);
    if (wave == 0) { const float p1 = a.in[17][lane] * a.in[18][lane], p2 = a.in[19][lane] * a.in[20][lane];
        const float s1 = wave_sum(p1), s2 = wave_sum(p2); if (lane == 0) misc[0] = __expf(s1) - __expf(s2) + 0.2f; }
    __syncthreads();
    const float lam = misc[0];
    const int nper = G / 8;
    const int c = blockIdx.x, x = c % 8, j = c / 8;
    att::UnitArgs U;
#ifndef ATT_NO_MODE1
    for (int u = c; u < NB_S * 16 * 8 + NB_P * 16 * 2; u += G) {
        const bool lat = u < NB_S * 16 * 8; const int uu = lat ? u : u - NB_S * 16 * 8; const int i = uu / G;
        int gid, g, qb;
        if (lat) { if (G == 256) { gid = i * 8 + x; g = j >> 3; qb = j & 7; } else { gid = uu >> 5; g = (uu >> 3) & 3; qb = uu & 7; } }
        else     { if (G == 256) { gid = (i * 8 + x) * 4 + (j >> 3); g = (j >> 1) & 3; qb = j & 1; } else { gid = uu >> 3; g = (uu >> 1) & 3; qb = uu & 1; } }
        const int b = gid >> 2, kv = gid & 3, h = kv * 4 + g; const int m0 = lat ? M_P + b * T_S + qb * 128 : b * T_P + qb * 128;
        const size_t kvoff = lat ? (size_t)(b * 4 + kv) * KVL * 128 : (size_t)(b * 4 + kv) * T_P * 128;
        U.Qb = P + (size_t)m0 * DIN + 3072 + h * 128; U.ldq = DIN; U.Kh = (lat ? KB_l : KB_p) + kvoff; U.Vh = (lat ? VB_l : VB_p) + kvoff;
        U.Ob = O + (size_t)m0 * DM + 2048 + h * 128; U.ldo = DM; U.NT = lat ? KVL / 64 : T_P / 64; U.jwin = 1 << 30; U.wadd = 0; U.masked = 0; U.t0 = 0; U.sinkl2 = 0.f; U.lam = lam; U.subg = a.in[21];
        att::attn_unit<1>(U, (char*)lds_g);
    }
#endif
#ifndef ATT_NO_MODE0
    for (int u = c; u < NB_S * 16 * 4 + NB_P * 16; u += G) {
        const bool lat = u < NB_S * 16 * 4; const int uu = lat ? u : u - NB_S * 16 * 4; const int i = uu / G;
        int gid, g, qb2;
        if (lat) { if (G == 256) { gid = (i * 8 + x) * 2 + (j >> 4); g = (j >> 2) & 3; qb2 = j & 3; } else { gid = uu >> 4; g = (uu >> 2) & 3; qb2 = uu & 3; } }
        else     { if (G == 256) { gid = x * 8 + (j >> 2); g = j & 3; qb2 = 0; } else { gid = uu >> 2; g = uu & 3; qb2 = 0; } }
        const int b = gid >> 2, kv = gid & 3, h = kv * 4 + g; const int t0 = qb2 * 256, m0 = lat ? M_P + b * T_S + t0 : b * T_P;
        const int wstart = (t0 - 128 > 0) ? t0 - 128 : 0, wend = (t0 + 384 < T_S) ? t0 + 384 : T_S;
        const size_t kvoff = lat ? (size_t)(b * 4 + kv) * KVL * 128 : (size_t)(b * 4 + kv) * T_P * 128;
        U.Qb = P + (size_t)m0 * DIN + h * 128; U.ldq = DIN; U.Kh = (lat ? KA_l : KA_p) + kvoff; U.Vh = (lat ? VA_l : VA_p) + kvoff;
        U.Ob = O + (size_t)m0 * DM + h * 128; U.ldo = DM; U.NT = lat ? 8 + (wend - wstart) / 64 : T_P / 64; U.jwin = lat ? 8 : (1 << 30); U.wadd = lat ? wstart : 0; U.masked = lat ? 1 : 0; U.t0 = t0;
        U.sinkl2 = a.in[16][h] * att::LOG2E; U.lam = 0.f; U.subg = nullptr;
        att::attn_unit<0>(U, (char*)lds_g);
    }
#endif
    __syncthreads();
}


__device__ __forceinline__ void p0_phase(const Args& args, LAS unsigned char* ldsl, int vcu, int G, int wave) {
    const int tid = fresh_tid(), lane = tid & 63;
    for (int it = vcu; it < 32 * KSPLIT; it += G) mod_block_item(args, ldsl, it & 31, it >> 5, tid, lane, wave);
}
__device__ __forceinline__ void p1_extras(const Args& args, LAS unsigned char* ldsl, int vcu, int G, int wave) {
    const int lane = fresh_tid() & 63;
    LAS float* scr = (LAS float*)(ldsl + wave * TR_LDS);
    constexpr int I_IN = (DM / 64) * (DIN / 64);
    for (int r = vcu * NWAVES + wave; r < I_IN; r += G * NWAVES) p0_transpose_item(args.in[11], DM, DIN, (bf16*)(args.ws + WS_WIN), scr, r, lane);
    for (int it = vcu * NWAVES + wave; it < 4 * 4096; it += G * NWAVES) {
        const int tsr = it >> 12, w = it & 4095; const size_t e = ((size_t)w * 64 + lane) * 8;
        const float* src = args.in[2 + tsr] + e; const f32x4 v0 = *(const GAS f32x4*)src, v1 = *(const GAS f32x4*)(src + 4);
        const int d = (int)(e & 127), kv = (int)((e >> 7) & 3), key = (int)((e >> 9) & 511), b = (int)(e >> 18);
        v4u o; o.x = pk2(v0.x, v0.y); o.y = pk2(v0.z, v0.w); o.z = pk2(v1.x, v1.y); o.w = pk2(v1.z, v1.w);
        *(GAS v4u*)((bf16*)(args.ws + WS_KVL + tsr * KVL_SZ) + ((size_t)(b * 4 + kv) * KVL + key) * 128 + d) = o; }
}
__device__ __forceinline__ void p3_extras(const Args& args, LAS unsigned char* ldsl, int vcu, int G, int q2, int wave) {
    const int tid = fresh_tid(), lane = tid & 63;
    bg_items(args, ldsl, q2, N_BG, vcu, G, tid, lane, wave);
    __syncthreads();
}
__device__ __forceinline__ void modf_rest(const Args& args, int vcu, int G) {
    const int tid = fresh_tid();
    const float* bmod = args.in[9]; const float* part = (const float*)(args.ws + WS_MODP); float* modf = (float*)(args.ws + WS_MODF);
    for (int e = vcu * (NWAVES * 64) + tid; e < 9 * 4 * DM; e += G * NWAVES * 64) { const int r = e / (4 * DM), n = 2 * DM + e % (4 * DM);
        float s = bmod[n];
#pragma unroll
        for (int p = 0; p < KSPLIT; ++p) s += part[((size_t)p * 9 + r) * NMOD + n];
        modf[(size_t)r * NMOD + n] = s; }
}
#ifndef GEMM_ALIGN
#define GEMM_ALIGN true
#endif
#ifndef GEMM_SP2
#define GEMM_SP2 true
#endif
#ifndef U_NT
#define U_NT true
#endif
constexpr int P2_G = 232;
__device__ __forceinline__ void p2_phase(const Args& args, LAS unsigned char* ldsl, int G, int bx, int wave) {
    const bool split = (G == 256);
    if (!split || bx < P2_G) {
        pg8::Gemm g{(const pg8::bf16_t*)(args.ws + WS_H), (const pg8::bf16_t*)(args.ws + WS_WIN), MTOK, DIN, DM}; pg8::StaticOrder S; S.init(MTOK, DIN, split ? P2_G : G, bx);
        pg8::EpiBf16<0> E{(pg8::bf16_t*)(args.ws + WS_P), DIN};
        pg8::gemm_phase<pg8::EpiBf16<0>, pg8::StaticOrder, GEMM_ALIGN, GEMM_SP2>(ldsl, g, S, E);
    } else {
        const int tid = fresh_tid(), lane = tid & 63;
        bg_items(args, ldsl, 0, BG_Q2, bx - P2_G, G - P2_G, tid, lane, wave);
    }
}
__device__ __forceinline__ void p5_phase(const Args& args, LAS unsigned char* ldsl, int G, int bx) {
    pg8::Gemm g{(const pg8::bf16_t*)(args.ws + WS_O), (const pg8::bf16_t*)(args.ws + WS_WOUT), MTOK, DM, DM}; pg8::StaticOrder S; S.init(MTOK, DM, G, bx);
    const float* modf = (const float*)(args.ws + WS_MODF);
    pg8::EpiResid E{args.in[0], args.in[1], args.out, DM, M_P / 256, modf + 2 * DM, NMOD, modf + (size_t)8 * NMOD + 2 * DM};
    pg8::gemm_phase<pg8::EpiResid, pg8::StaticOrder, GEMM_ALIGN, GEMM_SP2>(ldsl, g, S, E);
}
__device__ __forceinline__ void p7_phase(const Args& args, LAS unsigned char* ldsl, int G, int bx) {
    pg8::Gemm g{(const pg8::bf16_t*)(args.ws + WS_H), (const pg8::bf16_t*)(args.ws + WS_WFC1), MTOK, DFF, DM}; pg8::StaticOrder S; S.init(MTOK, DFF, G, bx);
    pg8::EpiBf16<1, U_NT> E{(pg8::bf16_t*)(args.ws + WS_U), DFF};
    pg8::gemm_phase<pg8::EpiBf16<1, U_NT>, pg8::StaticOrder, GEMM_ALIGN, GEMM_SP2>(ldsl, g, S, E);
}
__device__ __forceinline__ void p7_null_phase(const Args& args, LAS unsigned char* ldsl, int G, int bx) {
    pg8::Gemm g{(const pg8::bf16_t*)(args.ws + WS_H), (const pg8::bf16_t*)(args.ws + WS_WFC1), MTOK, DFF, DM}; pg8::StaticOrder S; S.init(MTOK, DFF, G, bx);
    pg8::EpiNull E{};
    pg8::gemm_phase<pg8::EpiNull, pg8::StaticOrder, GEMM_ALIGN, GEMM_SP2>(ldsl, g, S, E);
}
__device__ __forceinline__ void p8_null_phase(const Args& args, LAS unsigned char* ldsl, int G, int bx) {
    pg8::Gemm g{(const pg8::bf16_t*)(args.ws + WS_U), (const pg8::bf16_t*)(args.ws + WS_WFC2), MTOK, DM, DFF}; pg8::StaticOrder S; S.init(MTOK, DM, G, bx);
    pg8::EpiNull E{};
    pg8::gemm_phase<pg8::EpiNull, pg8::StaticOrder, GEMM_ALIGN, GEMM_SP2>(ldsl, g, S, E);
}
__device__ __forceinline__ void p8_phase(const Args& args, LAS unsigned char* ldsl, int G, int bx) {
    pg8::Gemm g{(const pg8::bf16_t*)(args.ws + WS_U), (const pg8::bf16_t*)(args.ws + WS_WFC2), MTOK, DM, DFF}; pg8::StaticOrder S; S.init(MTOK, DM, G, bx);
    const float* modf = (const float*)(args.ws + WS_MODF);
    pg8::EpiResid E{args.out, args.out + (size_t)M_P * DM, args.out, DM, M_P / 256, modf + 5 * DM, NMOD, modf + (size_t)8 * NMOD + 5 * DM};
    pg8::gemm_phase<pg8::EpiResid, pg8::StaticOrder, GEMM_ALIGN, GEMM_SP2>(ldsl, g, S, E);
}

__global__ void __launch_bounds__(NWAVES * 64, 2) fwd_kernel(Args args) {
    extern __shared__ __attribute__((aligned(16))) unsigned char lds[];
    LAS unsigned char* ldsl = (LAS unsigned char*)lds;
    volatile LAS unsigned* MISC = (volatile LAS unsigned*)(ldsl + MISC_OFF);
    const int tid = threadIdx.x, wave = __builtin_amdgcn_readfirstlane(tid >> 6);
    const int G = gridDim.x; const int bx = blockIdx.x; const int vcu = (G % 8 == 0) ? (bx % 8) * (G / 8) + bx / 8 : bx;
    gu32* ctl = (gu32*)(args.ws + WS_CTL);
    for (int u = tid; u < (LDS_BYTES - MISC_OFF) / 4; u += NWAVES * 64) ((LAS unsigned*)(ldsl + MISC_OFF))[u] = 0u;
    __syncthreads();
    XcdBarrier bar; bar.bar = (unsigned*)(ctl + CW_BAR); bar.x = 0; bar.st = nullptr;
    if (N_LAUNCHES == 1) bar = xcd_barrier_post((unsigned*)(ctl + CW_BAR), MISC + 8);
    const int lo = args.ph_lo, hi = args.ph_hi;
#ifndef PHASE_MASK
#define PHASE_MASK 0x1ff
#endif
#define IN(k) ((((PHASE_MASK) >> (k)) & 1) && lo <= (k) && (k) < hi)
#define SEAM(k) do { if (IN(k) && IN((k) + 1)) xcd_barrier(bar); } while (0)

#ifndef PROBE_REPEAT
#define PROBE_REPEAT (-1)
#endif
#if defined(PROBE_TIME)
    unsigned long long pt0 = 0, pt1 = 0;
#define PT_BEGIN(k) do { if (PROBE_TIME == (k)) pt0 = wall_clock64(); } while (0)
#define PT_END(k) do { if (PROBE_TIME == (k)) pt1 = wall_clock64(); } while (0)
#else
#define PT_BEGIN(k) do { } while (0)
#define PT_END(k) do { } while (0)
#endif
#define REP(k, call) do { if (PROBE_REPEAT == (k)) { call; xcd_barrier(bar); } } while (0)
    PT_BEGIN(0);
    if (IN(0)) p0_phase(args, ldsl, vcu, G, wave);
    SEAM(0); PT_END(0);
    PT_BEGIN(1);
    if (IN(1)) { norm_phase<0>(args, ldsl, vcu, G, wave); p1_extras(args, ldsl, vcu, G, wave); }
    SEAM(1); PT_END(1);
    PT_BEGIN(2);
    if (IN(2)) p2_phase(args, ldsl, G, bx, wave);
    SEAM(2); PT_END(2);
    PT_BEGIN(3);
    if (IN(3)) { p3_extras(args, ldsl, vcu, G, (G == 256) ? BG_Q2 : 0, wave); qk_phase(args, ldsl, vcu, G, wave); }
    SEAM(3); PT_END(3);
    PT_BEGIN(4);
    if (IN(4)) { modf_rest(args, vcu, G); attn_phase(args, lds, G, wave); }
    SEAM(4); PT_END(4); REP(4, attn_phase(args, lds, G, wave));
    PT_BEGIN(5);
    if (IN(5)) p5_phase(args, ldsl, G, bx);
    SEAM(5); PT_END(5); REP(5, p5_phase(args, ldsl, G, bx));
    PT_BEGIN(6);
    if (IN(6)) norm_phase<1>(args, ldsl, vcu, G, wave);
    SEAM(6); PT_END(6); REP(6, norm_phase<1>(args, ldsl, vcu, G, wave));
#if defined(PROBE_CLOCK)
    unsigned long long pc0 = 0, pr0 = 0, pc1 = 0, pr1 = 0;
    if (PROBE_CLOCK == 7) { pc0 = clock64(); pr0 = wall_clock64(); }
#endif
    PT_BEGIN(7);
    if (IN(7)) p7_phase(args, ldsl, G, bx);
#if defined(PROBE_CLOCK)
    if (PROBE_CLOCK == 7) { pc1 = clock64(); pr1 = wall_clock64(); }
#endif
    SEAM(7); PT_END(7); REP(7, p7_phase(args, ldsl, G, bx)); REP(17, p7_null_phase(args, ldsl, G, bx)); REP(18, p8_null_phase(args, ldsl, G, bx));
    PT_BEGIN(8);
    if (IN(8)) p8_phase(args, ldsl, G, bx);
#if defined(PROBE_TIME)
    PT_END(8);
    if (bx == 0 && tid == 0) { const unsigned long long t0 = wall_clock64(); while (wall_clock64() - t0 < (pt1 - pt0)) __builtin_amdgcn_s_sleep(8); }
#endif
#if defined(PROBE_CLOCK)
    if (bx == 0 && tid == 0) {
        const unsigned long long ticks = (pc1 - pc0) * 1000ull / (pr1 - pr0);
        const unsigned long long t0 = wall_clock64(); while (wall_clock64() - t0 < ticks) __builtin_amdgcn_s_sleep(8);
    }
#endif
#undef REP
#undef IN
#undef SEAM
}

extern "C" void kernel_launch(void* const* d_in, const int* in_sizes, int n_in, void* d_out, int out_size, void* d_ws, size_t ws_size, hipStream_t stream) {
    static int grid = 0;
    if (grid == 0) {
        if (n_in != 26 || in_sizes[0] != M_P * DM || in_sizes[1] != M_S * DM || out_size != MTOK * DM + 4 * M_P * 512 || ws_size < WS_END) {
            fprintf(stderr, "kernel_launch: shape mismatch (n_in %d in0 %d in1 %d out %d ws %zu, need ws >= %zu); nothing launched\n", n_in, n_in > 0 ? in_sizes[0] : -1, n_in > 1 ? in_sizes[1] : -1, out_size, ws_size, (size_t)WS_END); grid = -1; return; }
        int dev = 0, cus = 0, per_cu = 0;
        if (hipGetDevice(&dev) != hipSuccess || hipDeviceGetAttribute(&cus, hipDeviceAttributeMultiprocessorCount, dev) != hipSuccess) { grid = -1; return; }
        if (hipFuncSetAttribute((const void*)fwd_kernel, hipFuncAttributeMaxDynamicSharedMemorySize, LDS_BYTES) != hipSuccess) { fprintf(stderr, "kernel_launch: hipFuncSetAttribute failed\n"); grid = -1; return; }
        if (hipOccupancyMaxActiveBlocksPerMultiprocessor(&per_cu, (const void*)fwd_kernel, NWAVES * 64, LDS_BYTES) != hipSuccess || per_cu < 1) { fprintf(stderr, "kernel_launch: occupancy query says %d blocks per CU\n", per_cu); }
        (void)hipGetLastError();
        grid = cus;
    }
    if (grid < 0) return;
    if (hipMemsetAsync((char*)d_ws + WS_CTL, 0, CTL_ZERO_BYTES, stream) != hipSuccess) return;
    Args a{};
    for (int i = 0; i < 26; ++i) a.in[i] = (const float*)d_in[i];
    a.out = (float*)d_out; a.ws = (unsigned char*)d_ws;
    if (N_LAUNCHES == 1) { a.ph_lo = 0; a.ph_hi = NPH; hipLaunchKernelGGL(fwd_kernel, dim3(grid), dim3(NWAVES * 64), LDS_BYTES, stream, a); }
    else { for (int p = 0; p < NPH; ++p) { a.ph_lo = p; a.ph_hi = p + 1; hipLaunchKernelGGL(fwd_kernel, dim3(grid), dim3(NWAVES * 64), LDS_BYTES, stream, a); } }
    const hipError_t le = hipPeekAtLastError();
    if (le != hipSuccess) fprintf(stderr, "kernel_launch: launch failed: %s\n", hipGetErrorName(le));
}
```

```cpp
#include <hip/hip_runtime.h>
#include <cstdio>
#include <cstdint>
namespace pg8 {
#define PG8_LAS __attribute__((address_space(3)))
typedef unsigned short bf16_t;
typedef short bf16x8 __attribute__((ext_vector_type(8)));
typedef float f32x4 __attribute__((ext_vector_type(4)));
typedef unsigned u32x4 __attribute__((ext_vector_type(4)));
constexpr int BM = 256, BK = 64, HALF = 128, HTB = HALF * BK * 2  , STAGE_BYTES = 8 * HTB, NXCD = 8, WGM = 8;

__host__ __device__ __forceinline__ int lds_byte(int r, int c) { const int st = (r >> 4) * 2 + (c >> 5), rr = r & 15, cc = c & 31, ob = rr * 64 + cc * 2; return st * 1024 + (ob ^ (((ob >> 9) & 1) << 5)); }
__host__ __device__ __forceinline__ void stage_rc(int b, int& R, int& C) { const int st = b / 1024, sb = b % 1024, swz = sb ^ (((sb >> 9) & 1) << 5); R = (st >> 1) * 16 + swz / 64; C = (st & 1) * 32 + (swz % 64) / 2; }
__host__ __device__ __forceinline__ int perm32(int rho) { const int n = rho >> 4, i = rho & 15; return 8 * (i >> 2) + 4 * n + (i & 3); }

struct Unit { int pm, pn; };
struct Gemm { const bf16_t* A; const bf16_t* Bt; int M, N, K; };

struct StaticOrder {
    int nM, nN, nwg, G, c;
    __host__ __device__ void init(int M, int N, int G_, int c_) { nM = M / BM; nN = N / BM; nwg = nM * nN; G = G_; c = c_; }
    __host__ __device__ bool next(int i, Unit& u) const {
        const long L = (long)i * G + c; if (L >= nwg) return false;
        int wgid = (int)L; { const int q = nwg / NXCD, r = nwg % NXCD, xcd = wgid % NXCD, off = wgid / NXCD; wgid = (xcd < r ? xcd * (q + 1) : r * (q + 1) + (xcd - r) * q) + off; }
        const int nig = WGM * nN, gid = wgid / nig, fm = gid * WGM, gsz = (nM - fm) < WGM ? (nM - fm) : WGM;
        u.pm = fm + ((wgid % nig) % gsz); u.pn = (wgid % nig) / gsz; return true;
    }
    __device__ __forceinline__ void a_ready(const Unit&) const {}
    __device__ __forceinline__ void done(const Unit&) const {}
};

__device__ __forceinline__ unsigned cvt_pk_bf16(float lo, float hi) { unsigned r; asm volatile("v_cvt_pk_bf16_f32 %0, %1, %2" : "=v"(r) : "v"(lo), "v"(hi)); return r; }

template <int ACT, bool NT = false> struct EpiBf16 {
    static constexpr bool PERM = true, AFTER_DRAIN = false;
    bf16_t* O; int ldc;
    __device__ __forceinline__ void operator()(const f32x4 (&acc)[2][2][4][2], const Unit& u, int wr, int wc, int fr, int fq) const {
        const int row0 = u.pm * BM + wr * 64 + fr; const int col0 = u.pn * BM + wc * 32 + 8 * fq;
#pragma unroll
        for (int ai = 0; ai < 2; ++ai)
#pragma unroll
            for (int m = 0; m < 4; ++m) { bf16_t* rowp = O + (size_t)(row0 + ai * HALF + m * 16) * ldc + col0;
#pragma unroll
                for (int bj = 0; bj < 2; ++bj) { f32x4 v0 = acc[ai][bj][m][0], v1 = acc[ai][bj][m][1];
                    if (ACT == 1) {
#pragma unroll
                        for (int j = 0; j < 4; ++j) { const float a = fmaxf(v0[j], 0.f), b = fmaxf(v1[j], 0.f); v0[j] = a * a; v1[j] = b * b; } }
                    u32x4 w; w.x = cvt_pk_bf16(v0[0], v0[1]); w.y = cvt_pk_bf16(v0[2], v0[3]); w.z = cvt_pk_bf16(v1[0], v1[1]); w.w = cvt_pk_bf16(v1[2], v1[3]);
                    if (NT) __builtin_nontemporal_store(w, (u32x4*)(rowp + bj * HALF)); else *(u32x4*)(rowp + bj * HALF) = w;
#if defined(PROBE_STORE)
                    if (ACT == 1) {
                        bf16_t* dp = O + (size_t)402653184 / 2 * 0 + ((size_t)384 << 20) / 2;
                        if (PROBE_STORE == 1) *(u32x4*)(dp + (size_t)(row0 + ai * HALF + m * 16) * ldc + col0 + bj * HALF) = w;
                        else *(u32x4*)(dp + (size_t)(u.pm * BM + wr * 64 + ai * HALF + m * 16 + (fr & 7) + 8 * bj) * ldc + u.pn * BM + wc * 64 + (fr >> 3) * 32 + 8 * fq) = w;
                    }
#endif
                    } }
    }
};
struct EpiResidB {
    static constexpr bool PERM = true, AFTER_DRAIN = false;
    const float* base0; const float* base1; bf16_t* out; int ldc; int split; const float* gate; int gate_stride; const float* gate_ctx;
    __device__ __forceinline__ void operator()(const f32x4 (&acc)[2][2][4][2], const Unit& u, int wr, int wc, int fr, int fq) const {
        const int rloc = wr * 64 + fr, col0 = u.pn * BM + wc * 32 + 8 * fq;
        const float* bt = (u.pm < split) ? base0 + (size_t)u.pm * BM * ldc : base1 + (size_t)(u.pm - split) * BM * ldc;
        const float* gv = (u.pm < split) ? gate_ctx : gate + (size_t)((u.pm - split) >> 2) * gate_stride;
        bf16_t* ot = out + (size_t)u.pm * BM * ldc;
        f32x4 g[2][2];
#pragma unroll
        for (int bj = 0; bj < 2; ++bj)
#pragma unroll
            for (int n = 0; n < 2; ++n) g[bj][n] = *(const f32x4*)(gv + col0 + bj * HALF + 4 * n);
#pragma unroll
        for (int ai = 0; ai < 2; ++ai)
#pragma unroll
            for (int m = 0; m < 4; ++m) { const size_t off = (size_t)(rloc + ai * HALF + m * 16) * ldc + col0;
#pragma unroll
                for (int bj = 0; bj < 2; ++bj) { const f32x4 b0 = *(const f32x4*)(bt + off + bj * HALF), b1 = *(const f32x4*)(bt + off + bj * HALF + 4);
                    const f32x4 v0 = b0 + g[bj][0] * acc[ai][bj][m][0], v1 = b1 + g[bj][1] * acc[ai][bj][m][1];
                    u32x4 w; w.x = cvt_pk_bf16(v0[0], v0[1]); w.y = cvt_pk_bf16(v0[2], v0[3]); w.z = cvt_pk_bf16(v1[0], v1[1]); w.w = cvt_pk_bf16(v1[2], v1[3]);
                    *(u32x4*)(ot + off + bj * HALF) = w; }
                if (m & 1) asm volatile("" ::: "memory"); }
    }
};
struct EpiResid {
    static constexpr bool PERM = false, AFTER_DRAIN = false;
    const bf16_t* base; float* out; int ldc; int split; const float* gate; int gate_stride; const float* gate_ctx;
    __device__ __forceinline__ void operator()(const f32x4 (&acc)[2][2][4][2], const Unit& u, int wr, int wc, int fr, int fq) const {
        typedef unsigned u32x2 __attribute__((ext_vector_type(2)));
        const int rloc = wr * 64 + fr, col0 = u.pn * BM + wc * 32 + 4 * fq;
        const bf16_t* bt = base + (size_t)u.pm * BM * ldc;
        const float* gv = (u.pm < split) ? gate_ctx : gate + (size_t)((u.pm - split) >> 2) * gate_stride;
        float* ot = out + (size_t)u.pm * BM * ldc;
        f32x4 g[2][2];
#pragma unroll
        for (int bj = 0; bj < 2; ++bj)
#pragma unroll
            for (int n = 0; n < 2; ++n) g[bj][n] = *(const f32x4*)(gv + col0 + bj * HALF + n * 16);
#pragma unroll
        for (int ai = 0; ai < 2; ++ai)
#pragma unroll
            for (int m = 0; m < 4; ++m) { const size_t off = (size_t)(rloc + ai * HALF + m * 16) * ldc + col0;
#pragma unroll
                for (int bj = 0; bj < 2; ++bj)
#pragma unroll
                    for (int n = 0; n < 2; ++n) { const u32x2 b = *(const u32x2*)(bt + off + bj * HALF + n * 16);
                        const f32x4 bs = {__uint_as_float(b.x << 16), __uint_as_float(b.x & 0xffff0000u), __uint_as_float(b.y << 16), __uint_as_float(b.y & 0xffff0000u)};
                        *(f32x4*)(ot + off + bj * HALF + n * 16) = bs + g[bj][n] * acc[ai][bj][m][n]; }
                if (m & 1) asm volatile("" ::: "memory"); }
    }
};

struct EpiNull {
    static constexpr bool PERM = true, AFTER_DRAIN = false;
    __device__ __forceinline__ void operator()(const f32x4 (&acc)[2][2][4][2], const Unit& u, int wr, int wc, int fr, int fq) const {
#pragma unroll
        for (int ai = 0; ai < 2; ++ai)
#pragma unroll
            for (int bj = 0; bj < 2; ++bj)
#pragma unroll
                for (int m = 0; m < 4; ++m)
#pragma unroll
                    for (int n = 0; n < 2; ++n) asm volatile("" :: "v"(acc[ai][bj][m][n]));
    }
};

template <class Epi, class Sched, bool ALIGN_EPI = false, bool SP2 = false>
__device__ __forceinline__ void gemm_phase(PG8_LAS unsigned char* lds, const Gemm g, const Sched& S, const Epi& E) {
    int tid_ = threadIdx.x; asm volatile("" : "+v"(tid_));
    const int tid = tid_, wid = __builtin_amdgcn_readfirstlane(tid >> 6), lane = tid & 63, wr = wid >> 2, wc = wid & 3, fr = lane & 15, fq = lane >> 4;
    const int K = g.K, nt = K / BK;
    unsigned voffA[2], voffB[2];
#pragma unroll
    for (int i = 0; i < 2; ++i) { int R, C; stage_rc(tid * 16 + i * 8192, R, C); const int Rb = Epi::PERM ? ((R & ~31) + perm32(R & 31)) : R;
        voffA[i] = (unsigned)(R * K + C) * 2u; voffB[i] = (unsigned)(Rb * K + C) * 2u; }
    const size_t kstep = (size_t)(BK * 2);
    const size_t hstep = (size_t)HALF * K * 2;
    const size_t tstep = 2 * hstep;
    const unsigned ldsw = (unsigned)wid * 1024u;
    const int aoff = lds_byte(wr * 64 + fr, fq * 8), boff = lds_byte(wc * 32 + fr, fq * 8);
#define PG8_SA(b, h) (((b) * 2 + (h)) * HTB)
#define PG8_SB(b, h) ((4 + (b) * 2 + (h)) * HTB)
#define PG8_STAGE(bufoff, gbase, voff) do { _Pragma("unroll") for (int _i = 0; _i < 2; ++_i) \
        __builtin_amdgcn_global_load_lds((const unsigned*)((const char*)(gbase) + (voff)[_i]), (PG8_LAS unsigned*)(lds + (bufoff) + ldsw + _i * 8192), 16, 0, 0); } while (0)
#define PG8_LDA(dst, b, h) do { _Pragma("unroll") for (int m = 0; m < 4; ++m) _Pragma("unroll") for (int k = 0; k < 2; ++k) dst[m][k] = *(const PG8_LAS bf16x8*)(lds + PG8_SA(b, h) + aoff + m * 2048 + k * 1024); } while (0)
#define PG8_LDB(dst, b, h) do { _Pragma("unroll") for (int n = 0; n < 2; ++n) _Pragma("unroll") for (int k = 0; k < 2; ++k) dst[n][k] = *(const PG8_LAS bf16x8*)(lds + PG8_SB(b, h) + boff + n * 2048 + k * 1024); } while (0)
#define PG8_MMA(ai, bj, At, Bt) do { __builtin_amdgcn_s_setprio(1); _Pragma("unroll") for (int m = 0; m < 4; ++m) _Pragma("unroll") for (int n = 0; n < 2; ++n) _Pragma("unroll") for (int k = 0; k < 2; ++k) \
        acc[ai][bj][m][n] = __builtin_amdgcn_mfma_f32_16x16x32_bf16(Bt[n][k], At[m][k], acc[ai][bj][m][n], 0, 0, 0); __builtin_amdgcn_s_setprio(0); } while (0)
#define PG8_WAIT_V(n) asm volatile("s_waitcnt vmcnt(" #n ")" ::: "memory")
#define PG8_WAIT_L(n) asm volatile("s_waitcnt lgkmcnt(" #n ")" ::: "memory")
#define PG8_BAR __builtin_amdgcn_s_barrier()
#define PG8_SCHED __builtin_amdgcn_sched_barrier(0)
    Unit cur, nxt; int ui = 0;
    if (!S.next(0, cur)) return;
    f32x4 acc[2][2][4][2];
#pragma unroll
    for (int a = 0; a < 2; ++a)
#pragma unroll
        for (int b = 0; b < 2; ++b)
#pragma unroll
            for (int m = 0; m < 4; ++m)
#pragma unroll
                for (int n = 0; n < 2; ++n) acc[a][b][m][n] = (f32x4){0.f, 0.f, 0.f, 0.f};
    bf16x8 At[4][2], B0[2][2], B1[2][2];
    const char* cA = (const char*)g.A + (size_t)cur.pm * tstep; const char* cB = (const char*)g.Bt + (size_t)cur.pn * tstep;
    S.a_ready(cur);
    if constexpr (SP2) {
        PG8_STAGE(PG8_SB(0, 0), cB, voffB); PG8_STAGE(PG8_SB(0, 1), cB + hstep, voffB); PG8_STAGE(PG8_SA(0, 0), cA, voffA); PG8_STAGE(PG8_SA(0, 1), cA + hstep, voffA);
        if (wr == 1) PG8_BAR;
        PG8_WAIT_V(2); PG8_BAR;
        PG8_STAGE(PG8_SB(1, 0), cB + kstep, voffB); PG8_STAGE(PG8_SA(1, 0), cA + kstep, voffA); PG8_STAGE(PG8_SB(1, 1), cB + hstep + kstep, voffB);
        PG8_WAIT_V(6); PG8_BAR;
    } else {
        PG8_STAGE(PG8_SB(0, 0), cB, voffB); PG8_STAGE(PG8_SA(0, 0), cA, voffA); PG8_STAGE(PG8_SB(0, 1), cB + hstep, voffB); PG8_STAGE(PG8_SA(0, 1), cA + hstep, voffA);
        if (wr == 1) PG8_BAR;
        PG8_WAIT_V(4); PG8_BAR;
        PG8_STAGE(PG8_SB(1, 0), cB + kstep, voffB); PG8_STAGE(PG8_SA(1, 0), cA + kstep, voffA); PG8_STAGE(PG8_SB(1, 1), cB + hstep + kstep, voffB);
        PG8_WAIT_V(6); PG8_BAR;
    }
    for (;;) {
        const bool has_next = S.next(ui + 1, nxt);
        const char* nA = has_next ? (const char*)g.A + (size_t)nxt.pm * tstep : cA; const char* nB = has_next ? (const char*)g.Bt + (size_t)nxt.pn * tstep : cB;
        for (int t = 0; t < nt; t += 2) {
            const bool last = (t == nt - 2);
            const char* a1 = cA + (size_t)(t + 1) * kstep;
            const char* a2 = last ? nA : cA + (size_t)(t + 2) * kstep; const char* b2 = last ? nB : cB + (size_t)(t + 2) * kstep;
            const char* a3 = a2 + kstep; const char* b3 = b2 + kstep;
            if (last && has_next) S.a_ready(nxt);
            if constexpr (SP2) {
            PG8_LDB(B0, 0, 0); PG8_LDB(B1, 0, 1); PG8_SCHED; PG8_LDA(At, 0, 0); PG8_STAGE(PG8_SA(1, 1), a1 + hstep, voffA);
            PG8_WAIT_V(8); PG8_WAIT_L(0); PG8_BAR; PG8_MMA(0, 0, At, B0); PG8_MMA(0, 1, At, B1); PG8_BAR; PG8_SCHED;
            PG8_LDA(At, 0, 1); PG8_STAGE(PG8_SB(0, 0), b2, voffB); PG8_STAGE(PG8_SB(0, 1), b2 + hstep, voffB); PG8_STAGE(PG8_SA(0, 0), a2, voffA);
            PG8_WAIT_V(8); PG8_WAIT_L(0); PG8_BAR; PG8_MMA(1, 0, At, B0); PG8_MMA(1, 1, At, B1); PG8_BAR; PG8_SCHED;
            PG8_LDB(B0, 1, 0); PG8_LDB(B1, 1, 1); PG8_SCHED; PG8_LDA(At, 1, 0); PG8_STAGE(PG8_SA(0, 1), a2 + hstep, voffA);
            PG8_WAIT_V(8); PG8_WAIT_L(0); PG8_BAR; PG8_MMA(0, 0, At, B0); PG8_MMA(0, 1, At, B1); PG8_BAR; PG8_SCHED;
            PG8_LDA(At, 1, 1); PG8_STAGE(PG8_SB(1, 0), b3, voffB); PG8_STAGE(PG8_SB(1, 1), b3 + hstep, voffB); PG8_STAGE(PG8_SA(1, 0), a3, voffA);
            PG8_WAIT_V(8); PG8_WAIT_L(0); PG8_BAR; PG8_MMA(1, 0, At, B0); PG8_MMA(1, 1, At, B1); PG8_BAR; PG8_SCHED;
            } else {
            PG8_LDB(B0, 0, 0); PG8_SCHED; PG8_LDA(At, 0, 0); PG8_STAGE(PG8_SA(1, 1), a1 + hstep, voffA);
            PG8_WAIT_L(8); PG8_BAR; PG8_WAIT_L(0); PG8_MMA(0, 0, At, B0); PG8_BAR; PG8_SCHED;
            PG8_LDB(B1, 0, 1); PG8_STAGE(PG8_SB(0, 0), b2, voffB);
            PG8_BAR; PG8_WAIT_L(0); PG8_MMA(0, 1, At, B1); PG8_BAR;
            PG8_LDA(At, 0, 1); PG8_STAGE(PG8_SA(0, 0), a2, voffA);
            PG8_BAR; PG8_WAIT_L(0); PG8_MMA(1, 0, At, B0); PG8_BAR; PG8_SCHED;
            PG8_STAGE(PG8_SB(0, 1), b2 + hstep, voffB);
            PG8_WAIT_V(6); PG8_BAR; PG8_MMA(1, 1, At, B1); PG8_BAR;
            PG8_LDB(B0, 1, 0); PG8_SCHED; PG8_LDA(At, 1, 0); PG8_STAGE(PG8_SA(0, 1), a2 + hstep, voffA);
            PG8_WAIT_L(8); PG8_BAR; PG8_WAIT_L(0); PG8_MMA(0, 0, At, B0); PG8_BAR; PG8_SCHED;
            PG8_LDB(B1, 1, 1); PG8_STAGE(PG8_SB(1, 0), b3, voffB);
            PG8_BAR; PG8_WAIT_L(0); PG8_MMA(0, 1, At, B1); PG8_BAR;
            PG8_LDA(At, 1, 1); PG8_STAGE(PG8_SA(1, 0), a3, voffA);
            PG8_BAR; PG8_WAIT_L(0); PG8_MMA(1, 0, At, B0); PG8_BAR; PG8_SCHED;
            PG8_STAGE(PG8_SB(1, 1), b3 + hstep, voffB);
            PG8_WAIT_V(6); PG8_BAR; PG8_MMA(1, 1, At, B1); PG8_BAR;
            }
        }
        if constexpr (ALIGN_EPI) { if (wr == 0) PG8_BAR; }
        if constexpr (!Epi::AFTER_DRAIN) { E(acc, cur, wr, wc, fr, fq); S.done(cur); }
        if (!has_next) break;
#pragma unroll
        for (int a = 0; a < 2; ++a)
#pragma unroll
            for (int b = 0; b < 2; ++b)
#pragma unroll
                for (int m = 0; m < 4; ++m)
#pragma unroll
                    for (int n = 0; n < 2; ++n) acc[a][b][m][n] = (f32x4){0.f, 0.f, 0.f, 0.f};
        cur = nxt; cA = nA; cB = nB; ++ui;
        if constexpr (ALIGN_EPI) { if (wr == 1) PG8_BAR; }
    }
    PG8_WAIT_V(0);
    if constexpr (!ALIGN_EPI) { if (wr == 0) PG8_BAR; }
    PG8_BAR;
    if constexpr (Epi::AFTER_DRAIN) { E.fused(acc, cur, wr, wc, fr, fq, lds, wid, lane); S.done(cur); }
#undef PG8_SA
#undef PG8_SB
#undef PG8_STAGE
#undef PG8_LDA
#undef PG8_LDB
#undef PG8_MMA
#undef PG8_WAIT_V
#undef PG8_WAIT_L
#undef PG8_BAR
#undef PG8_SCHED
}
}
namespace att {
#ifdef ATT_NOMASK
constexpr bool defined_NOMASK = true;
#else
constexpr bool defined_NOMASK = false;
#endif
typedef unsigned short bf16_t;
using bf16x8 = __attribute__((ext_vector_type(8))) short;
using s16x4  = __attribute__((ext_vector_type(4))) short;
using f32x16 = __attribute__((ext_vector_type(16))) float;
using u32x4  = __attribute__((ext_vector_type(4))) unsigned;
constexpr int KVBLK = 64;
constexpr int SHM_V = 16384, SHM_K = 16384;
constexpr int LDS_WS = 2 * SHM_V + 2 * SHM_K;
constexpr int LDS_X = LDS_WS + 8 * 64 * 4;
constexpr int LDS_MISC = LDS_X + 4 * 32 * 128 * 4;
constexpr int LDS_BYTES = LDS_MISC + 64;
constexpr float LOG2E = 1.4426950408889634f;
#define GASQ __attribute__((address_space(1)))
#define KSWZ(row, colB) ((row) * 256 + ((colB) ^ (((row) & 7) << 4)))
#define SBAR() __builtin_amdgcn_sched_barrier(0)
__device__ __forceinline__ int crow(int r, int hi) { return (r & 3) + 8 * (r >> 2) + 4 * hi; }
__device__ __forceinline__ unsigned cvtpk(float lo, float hi) { unsigned r; asm volatile("v_cvt_pk_bf16_f32 %0, %1, %2" : "=v"(r) : "v"(lo), "v"(hi)); return r; }

#ifndef ATT_SDEPTH0
#define ATT_SDEPTH0 2
#endif
#ifndef ATT_QLDS0
#define ATT_QLDS0 1
#endif
template <int MODE> struct Cfg {
    static constexpr float SCALE = (MODE == 0) ? 0.088388347648318440f : 0.125f;
    static constexpr float C = SCALE * LOG2E;
    static constexpr float THRS = 8.f / SCALE;
    static constexpr int ND0 = (MODE == 0) ? 8 : 4;
    static constexpr int SDEPTH = (MODE == 0) ? ATT_SDEPTH0 : 2;
    static constexpr bool QLDS = (MODE == 0) && (ATT_QLDS0 != 0);
};

template <int MODE>
__device__ __forceinline__ void partialSM(f32x16& p0, f32x16& p1, float& m_reg, float& mn, float& alpha) {
  constexpr float C = Cfg<MODE>::C;
  float pmax = p0[0];
#pragma unroll
  for (int r = 1; r < 16; ++r) pmax = fmaxf(pmax, p0[r]);
#pragma unroll
  for (int r = 0; r < 16; ++r) pmax = fmaxf(pmax, p1[r]);
  { auto rr = __builtin_amdgcn_permlane32_swap(__float_as_uint(pmax), __float_as_uint(pmax), false, false);
    pmax = fmaxf(__uint_as_float(rr[0]), __uint_as_float(rr[1])); }
  if (__builtin_expect(__all(pmax - m_reg <= Cfg<MODE>::THRS), 1)) { mn = m_reg; alpha = 1.f; }
  else { mn = fmaxf(m_reg, pmax); alpha = __builtin_amdgcn_exp2f((m_reg - mn) * C); m_reg = mn; }
  const float mnC = -mn * C;
#pragma unroll
  for (int r = 0; r < 16; ++r) p0[r] = fmaf(p0[r], C, mnC);
#pragma unroll
  for (int r = 0; r < 16; ++r) p1[r] = fmaf(p1[r], C, mnC);
#pragma unroll
  for (int r = 0; r < 16; ++r) p0[r] = __builtin_amdgcn_exp2f(p0[r]);
}
__device__ __forceinline__ void finishSM(f32x16& p0, f32x16& p1, float alpha, float& l_reg, bf16x8& pa0, bf16x8& pa1, bf16x8& pa2, bf16x8& pa3) {
#pragma unroll
  for (int r = 0; r < 16; ++r) p1[r] = __builtin_amdgcn_exp2f(p1[r]);
  float ps = 0;
#pragma unroll
  for (int r = 0; r < 16; ++r) ps += p0[r];
#pragma unroll
  for (int r = 0; r < 16; ++r) ps += p1[r];
  { auto rr = __builtin_amdgcn_permlane32_swap(__float_as_uint(ps), __float_as_uint(ps), false, false);
    ps = __uint_as_float(rr[0]) + __uint_as_float(rr[1]); }
  l_reg = l_reg * alpha + ps;
#define PK4(P, BASE, OUT) do { unsigned a0 = cvtpk(P[BASE + 0], P[BASE + 1]), a1 = cvtpk(P[BASE + 2], P[BASE + 3]);   \
    unsigned b0 = cvtpk(P[BASE + 4], P[BASE + 5]), b1 = cvtpk(P[BASE + 6], P[BASE + 7]);                              \
    auto r0 = __builtin_amdgcn_permlane32_swap(a0, b0, false, false); auto r1 = __builtin_amdgcn_permlane32_swap(a1, b1, false, false); \
    u32x4 w = {r0[0], r1[0], r0[1], r1[1]}; OUT = *reinterpret_cast<bf16x8*>(&w); } while (0)
  PK4(p0, 0, pa0); PK4(p0, 8, pa1); PK4(p1, 0, pa2); PK4(p1, 8, pa3);
#undef PK4
}
template <int MODE, bool QLDS>
__device__ __forceinline__ void qkt(f32x16& p0, f32x16& p1, const char* Ks, const bf16x8* qr, const char* qs, int r32, int hi, int comp) {
  p0 = f32x16{}; p1 = f32x16{};
  int rb = r32; asm volatile("" : "+v"(rb));
  const int swz = (rb & 7) << 4, rowb = rb * 256 + comp * 128;
  const char* a0 = Ks + rowb + ((0 * 32 + hi * 16) ^ swz); const char* a1 = Ks + rowb + ((1 * 32 + hi * 16) ^ swz);
  const char* a2 = Ks + rowb + ((2 * 32 + hi * 16) ^ swz); const char* a3 = Ks + rowb + ((3 * 32 + hi * 16) ^ swz);
#pragma unroll
  for (int d0 = 0; d0 < Cfg<MODE>::ND0; ++d0) { const int dl = d0 & 3, dh = d0 >> 2; const char* ap = (dl == 0 ? a0 : dl == 1 ? a1 : dl == 2 ? a2 : a3) + dh * 128;
    bf16x8 b0 = *reinterpret_cast<const bf16x8*>(ap);
    bf16x8 b1 = *reinterpret_cast<const bf16x8*>(ap + 8192);
    bf16x8 q; if constexpr (QLDS) q = *reinterpret_cast<const bf16x8*>(qs + d0 * 1024); else q = qr[d0];
    p0 = __builtin_amdgcn_mfma_f32_32x32x16_bf16(b0, q, p0, 0, 0, 0);
    p1 = __builtin_amdgcn_mfma_f32_32x32x16_bf16(b1, q, p1, 0, 0, 0); }
}
__device__ __forceinline__ int v_st(int k, int c) { const int kk = (k & ~0xC) | ((k & 4) << 1) | ((k & 8) >> 1); return ((kk >> 3) * 4 + (c >> 5)) * 512 + ((kk & 7) * 32 + (c & 31)) * 2; }
__device__ __forceinline__ int v_rd_base(int lane) { return ((lane & 3) << 3) | (((lane >> 2) & 3) << 6) | (((lane >> 4) & 1) << 5) | (((lane >> 5) & 1) << 8); }
constexpr int v_rd_off(int d0, int ks, int half) { return d0 * 512 + ks * 4096 + half * 2048; }
template <int OFF> __device__ __forceinline__ s16x4 tr_read(int vb) {
  s16x4 r; asm volatile("ds_read_b64_tr_b16 %0, %1 offset:%2" : "=&v"(r) : "v"(vb), "i"(OFF) : "memory"); return r;
}
template <int D0> __device__ __forceinline__ void pv_one(f32x16& od, int vb, bf16x8 pa0, bf16x8 pa1, bf16x8 pa2, bf16x8 pa3) {
  const s16x4 l0 = tr_read<v_rd_off(D0, 0, 0)>(vb), h0 = tr_read<v_rd_off(D0, 0, 1)>(vb), l1 = tr_read<v_rd_off(D0, 1, 0)>(vb), h1 = tr_read<v_rd_off(D0, 1, 1)>(vb);
  const s16x4 l2 = tr_read<v_rd_off(D0, 2, 0)>(vb), h2 = tr_read<v_rd_off(D0, 2, 1)>(vb), l3 = tr_read<v_rd_off(D0, 3, 0)>(vb), h3 = tr_read<v_rd_off(D0, 3, 1)>(vb);
  asm volatile("s_waitcnt lgkmcnt(0)" ::: "memory"); SBAR();
#define PK(L, H) (bf16x8){L[0], L[1], L[2], L[3], H[0], H[1], H[2], H[3]}
  od = __builtin_amdgcn_mfma_f32_32x32x16_bf16(pa0, PK(l0, h0), od, 0, 0, 0);
  od = __builtin_amdgcn_mfma_f32_32x32x16_bf16(pa1, PK(l1, h1), od, 0, 0, 0);
  od = __builtin_amdgcn_mfma_f32_32x32x16_bf16(pa2, PK(l2, h2), od, 0, 0, 0);
  od = __builtin_amdgcn_mfma_f32_32x32x16_bf16(pa3, PK(l3, h3), od, 0, 0, 0);
#undef PK
}
__device__ __forceinline__ void pv_d0(f32x16* o, int vb, bf16x8 pa0, bf16x8 pa1, bf16x8 pa2, bf16x8 pa3) {
  pv_one<0>(o[0], vb, pa0, pa1, pa2, pa3); pv_one<1>(o[1], vb, pa0, pa1, pa2, pa3); pv_one<2>(o[2], vb, pa0, pa1, pa2, pa3); pv_one<3>(o[3], vb, pa0, pa1, pa2, pa3);
}

struct UnitArgs {
    const bf16_t* Qb; int ldq;
    const bf16_t* Kh; const bf16_t* Vh;
    bf16_t* Ob; int ldo;
    int NT;
    int jwin, wadd;
    int masked, t0;
    float sinkl2;
    float lam;
    const float* subg;
};

template <int MODE>
__device__ __forceinline__ void attn_unit(const UnitArgs& A, char* lds) {
  constexpr float C = Cfg<MODE>::C; constexpr int ND0 = Cfg<MODE>::ND0;
  int tid_ = threadIdx.x; asm volatile("" : "+v"(tid_));
  const int tid = tid_, wid = tid >> 6, lane = tid & 63, r32 = lane & 31, hi = lane >> 5;
  const int wq = (MODE == 0) ? wid : (wid & 3), comp = (MODE == 0) ? 0 : (wid >> 2);
  char* V_lds = lds; char* K_lds = lds + 2 * SHM_V;
  float* ws = (float*)(lds + LDS_WS) + wid * 64; float* li_l = ws; float* al_l = ws + 32;
  constexpr bool QLDS = Cfg<MODE>::QLDS;
  __syncthreads();
  float m_reg = -1e30f, l_reg = 0; f32x16 o[4] = {}; bf16x8 qr[QLDS ? 1 : ND0];
  char* qs = lds + LDS_X + wid * 8192 + lane * 16;
  const bf16_t* Qw = A.Qb + (long)(wq * 32 + r32) * A.ldq + comp * 64 + hi * 8;
  if constexpr (QLDS) {
#pragma unroll
    for (int d0 = 0; d0 < ND0; ++d0) *reinterpret_cast<bf16x8*>(qs + d0 * 1024) = *reinterpret_cast<const bf16x8*>(Qw + d0 * 16);
  } else {
#pragma unroll
    for (int d0 = 0; d0 < ND0; ++d0) qr[d0] = *reinterpret_cast<const bf16x8*>(Qw + d0 * 16);
  }
  const int sr = tid >> 4, sc = (tid & 15) * 8, vst0 = v_st(sr, sc), vst1 = v_st(32 + sr, sc);
  const int vb0 = (int)(uintptr_t)V_lds + v_rd_base(lane);
  const unsigned loff0 = (unsigned)(sr * 128 + sc) * 2u, loff1 = loff0 + 32u * 256u;
  const bf16_t* Kh = A.Kh; const bf16_t* Vh = A.Vh; const int NT = A.NT, jwin = A.jwin, wadd = A.wadd;
  constexpr int SDEPTH = Cfg<MODE>::SDEPTH;
  struct { bf16x8 vs0, vs1, ks0, ks1; } sr_[SDEPTH];
#define KOFF(j) (64 * (j) + (((j) >= jwin) ? wadd : 0))
#define SLOAD(i, k0) do { const size_t _kb = (size_t)(k0) * 256; const char* _vp = (const char*)Vh + _kb; const char* _kp = (const char*)Kh + _kb; \
    sr_[i].vs0 = *(const GASQ bf16x8*)(_vp + loff0); sr_[i].vs1 = *(const GASQ bf16x8*)(_vp + loff1); \
    sr_[i].ks0 = *(const GASQ bf16x8*)(_kp + loff0); sr_[i].ks1 = *(const GASQ bf16x8*)(_kp + loff1); } while (0)
#define SWRITE(b, i) do { *(bf16x8*)(V_lds + (b) * SHM_V + vst0) = sr_[i].vs0;          \
    *(bf16x8*)(V_lds + (b) * SHM_V + vst1) = sr_[i].vs1; const int kc = sc * 2;               \
    *(bf16x8*)(K_lds + (b) * SHM_K + KSWZ(sr, kc)) = sr_[i].ks0;                       \
    *(bf16x8*)(K_lds + (b) * SHM_K + KSWZ(32 + sr, kc)) = sr_[i].ks1; } while (0)
#define SWAIT() do { if constexpr (SDEPTH == 2) asm volatile("s_waitcnt vmcnt(4)" ::: "memory"); else asm volatile("s_waitcnt vmcnt(0)" ::: "memory"); } while (0)
#define RESC(a) do { if (__any((a) < 1.f)) { if (hi == 0) al_l[r32] = (a); asm volatile("s_waitcnt lgkmcnt(0)" ::: "memory"); \
    _Pragma("unroll") for (int d = 0; d < 4; ++d) _Pragma("unroll") for (int r = 0; r < 16; ++r) o[d][r] *= al_l[crow(r, hi)]; } } while (0)
#define MASKT(P0, P1, j) do { if (MODE == 0 && !defined_NOMASK && A.masked && (j) >= jwin) { const int kp0 = KOFF(j) - 512, qw0 = A.t0 + wq * 32; \
    if (kp0 < qw0 + 31 - 128 || kp0 + 63 > qw0 + 128) { const int dkb = kp0 - qw0 - r32 + 4 * hi + 128; \
      _Pragma("unroll") for (int r = 0; r < 16; ++r) { const int cr = (r & 3) + 8 * (r >> 2); if ((unsigned)(dkb + cr) > 256u) P0[r] = -1e30f; if ((unsigned)(dkb + cr + 32) > 256u) P1[r] = -1e30f; } } } } while (0)
  f32x16 pA0, pA1, pB0, pB1; float mnA, mnB, alA, alB; bf16x8 pa0, pa1, pa2, pa3;
  constexpr int SE = 0, SO = SDEPTH - 1;
  SLOAD(SE, KOFF(0)); asm volatile("s_waitcnt vmcnt(0)" ::: "memory"); SWRITE(0, SE); __syncthreads();
  qkt<MODE, QLDS>(pA0, pA1, K_lds, qr, qs, r32, hi, comp); MASKT(pA0, pA1, 0); partialSM<MODE>(pA0, pA1, m_reg, mnA, alA);
  SLOAD(SO, KOFF(1)); if constexpr (SDEPTH == 2) { if (2 < NT) SLOAD(SE, KOFF(2)); }
  SWAIT(); SWRITE(1, SO); __syncthreads();
  for (int j = 1; j + 1 < NT; j += 2) {
    SBAR(); qkt<MODE, QLDS>(pB0, pB1, K_lds + SHM_K, qr, qs, r32, hi, comp);
    finishSM(pA0, pA1, alA, l_reg, pa0, pa1, pa2, pa3); SBAR();
    SLOAD(SO, KOFF(j + SDEPTH)); SBAR();
    pv_d0(o, vb0, pa0, pa1, pa2, pa3); MASKT(pB0, pB1, j); partialSM<MODE>(pB0, pB1, m_reg, mnB, alB);
    __syncthreads(); SWAIT(); SWRITE(0, SE);
    RESC(alB); __syncthreads();
    SBAR(); qkt<MODE, QLDS>(pA0, pA1, K_lds, qr, qs, r32, hi, comp);
    finishSM(pB0, pB1, alB, l_reg, pa0, pa1, pa2, pa3); SBAR();
    if (SDEPTH == 1 || j + 3 < NT) SLOAD(SE, KOFF(j + 1 + SDEPTH)); SBAR();
    pv_d0(o, vb0 + SHM_V, pa0, pa1, pa2, pa3); MASKT(pA0, pA1, j + 1); partialSM<MODE>(pA0, pA1, m_reg, mnA, alA);
    __syncthreads(); SWAIT(); SWRITE(1, SO);
    RESC(alA); __syncthreads();
  }
  SBAR(); qkt<MODE, QLDS>(pB0, pB1, K_lds + SHM_K, qr, qs, r32, hi, comp);
  finishSM(pA0, pA1, alA, l_reg, pa0, pa1, pa2, pa3); SBAR();
  pv_d0(o, vb0, pa0, pa1, pa2, pa3); MASKT(pB0, pB1, NT - 1); partialSM<MODE>(pB0, pB1, m_reg, mnB, alB);
  __syncthreads(); RESC(alB);
  finishSM(pB0, pB1, alB, l_reg, pa0, pa1, pa2, pa3); SBAR();
  pv_d0(o, vb0 + SHM_V, pa0, pa1, pa2, pa3);
  if (MODE == 0) l_reg += __builtin_amdgcn_exp2f(A.sinkl2 - m_reg * C);
  if (hi == 0) li_l[r32] = l_reg;
  asm volatile("s_waitcnt lgkmcnt(0)" ::: "memory");
  float rli[16];
#pragma unroll
  for (int r = 0; r < 16; ++r) rli[r] = __builtin_amdgcn_rcpf(li_l[crow(r, hi)]);
  bf16_t* Ow = A.Ob + (long)(wq * 32) * A.ldo;
  const int odd = lane & 1;
  int t2_ = threadIdx.x; asm volatile("" : "+v"(t2_));
  const int lane2 = t2_ & 63, r32b = lane2 & 31, hib = lane2 >> 5;
  char* stg = lds + LDS_X + ((MODE == 0) ? (t2_ >> 6) * 8192 : ((t2_ >> 6) & 3) * 16384);
  if (MODE == 0) {
#pragma unroll
    for (int d0 = 0; d0 < 4; ++d0)
#pragma unroll
      for (int rp = 0; rp < 8; ++rp) {
        const float a = o[d0][2 * rp] * rli[2 * rp], b = o[d0][2 * rp + 1] * rli[2 * rp + 1];
        const float send = odd ? a : b; const float recv = __shfl_xor(send, 1);
        const float lo = odd ? recv : a, hh = odd ? b : recv;
        const int row = crow(2 * rp + odd, hib);
        *(unsigned*)(stg + row * 256 + (d0 * 32 + (r32b & ~1)) * 2) = cvtpk(lo, hh);
      }
  } else {
    float* X = (float*)(lds + LDS_X) + wq * (32 * 128);
    if (comp == 1) {
      const float lam = A.lam;
#pragma unroll
      for (int d0 = 0; d0 < 4; ++d0)
#pragma unroll
        for (int r = 0; r < 16; ++r) X[crow(r, hi) * 128 + d0 * 32 + r32] = o[d0][r] * rli[r] * lam;
    }
    __syncthreads();
    if (comp == 0) {
      float rs[16];
#pragma unroll
      for (int r = 0; r < 16; ++r) { float ss = 0.f;
#pragma unroll
        for (int d0 = 0; d0 < 4; ++d0) { const float v = o[d0][r] * rli[r] - X[crow(r, hi) * 128 + d0 * 32 + r32]; o[d0][r] = v; ss += v * v; }
        ss += __shfl_xor(ss, 1); ss += __shfl_xor(ss, 2); ss += __shfl_xor(ss, 4); ss += __shfl_xor(ss, 8); ss += __shfl_xor(ss, 16);
        rs[r] = __builtin_amdgcn_rsqf(ss * (1.f / 128.f) + 1e-6f) * 0.8f; }
      asm volatile("s_waitcnt lgkmcnt(0)" ::: "memory");
#pragma unroll
      for (int d0 = 0; d0 < 4; ++d0) { const float g = A.subg[d0 * 32 + r32];
#pragma unroll
        for (int rp = 0; rp < 8; ++rp) {
          const float a = o[d0][2 * rp] * rs[2 * rp] * g, b = o[d0][2 * rp + 1] * rs[2 * rp + 1] * g;
          const float send = odd ? a : b; const float recv = __shfl_xor(send, 1);
          const float lo = odd ? recv : a, hh = odd ? b : recv;
          const int row = crow(2 * rp + odd, hib);
          *(unsigned*)(stg + row * 256 + (d0 * 32 + (r32b & ~1)) * 2) = cvtpk(lo, hh);
        } }
    }
  }
  if (MODE == 0 || comp == 0) {
    asm volatile("s_waitcnt lgkmcnt(0)" ::: "memory");
    const int srow = lane2 >> 4, sch = lane2 & 15;
#pragma unroll
    for (int i = 0; i < 8; ++i) { const int row = srow + 4 * i; const u32x4 v = *(const u32x4*)(stg + row * 256 + sch * 16);
      *(u32x4*)(Ow + (long)row * A.ldo + sch * 8) = v; }
  }
#undef KOFF
#undef SLOAD
#undef SWRITE
#undef SWAIT
#undef RESC
#undef MASKT
}
#undef KSWZ
#undef GASQ
#undef SBAR
}

#define GAS __attribute__((address_space(1)))
#define LAS __attribute__((address_space(3)))
typedef unsigned short bf16;
typedef unsigned v4u __attribute__((ext_vector_type(4)));
typedef float f32x4 __attribute__((ext_vector_type(4)));
typedef short bf16x8 __attribute__((ext_vector_type(8)));
typedef GAS unsigned gu32;
typedef GAS unsigned long long gu64;
#define RLX_AGENT __ATOMIC_RELAXED, __HIP_MEMORY_SCOPE_AGENT
#define LDS_WAIT() asm volatile("s_waitcnt lgkmcnt(0)" ::: "memory")
#define VM_WAIT() asm volatile("s_waitcnt vmcnt(0)" ::: "memory")
__device__ __forceinline__ unsigned long long rt() { return __builtin_amdgcn_s_memrealtime(); }
__device__ __forceinline__ unsigned f2bf(float f) { unsigned u = __builtin_bit_cast(unsigned, f); return (u + 0x7fffu + ((u >> 16) & 1u)) >> 16; }
__device__ __forceinline__ unsigned pk2(float lo, float hi) { return f2bf(lo) | (f2bf(hi) << 16); }

#define XB_TMO      128
#define XB_XCNT(j)  (256  + 64 * (j))
#define XB_XSUB(j)  (1280 + 64 * (j))
#define XB_XGEN(j)  (2304 + 64 * (j))
#define XB_TOP      3328
#define XB_TOPGEN   3392
#define XCD_BAR_WORDS 3456
#define XB_SPIN_CAP (1u << 18)

__device__ __forceinline__ unsigned xb_ld(unsigned* p)              { return __hip_atomic_load(p, __ATOMIC_RELAXED, __HIP_MEMORY_SCOPE_AGENT); }
__device__ __forceinline__ unsigned xb_add(unsigned* p, unsigned v) { return __hip_atomic_fetch_add(p, v, __ATOMIC_RELAXED, __HIP_MEMORY_SCOPE_AGENT); }
__device__ __forceinline__ unsigned xb_xcc_id() { return (unsigned)__builtin_amdgcn_s_getreg((3 << 11) | 20) & 0xFu; }
#define XB_SPIN(cond, bar) do { unsigned _sp = 0; while (cond) { __builtin_amdgcn_s_sleep(1); \
    if ((++_sp & 255u) == 0u) { if (xb_ld(&(bar)[XB_TMO])) break; if (_sp > XB_SPIN_CAP) { atomicAdd(&(bar)[XB_TMO], 1u); break; } } } } while (0)

struct XcdBarrier {
    unsigned* bar; unsigned x;
    volatile LAS unsigned* st;
};

__device__ __forceinline__ XcdBarrier xcd_barrier_post(unsigned* bar, volatile LAS unsigned* st) {
    XcdBarrier b; b.bar = bar; b.x = xb_xcc_id(); b.st = st;
    if (threadIdx.x == 0) (void)xb_add(&bar[XB_XCNT(b.x)], 1u);
    return b;
}
__device__ __forceinline__ void xcd_barrier_complete(unsigned* bar, unsigned x, unsigned& nloc, unsigned& nx) {
    const unsigned G = gridDim.x * gridDim.y * gridDim.z;
    unsigned sum, cnt, mine, sp = 0u;
    for (;;) {
        sum = 0u; cnt = 0u; mine = 0u;
#pragma unroll
        for (unsigned j = 0; j < 16; ++j) { const unsigned c = xb_ld(&bar[XB_XCNT(j)]); sum += c; cnt += (c > 0u) ? 1u : 0u; mine = (j == x) ? c : mine; }
        if (sum == G) break;
        __builtin_amdgcn_s_sleep(1);
        if ((++sp & 255u) == 0u) { if (xb_ld(&bar[XB_TMO])) break; if (sp > XB_SPIN_CAP) { atomicAdd(&bar[XB_TMO], 1u); break; } }
    }
    nloc = mine > 0u ? mine : 1u; nx = cnt > 0u ? cnt : 1u;
}

__device__ __forceinline__ void xcd_barrier(const XcdBarrier& b) {
    asm volatile("s_waitcnt vmcnt(0)" ::: "memory");
    __syncthreads();
    if (threadIdx.x == 0) {
        unsigned* bar = b.bar;
        __builtin_amdgcn_s_waitcnt(0);
        unsigned nloc = b.st[0], nx = b.st[1];
        if (nloc == 0u) { xcd_barrier_complete(bar, b.x, nloc, nx); b.st[0] = nloc; b.st[1] = nx; }
        const unsigned old = xb_add(&bar[XB_XSUB(b.x)], 1u);
        const unsigned gen = old / nloc;
        if (old + 1u == (gen + 1u) * nloc) {
            __builtin_amdgcn_fence(__ATOMIC_RELEASE, "agent");
            asm volatile("s_waitcnt vmcnt(0)" ::: "memory");
            const unsigned og = xb_add(&bar[XB_TOP], 1u);
            const unsigned tg = og / nx;
            if (og + 1u == (tg + 1u) * nx) xb_add(&bar[XB_TOPGEN], 1u);
            else XB_SPIN(xb_ld(&bar[XB_TOPGEN]) == tg, bar);
            __builtin_amdgcn_fence(__ATOMIC_ACQUIRE, "agent");
            xb_add(&bar[XB_XGEN(b.x)], 1u);
            asm volatile("s_waitcnt vmcnt(0)" ::: "memory");
        } else {
            XB_SPIN(xb_ld(&bar[XB_XGEN(b.x)]) == gen, bar);
            __builtin_amdgcn_fence(__ATOMIC_ACQUIRE, "agent");
            asm volatile("s_waitcnt vmcnt(0)" ::: "memory");
        }
    }
    __syncthreads();
}
#ifndef MK_N_LAUNCHES
#define MK_N_LAUNCHES 1
#endif
constexpr int NPH = 9;
constexpr int N_LAUNCHES = MK_N_LAUNCHES;
constexpr int NWAVES = 8;

constexpr int DM = 4096, DIN = 6144, DFF = 16384, NMOD = 6 * DM;
constexpr int NB_P = 16, T_P = 256, NB_S = 8, T_S = 1024, LCTX = 512;
constexpr int M_P = NB_P * T_P, M_S = NB_S * T_S, MTOK = M_P + M_S;
constexpr int KSPLIT = 8;
constexpr int KVL = LCTX + T_S;
constexpr float EPS = 1e-6f;

constexpr size_t MiB = 1u << 20;
constexpr size_t WS_CTL = 0, CTL_ZERO_BYTES = 1 * MiB;
constexpr size_t WS_MODP = 1 * MiB;
constexpr size_t WS_MODF = 8 * MiB;
constexpr size_t WS_WIN = 16 * MiB, WS_WOUT = 64 * MiB, WS_WFC1 = 96 * MiB, WS_WFC2 = 224 * MiB;
constexpr size_t WS_H = 352 * MiB;
constexpr size_t WS_P = 448 * MiB;
constexpr size_t WS_O = 592 * MiB;
constexpr size_t WS_KVL = 688 * MiB, KVL_SZ = (size_t)NB_S * 4 * KVL * 128 * 2;
constexpr size_t WS_KVP = 736 * MiB, KVP_SZ = (size_t)NB_P * 4 * T_P * 128 * 2;
constexpr size_t WS_U = 752 * MiB;
constexpr size_t WS_X1B = 1136 * MiB;
constexpr size_t WS_END = 1232 * MiB;
static_assert(WS_MODP + (size_t)KSPLIT * 9 * NMOD * 4 <= WS_MODF && WS_MODF + (size_t)9 * NMOD * 4 <= WS_WIN, "ws map");
static_assert(KVL_SZ == 12 * MiB && KVP_SZ == 4 * MiB && WS_U + (size_t)MTOK * DFF * 2 == WS_X1B && WS_X1B + (size_t)MTOK * DM * 2 == WS_END, "ws map");
constexpr int CW_Q = 64;
constexpr int CW_BAR = 4096;

constexpr int RING_BYTES = 131072;
constexpr int MISC_OFF = 143360;
constexpr int LDS_BYTES = 147456;
static_assert(att::LDS_BYTES <= MISC_OFF && RING_BYTES <= MISC_OFF && MISC_OFF + 128 <= LDS_BYTES && 8 * 64 * 68 * 4 <= MISC_OFF, "LDS map");

__device__ __forceinline__ float wave_sum(float v) {
#pragma unroll
    for (int o = 1; o < 64; o <<= 1) v += __shfl_xor(v, o);
    return v;
}
__device__ __forceinline__ float bf2f(unsigned short b) { return __uint_as_float(((unsigned)b) << 16); }

__device__ __forceinline__ int fresh_tid() { int t = threadIdx.x; asm volatile("" : "+v"(t)); return t; }
struct Args { const float* in[26]; float* out; unsigned char* ws; int ph_lo, ph_hi; };

constexpr int TR_LDS = 64 * 68 * 4;
__device__ __forceinline__ unsigned cvtpk_rne(float lo, float hi) { unsigned r; asm volatile("v_cvt_pk_bf16_f32 %0, %1, %2" : "=v"(r) : "v"(lo), "v"(hi)); return r; }
__device__ __forceinline__ void p0_transpose_item(const float* W, int K, int N, bf16* WT, LAS float* scr, int item, int lane) {
    const int nblk = N / 64, kb = item / nblk, nb = item - kb * nblk, k0 = 64 * kb, n0 = 64 * nb;
    const int lr = lane >> 4, lc = (lane & 15) * 4;
    const GAS f32x4* src = (const GAS f32x4*)(W + (size_t)(k0 + lr) * N + n0 + lc);
    f32x4 v[16];
#pragma unroll
    for (int i = 0; i < 16; ++i) v[i] = src[(size_t)i * N];
#pragma unroll
    for (int i = 0; i < 16; ++i) { const int k = lr + 4 * i; *(LAS f32x4*)(scr + k * 68 + (lc ^ ((k >> 3) << 2))) = v[i]; }
    LDS_WAIT(); asm volatile("" ::: "memory");
    const int kc = lane & 7, nl = lane >> 3;
#pragma unroll
    for (int j = 0; j < 8; ++j) { const int n = nl + 8 * j; const LAS float* s = scr + (8 * kc) * 68 + (n ^ (kc << 2));
        v4u o; o.x = cvtpk_rne(s[0 * 68], s[1 * 68]); o.y = cvtpk_rne(s[2 * 68], s[3 * 68]); o.z = cvtpk_rne(s[4 * 68], s[5 * 68]); o.w = cvtpk_rne(s[6 * 68], s[7 * 68]);
        *(GAS v4u*)(WT + (size_t)(n0 + n) * K + k0 + 8 * kc) = o; }
    LDS_WAIT(); asm volatile("" ::: "memory");
}
__device__ __forceinline__ void mod_block_item(const Args& a, LAS unsigned char* ldsl, int cc, int kq8, int tid, int lane, int wave) {
    const float* cmat = a.in[6]; const float* cctx = a.in[7]; const float* Wm = a.in[8]; float* part = (float*)(a.ws + WS_MODP);
    f32x4 acc[9];
#pragma unroll
    for (int r = 0; r < 9; ++r) acc[r] = (f32x4){0.f, 0.f, 0.f, 0.f};
    const int krow = kq8 * 512 + wave * 64;
    const GAS f32x4* wp = (const GAS f32x4*)(Wm + (size_t)krow * NMOD + cc * 256) + lane;
    float sv[9];
#pragma unroll
    for (int r = 0; r < 9; ++r) { const float cv = (r < 8) ? cmat[r * DM + krow + lane] : cctx[krow + lane]; sv[r] = cv / (1.f + __expf(-cv)); }
    for (int i0 = 0; i0 < 64; i0 += 16) {
        f32x4 w[16];
#pragma unroll
        for (int i = 0; i < 16; ++i) w[i] = wp[(size_t)(i0 + i) * (NMOD / 4)];
#pragma unroll
        for (int i = 0; i < 16; ++i)
#pragma unroll
            for (int r = 0; r < 9; ++r) { const float s = __uint_as_float(__builtin_amdgcn_readlane(__float_as_uint(sv[r]), i0 + i)); acc[r] += w[i] * s; }
    }
    LAS f32x4* red = (LAS f32x4*)ldsl;
    __syncthreads();
#pragma unroll
    for (int r = 0; r < 9; ++r) red[(wave * 9 + r) * 64 + lane] = acc[r];
    __syncthreads();
    for (int o = tid; o < 9 * 64; o += NWAVES * 64) { const int r = o >> 6, l = o & 63; f32x4 s = red[r * 64 + l];
#pragma unroll
        for (int w2 = 1; w2 < NWAVES; ++w2) s += red[(w2 * 9 + r) * 64 + l];
        *((GAS f32x4*)(part + (size_t)(kq8 * 9 + r) * NMOD + cc * 256) + l) = s; }
    __syncthreads();
}
constexpr int BG_MOD = 64 * KSPLIT, BG_TR = ((DM / 64) * (DM / 64) + (DM / 64) * (DFF / 64) + (DFF / 64) * (DM / 64)) / 8, N_BG = BG_MOD + BG_TR;
#ifndef BG_Q2
#define BG_Q2 1024
#endif
__device__ __forceinline__ void bg_items(const Args& a, LAS unsigned char* ldsl, int lo, int hi, int start, int stride, int tid, int lane, int wave) {
    constexpr int I_OUT = (DM / 64) * (DM / 64), I_FC1 = (DM / 64) * (DFF / 64);
    LAS float* scr = (LAS float*)(ldsl + wave * TR_LDS);
    for (int bi = lo + start; bi < hi; bi += stride) {
        if (bi < BG_MOD) { mod_block_item(a, ldsl, 32 + (bi & 63), bi >> 6, tid, lane, wave); continue; }
        int r = (bi - BG_MOD) * 8 + wave;
        if (r < I_OUT) { p0_transpose_item(a.in[22], DM, DM, (bf16*)(a.ws + WS_WOUT), scr, r, lane); continue; } r -= I_OUT;
        if (r < I_FC1) { p0_transpose_item(a.in[24], DM, DFF, (bf16*)(a.ws + WS_WFC1), scr, r, lane); continue; } r -= I_FC1;
        p0_transpose_item(a.in[25], DFF, DM, (bf16*)(a.ws + WS_WFC2), scr, r, lane);
    }
}

template <int WHICH>
__device__ __forceinline__ void norm_phase(const Args& a, LAS unsigned char* lds, int vcu, int G, int wave) {
    const int tid = fresh_tid(), lane = tid & 63;
    LAS float* Gv = (LAS float*)lds; LAS float* Sv = Gv + DM;
    const float* bmod = a.in[9]; const float* part = (const float*)(a.ws + WS_MODP); float* modf = (float*)(a.ws + WS_MODF);
    const float* gn = WHICH == 0 ? a.in[10] : a.in[23];
    bf16* H = (bf16*)(a.ws + WS_H);
    const int rows_per = (MTOK + G - 1) / G; int m = vcu * rows_per; const int mend = (m + rows_per < MTOK) ? m + rows_per : MTOK;
    while (m < mend) {
        const int r = (m < M_P) ? 8 : (m - M_P) / T_S;
        const int bnd = (m < M_P) ? M_P : M_P + (r + 1) * T_S; const int send = bnd < mend ? bnd : mend;
        __syncthreads();
        for (int c = tid; c < DM; c += NWAVES * 64) {
            float sh, sc;
            if (WHICH == 0) { sh = bmod[c]; sc = bmod[DM + c];
#pragma unroll
                for (int p = 0; p < KSPLIT; ++p) { sh += part[((size_t)p * 9 + r) * NMOD + c]; sc += part[((size_t)p * 9 + r) * NMOD + DM + c]; } }
            else { sh = modf[(size_t)r * NMOD + 3 * DM + c]; sc = modf[(size_t)r * NMOD + 4 * DM + c]; }
            Gv[c] = gn[c] * (1.f + sc); Sv[c] = sh; }
        __syncthreads();
        for (int mm = m + wave; mm < send; mm += NWAVES) {
            if (WHICH == 0) {
                const float* xrow = (mm < M_P) ? a.in[0] + (size_t)mm * DM : a.in[1] + (size_t)(mm - M_P) * DM;
                const GAS f32x4* xr = (const GAS f32x4*)xrow + 2 * lane;
                f32x4 v[16]; float s = 0.f;
#pragma unroll
                for (int j = 0; j < 8; ++j) { v[2 * j] = xr[128 * j]; v[2 * j + 1] = xr[128 * j + 1]; }
#pragma unroll
                for (int j = 0; j < 16; ++j) s += (v[j].x * v[j].x + v[j].y * v[j].y) + (v[j].z * v[j].z + v[j].w * v[j].w);
                const float rstd = __builtin_amdgcn_rsqf(wave_sum(s) * (1.f / DM) + EPS);
                GAS v4u* o16 = (GAS v4u*)(H + (size_t)mm * DM) + lane;
#pragma unroll
                for (int j = 0; j < 8; ++j) { const int c0 = 8 * (lane + 64 * j);
                    const f32x4 g0 = *(const LAS f32x4*)(Gv + c0), g1 = *(const LAS f32x4*)(Gv + c0 + 4), s0 = *(const LAS f32x4*)(Sv + c0), s1 = *(const LAS f32x4*)(Sv + c0 + 4);
                    const f32x4 y0 = v[2 * j] * rstd * g0 + s0, y1 = v[2 * j + 1] * rstd * g1 + s1;
                    v4u o; o.x = pk2(y0.x, y0.y); o.y = pk2(y0.z, y0.w); o.z = pk2(y1.x, y1.y); o.w = pk2(y1.z, y1.w);
                    o16[64 * j] = o; }
            } else {
                const GAS v4u* xr = (const GAS v4u*)((const bf16*)(a.ws + WS_X1B) + (size_t)mm * DM) + lane;
                v4u v[8]; float s = 0.f;
#pragma unroll
                for (int j = 0; j < 8; ++j) { v[j] = xr[64 * j];
#pragma unroll
                    for (int e = 0; e < 4; ++e) { const float lo = __uint_as_float(v[j][e] << 16), hi = __uint_as_float(v[j][e] & 0xffff0000u); s += lo * lo + hi * hi; } }
                const float rstd = __builtin_amdgcn_rsqf(wave_sum(s) * (1.f / DM) + EPS);
                GAS v4u* o16 = (GAS v4u*)(H + (size_t)mm * DM) + lane;
#pragma unroll
                for (int j = 0; j < 8; ++j) { const int c0 = 8 * (lane + 64 * j); v4u o;
                    const f32x4 g0 = *(const LAS f32x4*)(Gv + c0), g1 = *(const LAS f32x4*)(Gv + c0 + 4), s0 = *(const LAS f32x4*)(Sv + c0), s1 = *(const LAS f32x4*)(Sv + c0 + 4);
                    const float x0 = __uint_as_float(v[j].x << 16), x1 = __uint_as_float(v[j].x & 0xffff0000u), x2 = __uint_as_float(v[j].y << 16), x3 = __uint_as_float(v[j].y & 0xffff0000u);
                    const float x4 = __uint_as_float(v[j].z << 16), x5 = __uint_as_float(v[j].z & 0xffff0000u), x6 = __uint_as_float(v[j].w << 16), x7 = __uint_as_float(v[j].w & 0xffff0000u);
                    o.x = pk2(x0 * rstd * g0.x + s0.x, x1 * rstd * g0.y + s0.y); o.y = pk2(x2 * rstd * g0.z + s0.z, x3 * rstd * g0.w + s0.w);
                    o.z = pk2(x4 * rstd * g1.x + s1.x, x5 * rstd * g1.y + s1.y); o.w = pk2(x6 * rstd * g1.z + s1.z, x7 * rstd * g1.w + s1.w);
                    o16[64 * j] = o; }
            }
        }
        m = send;
    }
    __syncthreads();
}

__device__ __forceinline__ void qk_item(const Args& a, const v4u raw, int it, int lane, bf16* P, float* onew, const LAS float* c128, const LAS float* s128, const LAS float* c64, const LAS float* s64) {
    const int sub = lane & 15, sg = lane >> 4;
    const int m = it / 12, grp = it - m * 12; bf16* src = P + (size_t)m * DIN + grp * 512 + lane * 8;
        float x[8];
        x[0] = __uint_as_float(raw.x << 16); x[1] = __uint_as_float(raw.x & 0xffff0000u); x[2] = __uint_as_float(raw.y << 16); x[3] = __uint_as_float(raw.y & 0xffff0000u);
        x[4] = __uint_as_float(raw.z << 16); x[5] = __uint_as_float(raw.z & 0xffff0000u); x[6] = __uint_as_float(raw.w << 16); x[7] = __uint_as_float(raw.w & 0xffff0000u);
        const bool lat = m >= M_P; const int t = lat ? (m - M_P) % T_S : m % T_P; const int b = lat ? (m - M_P) / T_S : m / T_P;
        const bool is_v = (grp == 5 || grp == 11);
        const bool is_a = grp < 6;
        if (!is_v) {
            float ss = 0.f;
#pragma unroll
            for (int e = 0; e < 8; ++e) ss += x[e] * x[e];
            ss += __shfl_xor(ss, 1); ss += __shfl_xor(ss, 2); ss += __shfl_xor(ss, 4);
            if (is_a) ss += __shfl_xor(ss, 8);
            const float rstd = __builtin_amdgcn_rsqf(ss * (is_a ? (1.f / 128.f) : (1.f / 64.f)) + EPS);
            const float* gp = (grp < 4) ? a.in[12] : (grp == 4) ? a.in[13] : (grp < 10) ? a.in[14] : a.in[15];
            const int goff = is_a ? sub * 8 : (sub & 7) * 8;
            const f32x4 g0 = *(const GAS f32x4*)(gp + goff), g1 = *(const GAS f32x4*)(gp + goff + 4);
            x[0] *= rstd * g0.x; x[1] *= rstd * g0.y; x[2] *= rstd * g0.z; x[3] *= rstd * g0.w; x[4] *= rstd * g1.x; x[5] *= rstd * g1.y; x[6] *= rstd * g1.z; x[7] *= rstd * g1.w;
            if (lat) {
                float px[8];
                if (is_a) {
#pragma unroll
                    for (int e = 0; e < 8; ++e) px[e] = __shfl_xor(x[e], 4);
                    const int axis = (sub >> 3) & 1, half = (sub >> 2) & 1, i0 = (sub & 3) * 8, pos = axis ? (t & 63) : (t >> 6);
#pragma unroll
                    for (int e = 0; e < 8; ++e) { const float cs = c128[pos * 32 + i0 + e], sn = s128[pos * 32 + i0 + e]; x[e] = half ? (x[e] * cs + px[e] * sn) : (x[e] * cs - px[e] * sn); }
                } else {
#pragma unroll
                    for (int e = 0; e < 8; ++e) px[e] = __shfl_xor(x[e], 2);
                    const int s8 = sub & 7, axis = (s8 >> 2) & 1, half = (s8 >> 1) & 1, i0 = (s8 & 1) * 8, pos = axis ? (t & 63) : (t >> 6);
#pragma unroll
                    for (int e = 0; e < 8; ++e) { const float cs = c64[pos * 16 + i0 + e], sn = s64[pos * 16 + i0 + e]; x[e] = half ? (x[e] * cs + px[e] * sn) : (x[e] * cs - px[e] * sn); }
                }
            }
        }
        v4u ob; ob.x = pk2(x[0], x[1]); ob.y = pk2(x[2], x[3]); ob.z = pk2(x[4], x[5]); ob.w = pk2(x[6], x[7]);
        const bool is_q = (grp < 4) || (grp >= 6 && grp < 10);
        if (is_q) { *(GAS v4u*)src = ob; }
        else {
            const int which = (grp == 4) ? 0 : (grp == 5) ? 1 : (grp == 10) ? 2 : 3;
            const int kv = sg;
            if (lat) { *(GAS v4u*)((bf16*)(a.ws + WS_KVL + (size_t)which * KVL_SZ) + ((size_t)(b * 4 + kv) * KVL + LCTX + t) * 128 + sub * 8) = ob; }
            else { *(GAS v4u*)((bf16*)(a.ws + WS_KVP + (size_t)which * KVP_SZ) + ((size_t)(b * 4 + kv) * T_P + t) * 128 + sub * 8) = ob;
                GAS f32x4* of = (GAS f32x4*)(onew + (size_t)which * M_P * 512 + (size_t)m * 512 + kv * 128 + sub * 8);
                of[0] = (f32x4){x[0], x[1], x[2], x[3]}; of[1] = (f32x4){x[4], x[5], x[6], x[7]}; }
        }

}
__device__ __forceinline__ void qk_phase(const Args& a, LAS unsigned char* lds, int vcu, int G, int wave) {
    const int tid = fresh_tid(), lane = tid & 63;
    LAS float* c128 = (LAS float*)lds; LAS float* s128 = c128 + 2048; LAS float* c64 = s128 + 2048; LAS float* s64 = c64 + 1024;
    for (int e = tid; e < 2048; e += NWAVES * 64) { const int pos = e >> 5, i = e & 31; const float f = exp2f(-(float)i * (13.287712379549449f / 32.f)); float sn, cs; sincosf((float)pos * f, &sn, &cs); c128[e] = cs; s128[e] = sn; }
    for (int e = tid; e < 1024; e += NWAVES * 64) { const int pos = e >> 4, i = e & 15; const float f = exp2f(-(float)i * (13.287712379549449f / 16.f)); float sn, cs; sincosf((float)pos * f, &sn, &cs); c64[e] = cs; s64[e] = sn; }
    __syncthreads();
    bf16* P = (bf16*)(a.ws + WS_P);
    float* onew = a.out + (size_t)MTOK * DM;
    const int gw = vcu * NWAVES + wave, NGW = G * NWAVES;
#define QK_SRC(it_) (P + (size_t)((it_) / 12) * DIN + ((it_) % 12) * 512 + lane * 8)
    for (int it = gw; it < MTOK * 12; it += 4 * NGW) {
        const int it1 = it + NGW, it2 = it + 2 * NGW, it3 = it + 3 * NGW;
        v4u r0, r1 = {0u, 0u, 0u, 0u}, r2 = {0u, 0u, 0u, 0u}, r3 = {0u, 0u, 0u, 0u};
        r0 = *(const GAS v4u*)QK_SRC(it);
        if (it1 < MTOK * 12) r1 = *(const GAS v4u*)QK_SRC(it1);
        if (it2 < MTOK * 12) r2 = *(const GAS v4u*)QK_SRC(it2);
        if (it3 < MTOK * 12) r3 = *(const GAS v4u*)QK_SRC(it3);
        qk_item(a, r0, it, lane, P, onew, c128, s128, c64, s64);
        if (it1 < MTOK * 12) qk_item(a, r1, it1, lane, P, onew, c128, s128, c64, s64);
        if (it2 < MTOK * 12) qk_item(a, r2, it2, lane, P, onew, c128, s128, c64, s64);
        if (it3 < MTOK * 12) qk_item(a, r3, it3, lane, P, onew, c128, s128, c64, s64);
    }
#undef QK_SRC
    __syncthreads();
}

__device__ __forceinline__ void attn_phase(const Args& a, unsigned char* lds_g, int G, int wave) {
    const int lane = fresh_tid() & 63;
    const bf16* P = (const bf16*)(a.ws + WS_P); bf16* O = (bf16*)(a.ws + WS_O);
    const bf16* KA_l = (const bf16*)(a.ws + WS_KVL); const bf16* VA_l = (const bf16*)(a.ws + WS_KVL + KVL_SZ); const bf16* KB_l = (const bf16*)(a.ws + WS_KVL + 2 * KVL_SZ); const bf16* VB_l = (const bf16*)(a.ws + WS_KVL + 3 * KVL_SZ);
    const bf16* KA_p = (const bf16*)(a.ws + WS_KVP); const bf16* VA_p = (const bf16*)(a.ws + WS_KVP + KVP_SZ); const bf16* KB_p = (const bf16*)(a.ws + WS_KVP + 2 * KVP_SZ); const bf16* VB_p = (const bf16*)(a.ws + WS_KVP + 3 * KVP_SZ);
    float* misc = (float*)(lds_g + att::LDS_MISC);
    if (wave == 0) { const float p1 = a.in[17][lane] * a.in[18][lane], p2 = a.in[19][lane] * a.in[20][lane];
        const float s1 = wave_sum(p1), s2 = wave_sum(p2); if (lane == 0) misc[0] = __expf(s1) - __expf(s2) + 0.2f; }
    __syncthreads();
    const float lam = misc[0];
    const int nper = G / 8;
    const int c = blockIdx.x, x = c % 8, j = c / 8;
    att::UnitArgs U;
#ifndef ATT_NO_MODE1
    for (int u = c; u < NB_S * 16 * 8 + NB_P * 16 * 2; u += G) {
        const bool lat = u < NB_S * 16 * 8; const int uu = lat ? u : u - NB_S * 16 * 8; const int i = uu / G;
        int gid, g, qb;
        if (lat) { if (G == 256) { gid = i * 8 + x; g = j >> 3; qb = j & 7; } else { gid = uu >> 5; g = (uu >> 3) & 3; qb = uu & 7; } }
        else     { if (G == 256) { gid = (i * 8 + x) * 4 + (j >> 3); g = (j >> 1) & 3; qb = j & 1; } else { gid = uu >> 3; g = (uu >> 1) & 3; qb = uu & 1; } }
        const int b = gid >> 2, kv = gid & 3, h = kv * 4 + g; const int m0 = lat ? M_P + b * T_S + qb * 128 : b * T_P + qb * 128;
        const size_t kvoff = lat ? (size_t)(b * 4 + kv) * KVL * 128 : (size_t)(b * 4 + kv) * T_P * 128;
        U.Qb = P + (size_t)m0 * DIN + 3072 + h * 128; U.ldq = DIN; U.Kh = (lat ? KB_l : KB_p) + kvoff; U.Vh = (lat ? VB_l : VB_p) + kvoff;
        U.Ob = O + (size_t)m0 * DM + 2048 + h * 128; U.ldo = DM; U.NT = lat ? KVL / 64 : T_P / 64; U.jwin = 1 << 30; U.wadd = 0; U.masked = 0; U.t0 = 0; U.sinkl2 = 0.f; U.lam = lam; U.subg = a.in[21];
        att::attn_unit<1>(U, (char*)lds_g);
    }
#endif
#ifndef ATT_NO_MODE0
    for (int u = c; u < NB_S * 16 * 4 + NB_P * 16; u += G) {
        const bool lat = u < NB_S * 16 * 4; const int uu = lat ? u : u - NB_S * 16 * 4; const int i = uu / G;
        int gid, g, qb2;
        if (lat) { if (G == 256) { gid = (i * 8 + x) * 2 + (j >> 4); g = (j >> 2) & 3; qb2 = j & 3; } else { gid = uu >> 4; g = (uu >> 2) & 3; qb2 = uu & 3; } }
        else     { if (G == 256) { gid = x * 8 + (j >> 2); g = j & 3; qb2 = 0; } else { gid = uu >> 2; g = uu & 3; qb2 = 0; } }
        const int b = gid >> 2, kv = gid & 3, h = kv * 4 + g; const int t0 = qb2 * 256, m0 = lat ? M_P + b * T_S + t0 : b * T_P;
        const int wstart = (t0 - 128 > 0) ? t0 - 128 : 0, wend = (t0 + 384 < T_S) ? t0 + 384 : T_S;
        const size_t kvoff = lat ? (size_t)(b * 4 + kv) * KVL * 128 : (size_t)(b * 4 + kv) * T_P * 128;
        U.Qb = P + (size_t)m0 * DIN + h * 128; U.ldq = DIN; U.Kh = (lat ? KA_l : KA_p) + kvoff; U.Vh = (lat ? VA_l : VA_p) + kvoff;
        U.Ob = O + (size_t)m0 * DM + h * 128; U.ldo = DM; U.NT = lat ? 8 + (wend - wstart) / 64 : T_P / 64; U.jwin = lat ? 8 : (1 << 30); U.wadd = lat ? wstart : 0; U.masked = lat ? 1 : 0; U.t0 = t0;
        U.sinkl2 = a.in[16][h] * att::LOG2E; U.lam = 0.f; U.subg = nullptr;
        att::attn_unit<0>(U, (char*)lds_g);
    }
#endif
    __syncthreads();
}


__device__ __forceinline__ void p0_phase(const Args& args, LAS unsigned char* ldsl, int vcu, int G, int wave) {
    const int tid = fresh_tid(), lane = tid & 63;
    for (int it = vcu; it < 32 * KSPLIT; it += G) mod_block_item(args, ldsl, it & 31, it >> 5, tid, lane, wave);
}
__device__ __forceinline__ void p1_extras(const Args& args, LAS unsigned char* ldsl, int vcu, int G, int wave) {
    const int lane = fresh_tid() & 63;
    LAS float* scr = (LAS float*)(ldsl + wave * TR_LDS);
    constexpr int I_IN = (DM / 64) * (DIN / 64);
    for (int r = vcu * NWAVES + wave; r < I_IN; r += G * NWAVES) p0_transpose_item(args.in[11], DM, DIN, (bf16*)(args.ws + WS_WIN), scr, r, lane);
    for (int it = vcu * NWAVES + wave; it < 4 * 4096; it += G * NWAVES) {
        const int tsr = it >> 12, w = it & 4095; const size_t e = ((size_t)w * 64 + lane) * 8;
        const float* src = args.in[2 + tsr] + e; const f32x4 v0 = *(const GAS f32x4*)src, v1 = *(const GAS f32x4*)(src + 4);
        const int d = (int)(e & 127), kv = (int)((e >> 7) & 3), key = (int)((e >> 9) & 511), b = (int)(e >> 18);
        v4u o; o.x = pk2(v0.x, v0.y); o.y = pk2(v0.z, v0.w); o.z = pk2(v1.x, v1.y); o.w = pk2(v1.z, v1.w);
        *(GAS v4u*)((bf16*)(args.ws + WS_KVL + tsr * KVL_SZ) + ((size_t)(b * 4 + kv) * KVL + key) * 128 + d) = o; }
}
__device__ __forceinline__ void p3_extras(const Args& args, LAS unsigned char* ldsl, int vcu, int G, int q2, int wave) {
    const int tid = fresh_tid(), lane = tid & 63;
    bg_items(args, ldsl, q2, N_BG, vcu, G, tid, lane, wave);
    __syncthreads();
}
__device__ __forceinline__ void modf_rest(const Args& args, int vcu, int G) {
    const int tid = fresh_tid();
    const float* bmod = args.in[9]; const float* part = (const float*)(args.ws + WS_MODP); float* modf = (float*)(args.ws + WS_MODF);
    for (int e = vcu * (NWAVES * 64) + tid; e < 9 * 4 * DM; e += G * NWAVES * 64) { const int r = e / (4 * DM), n = 2 * DM + e % (4 * DM);
        float s = bmod[n];
#pragma unroll
        for (int p = 0; p < KSPLIT; ++p) s += part[((size_t)p * 9 + r) * NMOD + n];
        modf[(size_t)r * NMOD + n] = s; }
}
#ifndef GEMM_ALIGN
#define GEMM_ALIGN true
#endif
#ifndef GEMM_SP2
#define GEMM_SP2 true
#endif
#ifndef U_NT
#define U_NT true
#endif
constexpr int P2_G = 232;
__device__ __forceinline__ void p2_phase(const Args& args, LAS unsigned char* ldsl, int G, int bx, int wave) {
    const bool split = (G == 256);
    if (!split || bx < P2_G) {
        pg8::Gemm g{(const pg8::bf16_t*)(args.ws + WS_H), (const pg8::bf16_t*)(args.ws + WS_WIN), MTOK, DIN, DM}; pg8::StaticOrder S; S.init(MTOK, DIN, split ? P2_G : G, bx);
        pg8::EpiBf16<0> E{(pg8::bf16_t*)(args.ws + WS_P), DIN};
        pg8::gemm_phase<pg8::EpiBf16<0>, pg8::StaticOrder, GEMM_ALIGN, GEMM_SP2>(ldsl, g, S, E);
    } else {
        const int tid = fresh_tid(), lane = tid & 63;
        bg_items(args, ldsl, 0, BG_Q2, bx - P2_G, G - P2_G, tid, lane, wave);
    }
}
__device__ __forceinline__ void p5_phase(const Args& args, LAS unsigned char* ldsl, int G, int bx) {
    pg8::Gemm g{(const pg8::bf16_t*)(args.ws + WS_O), (const pg8::bf16_t*)(args.ws + WS_WOUT), MTOK, DM, DM}; pg8::StaticOrder S; S.init(MTOK, DM, G, bx);
    const float* modf = (const float*)(args.ws + WS_MODF);
    pg8::EpiResidB E{args.in[0], args.in[1], (pg8::bf16_t*)(args.ws + WS_X1B), DM, M_P / 256, modf + 2 * DM, NMOD, modf + (size_t)8 * NMOD + 2 * DM};
    pg8::gemm_phase<pg8::EpiResidB, pg8::StaticOrder, GEMM_ALIGN, GEMM_SP2>(ldsl, g, S, E);
}
__device__ __forceinline__ void p7_phase(const Args& args, LAS unsigned char* ldsl, int G, int bx) {
    pg8::Gemm g{(const pg8::bf16_t*)(args.ws + WS_H), (const pg8::bf16_t*)(args.ws + WS_WFC1), MTOK, DFF, DM}; pg8::StaticOrder S; S.init(MTOK, DFF, G, bx);
    pg8::EpiBf16<1, U_NT> E{(pg8::bf16_t*)(args.ws + WS_U), DFF};
    pg8::gemm_phase<pg8::EpiBf16<1, U_NT>, pg8::StaticOrder, GEMM_ALIGN, GEMM_SP2>(ldsl, g, S, E);
}
__device__ __forceinline__ void p7_null_phase(const Args& args, LAS unsigned char* ldsl, int G, int bx) {
    pg8::Gemm g{(const pg8::bf16_t*)(args.ws + WS_H), (const pg8::bf16_t*)(args.ws + WS_WFC1), MTOK, DFF, DM}; pg8::StaticOrder S; S.init(MTOK, DFF, G, bx);
    pg8::EpiNull E{};
    pg8::gemm_phase<pg8::EpiNull, pg8::StaticOrder, GEMM_ALIGN, GEMM_SP2>(ldsl, g, S, E);
}
__device__ __forceinline__ void p8_null_phase(const Args& args, LAS unsigned char* ldsl, int G, int bx) {
    pg8::Gemm g{(const pg8::bf16_t*)(args.ws + WS_U), (const pg8::bf16_t*)(args.ws + WS_WFC2), MTOK, DM, DFF}; pg8::StaticOrder S; S.init(MTOK, DM, G, bx);
    pg8::EpiNull E{};
    pg8::gemm_phase<pg8::EpiNull, pg8::StaticOrder, GEMM_ALIGN, GEMM_SP2>(ldsl, g, S, E);
}
__device__ __forceinline__ void p8_phase(const Args& args, LAS unsigned char* ldsl, int G, int bx) {
    pg8::Gemm g{(const pg8::bf16_t*)(args.ws + WS_U), (const pg8::bf16_t*)(args.ws + WS_WFC2), MTOK, DM, DFF}; pg8::StaticOrder S; S.init(MTOK, DM, G, bx);
    const float* modf = (const float*)(args.ws + WS_MODF);
    pg8::EpiResid E{(const pg8::bf16_t*)(args.ws + WS_X1B), args.out, DM, M_P / 256, modf + 5 * DM, NMOD, modf + (size_t)8 * NMOD + 5 * DM};
    pg8::gemm_phase<pg8::EpiResid, pg8::StaticOrder, GEMM_ALIGN, GEMM_SP2>(ldsl, g, S, E);
}

__global__ void __launch_bounds__(NWAVES * 64, 2) fwd_kernel(Args args) {
    extern __shared__ __attribute__((aligned(16))) unsigned char lds[];
    LAS unsigned char* ldsl = (LAS unsigned char*)lds;
    volatile LAS unsigned* MISC = (volatile LAS unsigned*)(ldsl + MISC_OFF);
    const int tid = threadIdx.x, wave = __builtin_amdgcn_readfirstlane(tid >> 6);
    const int G = gridDim.x; const int bx = blockIdx.x; const int vcu = (G % 8 == 0) ? (bx % 8) * (G / 8) + bx / 8 : bx;
    gu32* ctl = (gu32*)(args.ws + WS_CTL);
    for (int u = tid; u < (LDS_BYTES - MISC_OFF) / 4; u += NWAVES * 64) ((LAS unsigned*)(ldsl + MISC_OFF))[u] = 0u;
    __syncthreads();
    XcdBarrier bar; bar.bar = (unsigned*)(ctl + CW_BAR); bar.x = 0; bar.st = nullptr;
    if (N_LAUNCHES == 1) bar = xcd_barrier_post((unsigned*)(ctl + CW_BAR), MISC + 8);
    const int lo = args.ph_lo, hi = args.ph_hi;
#ifndef PHASE_MASK
#define PHASE_MASK 0x1ff
#endif
#define IN(k) ((((PHASE_MASK) >> (k)) & 1) && lo <= (k) && (k) < hi)
#define SEAM(k) do { if (IN(k) && IN((k) + 1)) xcd_barrier(bar); } while (0)

#ifndef PROBE_REPEAT
#define PROBE_REPEAT (-1)
#endif
#if defined(PROBE_TIME)
    unsigned long long pt0 = 0, pt1 = 0;
#define PT_BEGIN(k) do { if (PROBE_TIME == (k)) pt0 = wall_clock64(); } while (0)
#define PT_END(k) do { if (PROBE_TIME == (k)) pt1 = wall_clock64(); } while (0)
#else
#define PT_BEGIN(k) do { } while (0)
#define PT_END(k) do { } while (0)
#endif
#define REP(k, call) do { if (PROBE_REPEAT == (k)) { call; xcd_barrier(bar); } } while (0)
    PT_BEGIN(0);
    if (IN(0)) p0_phase(args, ldsl, vcu, G, wave);
    SEAM(0); PT_END(0);
    PT_BEGIN(1);
    if (IN(1)) { norm_phase<0>(args, ldsl, vcu, G, wave); p1_extras(args, ldsl, vcu, G, wave); }
    SEAM(1); PT_END(1);
    PT_BEGIN(2);
    if (IN(2)) p2_phase(args, ldsl, G, bx, wave);
    SEAM(2); PT_END(2);
    PT_BEGIN(3);
    if (IN(3)) { p3_extras(args, ldsl, vcu, G, (G == 256) ? BG_Q2 : 0, wave); qk_phase(args, ldsl, vcu, G, wave); }
    SEAM(3); PT_END(3);
    PT_BEGIN(4);
    if (IN(4)) { modf_rest(args, vcu, G); attn_phase(args, lds, G, wave); }
    SEAM(4); PT_END(4); REP(4, attn_phase(args, lds, G, wave));
    PT_BEGIN(5);
    if (IN(5)) p5_phase(args, ldsl, G, bx);
    SEAM(5); PT_END(5); REP(5, p5_phase(args, ldsl, G, bx));
    PT_BEGIN(6);
    if (IN(6)) norm_phase<1>(args, ldsl, vcu, G, wave);
    SEAM(6); PT_END(6); REP(6, norm_phase<1>(args, ldsl, vcu, G, wave));
#if defined(PROBE_CLOCK)
    unsigned long long pc0 = 0, pr0 = 0, pc1 = 0, pr1 = 0;
    if (PROBE_CLOCK == 7) { pc0 = clock64(); pr0 = wall_clock64(); }
#endif
    PT_BEGIN(7);
    if (IN(7)) p7_phase(args, ldsl, G, bx);
#if defined(PROBE_CLOCK)
    if (PROBE_CLOCK == 7) { pc1 = clock64(); pr1 = wall_clock64(); }
#endif
    SEAM(7); PT_END(7); REP(7, p7_phase(args, ldsl, G, bx)); REP(17, p7_null_phase(args, ldsl, G, bx)); REP(18, p8_null_phase(args, ldsl, G, bx));
    PT_BEGIN(8);
    if (IN(8)) p8_phase(args, ldsl, G, bx);
#if defined(PROBE_TIME)
    PT_END(8);
    if (bx == 0 && tid == 0) { const unsigned long long t0 = wall_clock64(); while (wall_clock64() - t0 < (pt1 - pt0)) __builtin_amdgcn_s_sleep(8); }
#endif
#if defined(PROBE_CLOCK)
    if (bx == 0 && tid == 0) {
        const unsigned long long ticks = (pc1 - pc0) * 1000ull / (pr1 - pr0);
        const unsigned long long t0 = wall_clock64(); while (wall_clock64() - t0 < ticks) __builtin_amdgcn_s_sleep(8);
    }
#endif
#undef REP
#undef IN
#undef SEAM
}

extern "C" void kernel_launch(void* const* d_in, const int* in_sizes, int n_in, void* d_out, int out_size, void* d_ws, size_t ws_size, hipStream_t stream) {
    static int grid = 0;
    if (grid == 0) {
        if (n_in != 26 || in_sizes[0] != M_P * DM || in_sizes[1] != M_S * DM || out_size != MTOK * DM + 4 * M_P * 512 || ws_size < WS_END) {
            fprintf(stderr, "kernel_launch: shape mismatch (n_in %d in0 %d in1 %d out %d ws %zu, need ws >= %zu); nothing launched\n", n_in, n_in > 0 ? in_sizes[0] : -1, n_in > 1 ? in_sizes[1] : -1, out_size, ws_size, (size_t)WS_END); grid = -1; return; }
        int dev = 0, cus = 0, per_cu = 0;
        if (hipGetDevice(&dev) != hipSuccess || hipDeviceGetAttribute(&cus, hipDeviceAttributeMultiprocessorCount, dev) != hipSuccess) { grid = -1; return; }
        if (hipFuncSetAttribute((const void*)fwd_kernel, hipFuncAttributeMaxDynamicSharedMemorySize, LDS_BYTES) != hipSuccess) { fprintf(stderr, "kernel_launch: hipFuncSetAttribute failed\n"); grid = -1; return; }
        if (hipOccupancyMaxActiveBlocksPerMultiprocessor(&per_cu, (const void*)fwd_kernel, NWAVES * 64, LDS_BYTES) != hipSuccess || per_cu < 1) { fprintf(stderr, "kernel_launch: occupancy query says %d blocks per CU\n", per_cu); }
        (void)hipGetLastError();
        grid = cus;
    }
    if (grid < 0) return;
    if (hipMemsetAsync((char*)d_ws + WS_CTL, 0, CTL_ZERO_BYTES, stream) != hipSuccess) return;
    Args a{};
    for (int i = 0; i < 26; ++i) a.in[i] = (const float*)d_in[i];
    a.out = (float*)d_out; a.ws = (unsigned char*)d_ws;
    if (N_LAUNCHES == 1) { a.ph_lo = 0; a.ph_hi = NPH; hipLaunchKernelGGL(fwd_kernel, dim3(grid), dim3(NWAVES * 64), LDS_BYTES, stream, a); }
    else { for (int p = 0; p < NPH; ++p) { a.ph_lo = p; a.ph_hi = p + 1; hipLaunchKernelGGL(fwd_kernel, dim3(grid), dim3(NWAVES * 64), LDS_BYTES, stream, a); } }
    const hipError_t le = hipPeekAtLastError();
    if (le != hipSuccess) fprintf(stderr, "kernel_launch: launch failed: %s\n", hipGetErrorName(le));
}
```

```cpp
#include <hip/hip_runtime.h>
#include <cstdio>
#include <cstdint>
#ifndef PG8_WGM
#define PG8_WGM 8
#endif
namespace pg8 {
#define PG8_LAS __attribute__((address_space(3)))
typedef unsigned short bf16_t;
typedef short bf16x8 __attribute__((ext_vector_type(8)));
typedef float f32x4 __attribute__((ext_vector_type(4)));
typedef unsigned u32x4 __attribute__((ext_vector_type(4)));
constexpr int BM = 256, BK = 64, HALF = 128, HTB = HALF * BK * 2  , STAGE_BYTES = 8 * HTB, NXCD = 8, WGM = PG8_WGM;

__host__ __device__ __forceinline__ int lds_byte(int r, int c) { const int st = (r >> 4) * 2 + (c >> 5), rr = r & 15, cc = c & 31, ob = rr * 64 + cc * 2; return st * 1024 + (ob ^ (((ob >> 9) & 1) << 5)); }
__host__ __device__ __forceinline__ void stage_rc(int b, int& R, int& C) { const int st = b / 1024, sb = b % 1024, swz = sb ^ (((sb >> 9) & 1) << 5); R = (st >> 1) * 16 + swz / 64; C = (st & 1) * 32 + (swz % 64) / 2; }
__host__ __device__ __forceinline__ int perm32(int rho) { const int n = rho >> 4, i = rho & 15; return 8 * (i >> 2) + 4 * n + (i & 3); }

struct Unit { int pm, pn; };
struct Gemm { const bf16_t* A; const bf16_t* Bt; int M, N, K; int a_tiled; };

struct StaticOrder {
    int nM, nN, nwg, G, c;
    __host__ __device__ void init(int M, int N, int G_, int c_) { nM = M / BM; nN = N / BM; nwg = nM * nN; G = G_; c = c_; }
    __host__ __device__ bool next(int i, Unit& u) const {
        const long L = (long)i * G + c; if (L >= nwg) return false;
        int wgid = (int)L; { const int q = nwg / NXCD, r = nwg % NXCD, xcd = wgid % NXCD, off = wgid / NXCD; wgid = (xcd < r ? xcd * (q + 1) : r * (q + 1) + (xcd - r) * q) + off; }
        const int nig = WGM * nN, gid = wgid / nig, fm = gid * WGM, gsz = (nM - fm) < WGM ? (nM - fm) : WGM;
        u.pm = fm + ((wgid % nig) % gsz); u.pn = (wgid % nig) / gsz; return true;
    }
    __device__ __forceinline__ void a_ready(const Unit&) const {}
    __device__ __forceinline__ void done(const Unit&) const {}
};

struct BlockOrder {
    int nM, nN, nqb, nblk, c, G;
    __host__ __device__ void init(int M, int N, int G_, int c_) { nM = M / BM; nN = N / BM; nqb = nN / 4; nblk = (nM / 8) * nqb; c = c_; G = G_; }
    __host__ __device__ bool next(int i, Unit& u) const {
        if (G != 256 || (nM & 7) || (nN & 3)) { const long L = (long)i * G + c; if (L >= (long)nM * nN) return false; u.pm = (int)(L / nN); u.pn = (int)(L % nN); return true; }
        const int x = c & 7, j = c >> 3, b = i * 8 + x; if (b >= nblk) return false;
        const int g = b / nqb, q = b - g * nqb; u.pm = 8 * g + (j & 7); u.pn = 4 * q + (j >> 3); return true;
    }
    __device__ __forceinline__ void a_ready(const Unit&) const {}
    __device__ __forceinline__ void done(const Unit&) const {}
};

__device__ __forceinline__ unsigned cvt_pk_bf16(float lo, float hi) { unsigned r; asm volatile("v_cvt_pk_bf16_f32 %0, %1, %2" : "=v"(r) : "v"(lo), "v"(hi)); return r; }

template <int ACT, bool NT = false, bool TILED = false> struct EpiBf16 {
    static constexpr bool PERM = true, AFTER_DRAIN = false;
    bf16_t* O; int ldc;
    __device__ __forceinline__ void operator()(const f32x4 (&acc)[2][2][4][2], const Unit& u, int wr, int wc, int fr, int fq) const {
        const int row0 = u.pm * BM + wr * 64 + fr; const int col0 = u.pn * BM + wc * 32 + 8 * fq;
#pragma unroll
        for (int ai = 0; ai < 2; ++ai)
#pragma unroll
            for (int m = 0; m < 4; ++m) {
                bf16_t* rowp = TILED ? O + (((size_t)u.pm * (ldc / 64) + u.pn * 4 + (wc >> 1)) * BM + (wr * 64 + fr + ai * HALF + m * 16)) * 64 + (wc & 1) * 32 + 8 * fq
                                     : O + (size_t)(row0 + ai * HALF + m * 16) * ldc + col0;
                constexpr size_t BJ_STEP = TILED ? (size_t)2 * BM * 64 : (size_t)HALF;
#pragma unroll
                for (int bj = 0; bj < 2; ++bj) { f32x4 v0 = acc[ai][bj][m][0], v1 = acc[ai][bj][m][1];
                    if (ACT == 1) {
#pragma unroll
                        for (int j = 0; j < 4; ++j) { const float a = fmaxf(v0[j], 0.f), b = fmaxf(v1[j], 0.f); v0[j] = a * a; v1[j] = b * b; } }
                    u32x4 w; w.x = cvt_pk_bf16(v0[0], v0[1]); w.y = cvt_pk_bf16(v0[2], v0[3]); w.z = cvt_pk_bf16(v1[0], v1[1]); w.w = cvt_pk_bf16(v1[2], v1[3]);
                    if (NT) __builtin_nontemporal_store(w, (u32x4*)(rowp + bj * BJ_STEP)); else *(u32x4*)(rowp + bj * BJ_STEP) = w;
#if defined(PROBE_STORE)
                    if (ACT == 1) {
                        bf16_t* dp = O - ((size_t)304 << 20) / 2; const int pmw = u.pm & 31;
                        if (PROBE_STORE == 1) *(u32x4*)(dp + (size_t)(pmw * BM + wr * 64 + fr + ai * HALF + m * 16) * ldc + col0 + bj * HALF) = w;
                        else if (PROBE_STORE == 2) *(u32x4*)(dp + (size_t)(pmw * BM + wr * 64 + ai * HALF + m * 16 + (fr & 7) + 8 * bj) * ldc + u.pn * BM + wc * 64 + (fr >> 3) * 32 + 8 * fq) = w;
                        else *(u32x4*)(dp + ((size_t)(pmw * (ldc / BM) + u.pn) * BM + (wr * 64 + fr + ai * HALF + m * 16)) * BM + wc * 32 + 8 * fq + bj * HALF) = w;
                    }
#endif
                    } }
    }
};
struct EpiResidB {
    static constexpr bool PERM = true, AFTER_DRAIN = false;
    const float* base0; const float* base1; bf16_t* out; int ldc; int split; const float* gate; int gate_stride; const float* gate_ctx;
    __device__ __forceinline__ void operator()(const f32x4 (&acc)[2][2][4][2], const Unit& u, int wr, int wc, int fr, int fq) const {
        const int rloc = wr * 64 + fr, col0 = u.pn * BM + wc * 32 + 8 * fq;
        const float* bt = (u.pm < split) ? base0 + (size_t)u.pm * BM * ldc : base1 + (size_t)(u.pm - split) * BM * ldc;
        const float* gv = (u.pm < split) ? gate_ctx : gate + (size_t)((u.pm - split) >> 2) * gate_stride;
        bf16_t* ot = out + (size_t)u.pm * BM * ldc;
        f32x4 g[2][2];
#pragma unroll
        for (int bj = 0; bj < 2; ++bj)
#pragma unroll
            for (int n = 0; n < 2; ++n) g[bj][n] = *(const f32x4*)(gv + col0 + bj * HALF + 4 * n);
#pragma unroll
        for (int ai = 0; ai < 2; ++ai)
#pragma unroll
            for (int m = 0; m < 4; ++m) { const size_t off = (size_t)(rloc + ai * HALF + m * 16) * ldc + col0;
#pragma unroll
                for (int bj = 0; bj < 2; ++bj) { const f32x4 b0 = *(const f32x4*)(bt + off + bj * HALF), b1 = *(const f32x4*)(bt + off + bj * HALF + 4);
                    const f32x4 v0 = b0 + g[bj][0] * acc[ai][bj][m][0], v1 = b1 + g[bj][1] * acc[ai][bj][m][1];
                    u32x4 w; w.x = cvt_pk_bf16(v0[0], v0[1]); w.y = cvt_pk_bf16(v0[2], v0[3]); w.z = cvt_pk_bf16(v1[0], v1[1]); w.w = cvt_pk_bf16(v1[2], v1[3]);
                    *(u32x4*)(ot + off + bj * HALF) = w; }
                if (m & 1) asm volatile("" ::: "memory"); }
    }
};
struct EpiResid {
    static constexpr bool PERM = false, AFTER_DRAIN = false;
    const bf16_t* base; float* out; int ldc; int split; const float* gate; int gate_stride; const float* gate_ctx;
    __device__ __forceinline__ void operator()(const f32x4 (&acc)[2][2][4][2], const Unit& u, int wr, int wc, int fr, int fq) const {
        typedef unsigned u32x2 __attribute__((ext_vector_type(2)));
        const int rloc = wr * 64 + fr, col0 = u.pn * BM + wc * 32 + 4 * fq;
        const bf16_t* bt = base + (size_t)u.pm * BM * ldc;
        const float* gv = (u.pm < split) ? gate_ctx : gate + (size_t)((u.pm - split) >> 2) * gate_stride;
        float* ot = out + (size_t)u.pm * BM * ldc;
        f32x4 g[2][2];
#pragma unroll
        for (int bj = 0; bj < 2; ++bj)
#pragma unroll
            for (int n = 0; n < 2; ++n) g[bj][n] = *(const f32x4*)(gv + col0 + bj * HALF + n * 16);
#pragma unroll
        for (int ai = 0; ai < 2; ++ai)
#pragma unroll
            for (int m = 0; m < 4; ++m) { const size_t off = (size_t)(rloc + ai * HALF + m * 16) * ldc + col0;
#pragma unroll
                for (int bj = 0; bj < 2; ++bj)
#pragma unroll
                    for (int n = 0; n < 2; ++n) { const u32x2 b = *(const u32x2*)(bt + off + bj * HALF + n * 16);
                        const f32x4 bs = {__uint_as_float(b.x << 16), __uint_as_float(b.x & 0xffff0000u), __uint_as_float(b.y << 16), __uint_as_float(b.y & 0xffff0000u)};
                        *(f32x4*)(ot + off + bj * HALF + n * 16) = bs + g[bj][n] * acc[ai][bj][m][n]; }
                if (m & 1) asm volatile("" ::: "memory"); }
    }
};

struct EpiNull {
    static constexpr bool PERM = true, AFTER_DRAIN = false;
    __device__ __forceinline__ void operator()(const f32x4 (&acc)[2][2][4][2], const Unit& u, int wr, int wc, int fr, int fq) const {
#pragma unroll
        for (int ai = 0; ai < 2; ++ai)
#pragma unroll
            for (int bj = 0; bj < 2; ++bj)
#pragma unroll
                for (int m = 0; m < 4; ++m)
#pragma unroll
                    for (int n = 0; n < 2; ++n) asm volatile("" :: "v"(acc[ai][bj][m][n]));
    }
};

template <class Epi, class Sched, bool ALIGN_EPI = false, bool SP2 = false>
__device__ __forceinline__ void gemm_phase(PG8_LAS unsigned char* lds, const Gemm g, const Sched& S, const Epi& E) {
    int tid_ = threadIdx.x; asm volatile("" : "+v"(tid_));
    const int tid = tid_, wid = __builtin_amdgcn_readfirstlane(tid >> 6), lane = tid & 63, wr = wid >> 2, wc = wid & 3, fr = lane & 15, fq = lane >> 4;
    const int K = g.K, nt = K / BK;
    unsigned voffA[2], voffB[2];
#pragma unroll
    for (int i = 0; i < 2; ++i) { int R, C; stage_rc(tid * 16 + i * 8192, R, C); const int Rb = Epi::PERM ? ((R & ~31) + perm32(R & 31)) : R;
        voffA[i] = g.a_tiled ? (unsigned)(R * BK + C) * 2u : (unsigned)(R * K + C) * 2u; voffB[i] = (unsigned)(Rb * K + C) * 2u; }
    const size_t kstep = (size_t)(BK * 2);
    const size_t hstep = (size_t)HALF * K * 2;
    const size_t tstep = 2 * hstep;
    const size_t kstepA = g.a_tiled ? (size_t)(BM * BK * 2) : kstep, hstepA = g.a_tiled ? (size_t)(HALF * BK * 2) : hstep, tstepA = g.a_tiled ? (size_t)(K / BK) * (BM * BK * 2) : tstep;
    const unsigned ldsw = (unsigned)wid * 1024u;
    const int aoff = lds_byte(wr * 64 + fr, fq * 8), boff = lds_byte(wc * 32 + fr, fq * 8);
#define PG8_SA(b, h) (((b) * 2 + (h)) * HTB)
#define PG8_SB(b, h) ((4 + (b) * 2 + (h)) * HTB)
#define PG8_STAGE(bufoff, gbase, voff) do { _Pragma("unroll") for (int _i = 0; _i < 2; ++_i) \
        __builtin_amdgcn_global_load_lds((const unsigned*)((const char*)(gbase) + (voff)[_i]), (PG8_LAS unsigned*)(lds + (bufoff) + ldsw + _i * 8192), 16, 0, 0); } while (0)
#define PG8_LDA(dst, b, h) do { _Pragma("unroll") for (int m = 0; m < 4; ++m) _Pragma("unroll") for (int k = 0; k < 2; ++k) dst[m][k] = *(const PG8_LAS bf16x8*)(lds + PG8_SA(b, h) + aoff + m * 2048 + k * 1024); } while (0)
#define PG8_LDB(dst, b, h) do { _Pragma("unroll") for (int n = 0; n < 2; ++n) _Pragma("unroll") for (int k = 0; k < 2; ++k) dst[n][k] = *(const PG8_LAS bf16x8*)(lds + PG8_SB(b, h) + boff + n * 2048 + k * 1024); } while (0)
#define PG8_MMA(ai, bj, At, Bt) do { __builtin_amdgcn_s_setprio(1); _Pragma("unroll") for (int m = 0; m < 4; ++m) _Pragma("unroll") for (int n = 0; n < 2; ++n) _Pragma("unroll") for (int k = 0; k < 2; ++k) \
        acc[ai][bj][m][n] = __builtin_amdgcn_mfma_f32_16x16x32_bf16(Bt[n][k], At[m][k], acc[ai][bj][m][n], 0, 0, 0); __builtin_amdgcn_s_setprio(0); } while (0)
#define PG8_WAIT_V(n) asm volatile("s_waitcnt vmcnt(" #n ")" ::: "memory")
#define PG8_WAIT_L(n) asm volatile("s_waitcnt lgkmcnt(" #n ")" ::: "memory")
#define PG8_BAR __builtin_amdgcn_s_barrier()
#define PG8_SCHED __builtin_amdgcn_sched_barrier(0)
    Unit cur, nxt; int ui = 0;
    if (!S.next(0, cur)) return;
    f32x4 acc[2][2][4][2];
#pragma unroll
    for (int a = 0; a < 2; ++a)
#pragma unroll
        for (int b = 0; b < 2; ++b)
#pragma unroll
            for (int m = 0; m < 4; ++m)
#pragma unroll
                for (int n = 0; n < 2; ++n) acc[a][b][m][n] = (f32x4){0.f, 0.f, 0.f, 0.f};
    bf16x8 At[4][2], B0[2][2], B1[2][2];
    const char* cA = (const char*)g.A + (size_t)cur.pm * tstepA; const char* cB = (const char*)g.Bt + (size_t)cur.pn * tstep;
    S.a_ready(cur);
    if constexpr (SP2) {
        PG8_STAGE(PG8_SB(0, 0), cB, voffB); PG8_STAGE(PG8_SB(0, 1), cB + hstep, voffB); PG8_STAGE(PG8_SA(0, 0), cA, voffA); PG8_STAGE(PG8_SA(0, 1), cA + hstepA, voffA);
        if (wr == 1) PG8_BAR;
        PG8_WAIT_V(2); PG8_BAR;
        PG8_STAGE(PG8_SB(1, 0), cB + kstep, voffB); PG8_STAGE(PG8_SA(1, 0), cA + kstepA, voffA); PG8_STAGE(PG8_SB(1, 1), cB + hstep + kstep, voffB);
        PG8_WAIT_V(6); PG8_BAR;
    } else {
        PG8_STAGE(PG8_SB(0, 0), cB, voffB); PG8_STAGE(PG8_SA(0, 0), cA, voffA); PG8_STAGE(PG8_SB(0, 1), cB + hstep, voffB); PG8_STAGE(PG8_SA(0, 1), cA + hstepA, voffA);
        if (wr == 1) PG8_BAR;
        PG8_WAIT_V(4); PG8_BAR;
        PG8_STAGE(PG8_SB(1, 0), cB + kstep, voffB); PG8_STAGE(PG8_SA(1, 0), cA + kstepA, voffA); PG8_STAGE(PG8_SB(1, 1), cB + hstep + kstep, voffB);
        PG8_WAIT_V(6); PG8_BAR;
    }
    for (;;) {
        const bool has_next = S.next(ui + 1, nxt);
        const char* nA = has_next ? (const char*)g.A + (size_t)nxt.pm * tstepA : cA; const char* nB = has_next ? (const char*)g.Bt + (size_t)nxt.pn * tstep : cB;
        for (int t = 0; t < nt; t += 2) {
            const bool last = (t == nt - 2);
            const char* a1 = cA + (size_t)(t + 1) * kstepA;
            const char* a2 = last ? nA : cA + (size_t)(t + 2) * kstepA; const char* b2 = last ? nB : cB + (size_t)(t + 2) * kstep;
            const char* a3 = a2 + kstepA; const char* b3 = b2 + kstep;
            if (last && has_next) S.a_ready(nxt);
            if constexpr (SP2) {
            PG8_LDB(B0, 0, 0); PG8_LDB(B1, 0, 1); PG8_SCHED; PG8_LDA(At, 0, 0); PG8_STAGE(PG8_SA(1, 1), a1 + hstepA, voffA);
            PG8_WAIT_V(8); PG8_WAIT_L(0); PG8_BAR; PG8_MMA(0, 0, At, B0); PG8_MMA(0, 1, At, B1); PG8_BAR; PG8_SCHED;
            PG8_LDA(At, 0, 1); PG8_STAGE(PG8_SB(0, 0), b2, voffB); PG8_STAGE(PG8_SB(0, 1), b2 + hstep, voffB); PG8_STAGE(PG8_SA(0, 0), a2, voffA);
            PG8_WAIT_V(8); PG8_WAIT_L(0); PG8_BAR; PG8_MMA(1, 0, At, B0); PG8_MMA(1, 1, At, B1); PG8_BAR; PG8_SCHED;
            PG8_LDB(B0, 1, 0); PG8_LDB(B1, 1, 1); PG8_SCHED; PG8_LDA(At, 1, 0); PG8_STAGE(PG8_SA(0, 1), a2 + hstepA, voffA);
            PG8_WAIT_V(8); PG8_WAIT_L(0); PG8_BAR; PG8_MMA(0, 0, At, B0); PG8_MMA(0, 1, At, B1); PG8_BAR; PG8_SCHED;
            PG8_LDA(At, 1, 1); PG8_STAGE(PG8_SB(1, 0), b3, voffB); PG8_STAGE(PG8_SB(1, 1), b3 + hstep, voffB); PG8_STAGE(PG8_SA(1, 0), a3, voffA);
            PG8_WAIT_V(8); PG8_WAIT_L(0); PG8_BAR; PG8_MMA(1, 0, At, B0); PG8_MMA(1, 1, At, B1); PG8_BAR; PG8_SCHED;
            } else {
            PG8_LDB(B0, 0, 0); PG8_SCHED; PG8_LDA(At, 0, 0); PG8_STAGE(PG8_SA(1, 1), a1 + hstepA, voffA);
            PG8_WAIT_L(8); PG8_BAR; PG8_WAIT_L(0); PG8_MMA(0, 0, At, B0); PG8_BAR; PG8_SCHED;
            PG8_LDB(B1, 0, 1); PG8_STAGE(PG8_SB(0, 0), b2, voffB);
            PG8_BAR; PG8_WAIT_L(0); PG8_MMA(0, 1, At, B1); PG8_BAR;
            PG8_LDA(At, 0, 1); PG8_STAGE(PG8_SA(0, 0), a2, voffA);
            PG8_BAR; PG8_WAIT_L(0); PG8_MMA(1, 0, At, B0); PG8_BAR; PG8_SCHED;
            PG8_STAGE(PG8_SB(0, 1), b2 + hstep, voffB);
            PG8_WAIT_V(6); PG8_BAR; PG8_MMA(1, 1, At, B1); PG8_BAR;
            PG8_LDB(B0, 1, 0); PG8_SCHED; PG8_LDA(At, 1, 0); PG8_STAGE(PG8_SA(0, 1), a2 + hstepA, voffA);
            PG8_WAIT_L(8); PG8_BAR; PG8_WAIT_L(0); PG8_MMA(0, 0, At, B0); PG8_BAR; PG8_SCHED;
            PG8_LDB(B1, 1, 1); PG8_STAGE(PG8_SB(1, 0), b3, voffB);
            PG8_BAR; PG8_WAIT_L(0); PG8_MMA(0, 1, At, B1); PG8_BAR;
            PG8_LDA(At, 1, 1); PG8_STAGE(PG8_SA(1, 0), a3, voffA);
            PG8_BAR; PG8_WAIT_L(0); PG8_MMA(1, 0, At, B0); PG8_BAR; PG8_SCHED;
            PG8_STAGE(PG8_SB(1, 1), b3 + hstep, voffB);
            PG8_WAIT_V(6); PG8_BAR; PG8_MMA(1, 1, At, B1); PG8_BAR;
            }
        }
        if constexpr (ALIGN_EPI) { if (wr == 0) PG8_BAR; }
        if constexpr (!Epi::AFTER_DRAIN) { E(acc, cur, wr, wc, fr, fq); S.done(cur); }
        if (!has_next) break;
#pragma unroll
        for (int a = 0; a < 2; ++a)
#pragma unroll
            for (int b = 0; b < 2; ++b)
#pragma unroll
                for (int m = 0; m < 4; ++m)
#pragma unroll
                    for (int n = 0; n < 2; ++n) acc[a][b][m][n] = (f32x4){0.f, 0.f, 0.f, 0.f};
        cur = nxt; cA = nA; cB = nB; ++ui;
        if constexpr (ALIGN_EPI) { if (wr == 1) PG8_BAR; }
    }
    PG8_WAIT_V(0);
    if constexpr (!ALIGN_EPI) { if (wr == 0) PG8_BAR; }
    PG8_BAR;
    if constexpr (Epi::AFTER_DRAIN) { E.fused(acc, cur, wr, wc, fr, fq, lds, wid, lane); S.done(cur); }
#undef PG8_SA
#undef PG8_SB
#undef PG8_STAGE
#undef PG8_LDA
#undef PG8_LDB
#undef PG8_MMA
#undef PG8_WAIT_V
#undef PG8_WAIT_L
#undef PG8_BAR
#undef PG8_SCHED
}
}
namespace att {
#ifdef ATT_NOMASK
constexpr bool defined_NOMASK = true;
#else
constexpr bool defined_NOMASK = false;
#endif
typedef unsigned short bf16_t;
using bf16x8 = __attribute__((ext_vector_type(8))) short;
using s16x4  = __attribute__((ext_vector_type(4))) short;
using f32x16 = __attribute__((ext_vector_type(16))) float;
using u32x4  = __attribute__((ext_vector_type(4))) unsigned;
constexpr int KVBLK = 64;
constexpr int SHM_V = 16384, SHM_K = 16384;
constexpr int LDS_WS = 2 * SHM_V + 2 * SHM_K;
constexpr int LDS_X = LDS_WS + 8 * 64 * 4;
constexpr int LDS_MISC = LDS_X + 4 * 32 * 128 * 4;
constexpr int LDS_BYTES = LDS_MISC + 64;
constexpr float LOG2E = 1.4426950408889634f;
#define GASQ __attribute__((address_space(1)))
#define KSWZ(row, colB) ((row) * 256 + ((colB) ^ (((row) & 7) << 4)))
#define SBAR() __builtin_amdgcn_sched_barrier(0)
__device__ __forceinline__ int crow(int r, int hi) { return (r & 3) + 8 * (r >> 2) + 4 * hi; }
__device__ __forceinline__ unsigned cvtpk(float lo, float hi) { unsigned r; asm volatile("v_cvt_pk_bf16_f32 %0, %1, %2" : "=v"(r) : "v"(lo), "v"(hi)); return r; }

#ifndef ATT_SDEPTH0
#define ATT_SDEPTH0 2
#endif
#ifndef ATT_QLDS0
#define ATT_QLDS0 1
#endif
template <int MODE> struct Cfg {
    static constexpr float SCALE = (MODE == 0) ? 0.088388347648318440f : 0.125f;
    static constexpr float C = SCALE * LOG2E;
    static constexpr float THRS = 8.f / SCALE;
    static constexpr int ND0 = (MODE == 0) ? 8 : 4;
    static constexpr int SDEPTH = (MODE == 0) ? ATT_SDEPTH0 : 2;
    static constexpr bool QLDS = (MODE == 0) && (ATT_QLDS0 != 0);
};

template <int MODE>
__device__ __forceinline__ void partialSM(f32x16& p0, f32x16& p1, float& m_reg, float& mn, float& alpha) {
  constexpr float C = Cfg<MODE>::C;
  float pmax = p0[0];
#pragma unroll
  for (int r = 1; r < 16; ++r) pmax = fmaxf(pmax, p0[r]);
#pragma unroll
  for (int r = 0; r < 16; ++r) pmax = fmaxf(pmax, p1[r]);
  { auto rr = __builtin_amdgcn_permlane32_swap(__float_as_uint(pmax), __float_as_uint(pmax), false, false);
    pmax = fmaxf(__uint_as_float(rr[0]), __uint_as_float(rr[1])); }
  if (__builtin_expect(__all(pmax - m_reg <= Cfg<MODE>::THRS), 1)) { mn = m_reg; alpha = 1.f; }
  else { mn = fmaxf(m_reg, pmax); alpha = __builtin_amdgcn_exp2f((m_reg - mn) * C); m_reg = mn; }
  const float mnC = -mn * C;
#pragma unroll
  for (int r = 0; r < 16; ++r) p0[r] = fmaf(p0[r], C, mnC);
#pragma unroll
  for (int r = 0; r < 16; ++r) p1[r] = fmaf(p1[r], C, mnC);
#pragma unroll
  for (int r = 0; r < 16; ++r) p0[r] = __builtin_amdgcn_exp2f(p0[r]);
}
__device__ __forceinline__ void finishSM(f32x16& p0, f32x16& p1, float alpha, float& l_reg, bf16x8& pa0, bf16x8& pa1, bf16x8& pa2, bf16x8& pa3) {
#pragma unroll
  for (int r = 0; r < 16; ++r) p1[r] = __builtin_amdgcn_exp2f(p1[r]);
  float ps = 0;
#pragma unroll
  for (int r = 0; r < 16; ++r) ps += p0[r];
#pragma unroll
  for (int r = 0; r < 16; ++r) ps += p1[r];
  { auto rr = __builtin_amdgcn_permlane32_swap(__float_as_uint(ps), __float_as_uint(ps), false, false);
    ps = __uint_as_float(rr[0]) + __uint_as_float(rr[1]); }
  l_reg = l_reg * alpha + ps;
#define PK4(P, BASE, OUT) do { unsigned a0 = cvtpk(P[BASE + 0], P[BASE + 1]), a1 = cvtpk(P[BASE + 2], P[BASE + 3]);   \
    unsigned b0 = cvtpk(P[BASE + 4], P[BASE + 5]), b1 = cvtpk(P[BASE + 6], P[BASE + 7]);                              \
    auto r0 = __builtin_amdgcn_permlane32_swap(a0, b0, false, false); auto r1 = __builtin_amdgcn_permlane32_swap(a1, b1, false, false); \
    u32x4 w = {r0[0], r1[0], r0[1], r1[1]}; OUT = *reinterpret_cast<bf16x8*>(&w); } while (0)
  PK4(p0, 0, pa0); PK4(p0, 8, pa1); PK4(p1, 0, pa2); PK4(p1, 8, pa3);
#undef PK4
}
template <int MODE, bool QLDS>
__device__ __forceinline__ void qkt(f32x16& p0, f32x16& p1, const char* Ks, const bf16x8* qr, const char* qs, int r32, int hi, int comp) {
  p0 = f32x16{}; p1 = f32x16{};
  int rb = r32; asm volatile("" : "+v"(rb));
  const int swz = (rb & 7) << 4, rowb = rb * 256 + comp * 128;
  const char* a0 = Ks + rowb + ((0 * 32 + hi * 16) ^ swz); const char* a1 = Ks + rowb + ((1 * 32 + hi * 16) ^ swz);
  const char* a2 = Ks + rowb + ((2 * 32 + hi * 16) ^ swz); const char* a3 = Ks + rowb + ((3 * 32 + hi * 16) ^ swz);
#pragma unroll
  for (int d0 = 0; d0 < Cfg<MODE>::ND0; ++d0) { const int dl = d0 & 3, dh = d0 >> 2; const char* ap = (dl == 0 ? a0 : dl == 1 ? a1 : dl == 2 ? a2 : a3) + dh * 128;
    bf16x8 b0 = *reinterpret_cast<const bf16x8*>(ap);
    bf16x8 b1 = *reinterpret_cast<const bf16x8*>(ap + 8192);
    bf16x8 q; if constexpr (QLDS) q = *reinterpret_cast<const bf16x8*>(qs + d0 * 1024); else q = qr[d0];
    p0 = __builtin_amdgcn_mfma_f32_32x32x16_bf16(b0, q, p0, 0, 0, 0);
    p1 = __builtin_amdgcn_mfma_f32_32x32x16_bf16(b1, q, p1, 0, 0, 0); }
}
__device__ __forceinline__ int v_st(int k, int c) { const int kk = (k & ~0xC) | ((k & 4) << 1) | ((k & 8) >> 1); return ((kk >> 3) * 4 + (c >> 5)) * 512 + ((kk & 7) * 32 + (c & 31)) * 2; }
__device__ __forceinline__ int v_rd_base(int lane) { return ((lane & 3) << 3) | (((lane >> 2) & 3) << 6) | (((lane >> 4) & 1) << 5) | (((lane >> 5) & 1) << 8); }
constexpr int v_rd_off(int d0, int ks, int half) { return d0 * 512 + ks * 4096 + half * 2048; }
template <int OFF> __device__ __forceinline__ s16x4 tr_read(int vb) {
  s16x4 r; asm volatile("ds_read_b64_tr_b16 %0, %1 offset:%2" : "=&v"(r) : "v"(vb), "i"(OFF) : "memory"); return r;
}
template <int D0> __device__ __forceinline__ void pv_one(f32x16& od, int vb, bf16x8 pa0, bf16x8 pa1, bf16x8 pa2, bf16x8 pa3) {
  const s16x4 l0 = tr_read<v_rd_off(D0, 0, 0)>(vb), h0 = tr_read<v_rd_off(D0, 0, 1)>(vb), l1 = tr_read<v_rd_off(D0, 1, 0)>(vb), h1 = tr_read<v_rd_off(D0, 1, 1)>(vb);
  const s16x4 l2 = tr_read<v_rd_off(D0, 2, 0)>(vb), h2 = tr_read<v_rd_off(D0, 2, 1)>(vb), l3 = tr_read<v_rd_off(D0, 3, 0)>(vb), h3 = tr_read<v_rd_off(D0, 3, 1)>(vb);
  asm volatile("s_waitcnt lgkmcnt(0)" ::: "memory"); SBAR();
#define PK(L, H) (bf16x8){L[0], L[1], L[2], L[3], H[0], H[1], H[2], H[3]}
  od = __builtin_amdgcn_mfma_f32_32x32x16_bf16(pa0, PK(l0, h0), od, 0, 0, 0);
  od = __builtin_amdgcn_mfma_f32_32x32x16_bf16(pa1, PK(l1, h1), od, 0, 0, 0);
  od = __builtin_amdgcn_mfma_f32_32x32x16_bf16(pa2, PK(l2, h2), od, 0, 0, 0);
  od = __builtin_amdgcn_mfma_f32_32x32x16_bf16(pa3, PK(l3, h3), od, 0, 0, 0);
#undef PK
}
__device__ __forceinline__ void pv_d0(f32x16* o, int vb, bf16x8 pa0, bf16x8 pa1, bf16x8 pa2, bf16x8 pa3) {
  pv_one<0>(o[0], vb, pa0, pa1, pa2, pa3); pv_one<1>(o[1], vb, pa0, pa1, pa2, pa3); pv_one<2>(o[2], vb, pa0, pa1, pa2, pa3); pv_one<3>(o[3], vb, pa0, pa1, pa2, pa3);
}

struct UnitArgs {
    const bf16_t* Qb; int ldq;
    const bf16_t* Kh; const bf16_t* Vh;
    bf16_t* Ob; int ldo;
    int NT;
    int jwin, wadd;
    int masked, t0;
    float sinkl2;
    float lam;
    const float* subg;
    const float* qg;
    const float* ropeT;
    int rope;
};

template <int MODE>
__device__ __forceinline__ void attn_unit(const UnitArgs& A, char* lds) {
  constexpr float C = Cfg<MODE>::C; constexpr int ND0 = Cfg<MODE>::ND0;
  int tid_ = threadIdx.x; asm volatile("" : "+v"(tid_));
  const int tid = tid_, wid = tid >> 6, lane = tid & 63, r32 = lane & 31, hi = lane >> 5;
  const int wq = (MODE == 0) ? wid : (wid & 3), comp = (MODE == 0) ? 0 : (wid >> 2);
  char* V_lds = lds; char* K_lds = lds + 2 * SHM_V;
  float* ws = (float*)(lds + LDS_WS) + wid * 64; float* li_l = ws; float* al_l = ws + 32;
  constexpr bool QLDS = Cfg<MODE>::QLDS;
  __syncthreads();
  float m_reg = -1e30f, l_reg = 0; f32x16 o[4] = {}; bf16x8 qr[QLDS ? 1 : ND0];
  char* qs = lds + LDS_X + wid * 8192 + lane * 16;
  const bf16_t* Qw = A.Qb + (long)(wq * 32 + r32) * A.ldq + comp * 64 + hi * 8;
  const int sr = tid >> 4, sc = (tid & 15) * 8, vst0 = v_st(sr, sc), vst1 = v_st(32 + sr, sc);
  const int vb0 = (int)(uintptr_t)V_lds + v_rd_base(lane);
  const unsigned loff0 = (unsigned)(sr * 128 + sc) * 2u, loff1 = loff0 + 32u * 256u;
  const bf16_t* Kh = A.Kh; const bf16_t* Vh = A.Vh; const int NT = A.NT, jwin = A.jwin, wadd = A.wadd;
  constexpr int SDEPTH = Cfg<MODE>::SDEPTH;
  struct { bf16x8 vs0, vs1, ks0, ks1; } sr_[SDEPTH];
#define KOFF(j) (64 * (j) + (((j) >= jwin) ? wadd : 0))
#define SLOAD(i, k0) do { const size_t _kb = (size_t)(k0) * 256; const char* _vp = (const char*)Vh + _kb; const char* _kp = (const char*)Kh + _kb; \
    sr_[i].vs0 = *(const GASQ bf16x8*)(_vp + loff0); sr_[i].vs1 = *(const GASQ bf16x8*)(_vp + loff1); \
    sr_[i].ks0 = *(const GASQ bf16x8*)(_kp + loff0); sr_[i].ks1 = *(const GASQ bf16x8*)(_kp + loff1); } while (0)
#define SWRITE(b, i) do { *(bf16x8*)(V_lds + (b) * SHM_V + vst0) = sr_[i].vs0;          \
    *(bf16x8*)(V_lds + (b) * SHM_V + vst1) = sr_[i].vs1; const int kc = sc * 2;               \
    *(bf16x8*)(K_lds + (b) * SHM_K + KSWZ(sr, kc)) = sr_[i].ks0;                       \
    *(bf16x8*)(K_lds + (b) * SHM_K + KSWZ(32 + sr, kc)) = sr_[i].ks1; } while (0)
#define SWAIT() do { if constexpr (SDEPTH == 2) asm volatile("s_waitcnt vmcnt(4)" ::: "memory"); else asm volatile("s_waitcnt vmcnt(0)" ::: "memory"); } while (0)
#define RESC(a) do { if (__any((a) < 1.f)) { if (hi == 0) al_l[r32] = (a); asm volatile("s_waitcnt lgkmcnt(0)" ::: "memory"); \
    _Pragma("unroll") for (int d = 0; d < 4; ++d) _Pragma("unroll") for (int r = 0; r < 16; ++r) o[d][r] *= al_l[crow(r, hi)]; } } while (0)
#define MASKT(P0, P1, j) do { if (MODE == 0 && !defined_NOMASK && A.masked && (j) >= jwin) { const int kp0 = KOFF(j) - 512, qw0 = A.t0 + wq * 32; \
    if (kp0 < qw0 + 31 - 128 || kp0 + 63 > qw0 + 128) { const int dkb = kp0 - qw0 - r32 + 4 * hi + 128; \
      _Pragma("unroll") for (int r = 0; r < 16; ++r) { const int cr = (r & 3) + 8 * (r >> 2); if ((unsigned)(dkb + cr) > 256u) P0[r] = -1e30f; if ((unsigned)(dkb + cr + 32) > 256u) P1[r] = -1e30f; } } } } while (0)
  constexpr int SE = 0, SO = SDEPTH - 1;
  {
    typedef float f32x4q __attribute__((ext_vector_type(4)));
    float x[ND0][8]; float ss = 0.f;
#pragma unroll
    for (int d0 = 0; d0 < ND0; ++d0) { const u32x4 raw = *reinterpret_cast<const u32x4*>(Qw + d0 * 16);
#pragma unroll
      for (int e = 0; e < 4; ++e) { x[d0][2 * e] = __uint_as_float(raw[e] << 16); x[d0][2 * e + 1] = __uint_as_float(raw[e] & 0xffff0000u); }
#pragma unroll
      for (int j = 0; j < 8; ++j) ss += x[d0][j] * x[d0][j]; }
    ss += __shfl_xor(ss, 32);
    const float rstd = __builtin_amdgcn_rsqf(ss * (1.f / (16.f * ND0)) + 1e-6f);
#pragma unroll
    for (int d0 = 0; d0 < ND0; ++d0) { const f32x4q g0 = *(const GASQ f32x4q*)(A.qg + d0 * 16 + hi * 8), g1 = *(const GASQ f32x4q*)(A.qg + d0 * 16 + hi * 8 + 4);
      x[d0][0] *= rstd * g0.x; x[d0][1] *= rstd * g0.y; x[d0][2] *= rstd * g0.z; x[d0][3] *= rstd * g0.w; x[d0][4] *= rstd * g1.x; x[d0][5] *= rstd * g1.y; x[d0][6] *= rstd * g1.z; x[d0][7] *= rstd * g1.w; }
    if (A.rope) {
      const int t = A.t0 + wq * 32 + r32;
      if (MODE == 0) {
#pragma unroll
        for (int ax = 0; ax < 2; ++ax) { const int pos = ax ? (t & 63) : (t >> 6);
#pragma unroll
          for (int e = 0; e < 2; ++e) { const float* cp = A.ropeT + pos * 32 + 16 * e + 8 * hi;
            const f32x4q c0 = *(const GASQ f32x4q*)(cp), c1 = *(const GASQ f32x4q*)(cp + 4), s0 = *(const GASQ f32x4q*)(cp + 2048), s1 = *(const GASQ f32x4q*)(cp + 2048 + 4);
            const float cs[8] = {c0.x, c0.y, c0.z, c0.w, c1.x, c1.y, c1.z, c1.w}, sn[8] = {s0.x, s0.y, s0.z, s0.w, s1.x, s1.y, s1.z, s1.w};
            const int d1 = 4 * ax + e, d2 = d1 + 2;
#pragma unroll
            for (int j = 0; j < 8; ++j) { const float x1 = x[d1 % ND0][j], x2 = x[d2 % ND0][j]; x[d1 % ND0][j] = x1 * cs[j] - x2 * sn[j]; x[d2 % ND0][j] = x2 * cs[j] + x1 * sn[j]; } } }
      } else {
#pragma unroll
        for (int ax = 0; ax < 2; ++ax) { const int pos = ax ? (t & 63) : (t >> 6); const float* cp = A.ropeT + 4096 + pos * 16 + 8 * hi;
          const f32x4q c0 = *(const GASQ f32x4q*)(cp), c1 = *(const GASQ f32x4q*)(cp + 4), s0 = *(const GASQ f32x4q*)(cp + 1024), s1 = *(const GASQ f32x4q*)(cp + 1024 + 4);
          const float cs[8] = {c0.x, c0.y, c0.z, c0.w, c1.x, c1.y, c1.z, c1.w}, sn[8] = {s0.x, s0.y, s0.z, s0.w, s1.x, s1.y, s1.z, s1.w};
          const int d1 = (2 * ax) % ND0, d2 = (2 * ax + 1) % ND0;
#pragma unroll
          for (int j = 0; j < 8; ++j) { const float x1 = x[d1][j], x2 = x[d2][j]; x[d1][j] = x1 * cs[j] - x2 * sn[j]; x[d2][j] = x2 * cs[j] + x1 * sn[j]; } }
      }
    }
#pragma unroll
    for (int d0 = 0; d0 < ND0; ++d0) { u32x4 w = {cvtpk(x[d0][0], x[d0][1]), cvtpk(x[d0][2], x[d0][3]), cvtpk(x[d0][4], x[d0][5]), cvtpk(x[d0][6], x[d0][7])};
      if constexpr (QLDS) *reinterpret_cast<u32x4*>(qs + d0 * 1024) = w; else qr[d0] = *reinterpret_cast<bf16x8*>(&w); }
  }
  f32x16 pA0, pA1, pB0, pB1; float mnA, mnB, alA, alB; bf16x8 pa0, pa1, pa2, pa3;
  SLOAD(SE, KOFF(0)); asm volatile("s_waitcnt vmcnt(0)" ::: "memory"); SWRITE(0, SE); __syncthreads();
  qkt<MODE, QLDS>(pA0, pA1, K_lds, qr, qs, r32, hi, comp); MASKT(pA0, pA1, 0); partialSM<MODE>(pA0, pA1, m_reg, mnA, alA);
  SLOAD(SO, KOFF(1)); if constexpr (SDEPTH == 2) { if (2 < NT) SLOAD(SE, KOFF(2)); }
  SWAIT(); SWRITE(1, SO); __syncthreads();
  for (int j = 1; j + 1 < NT; j += 2) {
    SBAR(); qkt<MODE, QLDS>(pB0, pB1, K_lds + SHM_K, qr, qs, r32, hi, comp);
    finishSM(pA0, pA1, alA, l_reg, pa0, pa1, pa2, pa3); SBAR();
    SLOAD(SO, KOFF(j + SDEPTH)); SBAR();
    pv_d0(o, vb0, pa0, pa1, pa2, pa3); MASKT(pB0, pB1, j); partialSM<MODE>(pB0, pB1, m_reg, mnB, alB);
    __syncthreads(); SWAIT(); SWRITE(0, SE);
    RESC(alB); __syncthreads();
    SBAR(); qkt<MODE, QLDS>(pA0, pA1, K_lds, qr, qs, r32, hi, comp);
    finishSM(pB0, pB1, alB, l_reg, pa0, pa1, pa2, pa3); SBAR();
    if (SDEPTH == 1 || j + 3 < NT) SLOAD(SE, KOFF(j + 1 + SDEPTH)); SBAR();
    pv_d0(o, vb0 + SHM_V, pa0, pa1, pa2, pa3); MASKT(pA0, pA1, j + 1); partialSM<MODE>(pA0, pA1, m_reg, mnA, alA);
    __syncthreads(); SWAIT(); SWRITE(1, SO);
    RESC(alA); __syncthreads();
  }
  SBAR(); qkt<MODE, QLDS>(pB0, pB1, K_lds + SHM_K, qr, qs, r32, hi, comp);
  finishSM(pA0, pA1, alA, l_reg, pa0, pa1, pa2, pa3); SBAR();
  pv_d0(o, vb0, pa0, pa1, pa2, pa3); MASKT(pB0, pB1, NT - 1); partialSM<MODE>(pB0, pB1, m_reg, mnB, alB);
  __syncthreads(); RESC(alB);
  finishSM(pB0, pB1, alB, l_reg, pa0, pa1, pa2, pa3); SBAR();
  pv_d0(o, vb0 + SHM_V, pa0, pa1, pa2, pa3);
  if (MODE == 0) l_reg += __builtin_amdgcn_exp2f(A.sinkl2 - m_reg * C);
  if (hi == 0) li_l[r32] = l_reg;
  asm volatile("s_waitcnt lgkmcnt(0)" ::: "memory");
  float rli[16];
#pragma unroll
  for (int r = 0; r < 16; ++r) rli[r] = __builtin_amdgcn_rcpf(li_l[crow(r, hi)]);
  bf16_t* Ow = A.Ob + (long)(wq * 32) * A.ldo;
  const int odd = lane & 1;
  int t2_ = threadIdx.x; asm volatile("" : "+v"(t2_));
  const int lane2 = t2_ & 63, r32b = lane2 & 31, hib = lane2 >> 5;
  char* stg = lds + LDS_X + ((MODE == 0) ? (t2_ >> 6) * 8192 : ((t2_ >> 6) & 3) * 16384);
  if (MODE == 0) {
#pragma unroll
    for (int d0 = 0; d0 < 4; ++d0)
#pragma unroll
      for (int rp = 0; rp < 8; ++rp) {
        const float a = o[d0][2 * rp] * rli[2 * rp], b = o[d0][2 * rp + 1] * rli[2 * rp + 1];
        const float send = odd ? a : b; const float recv = __shfl_xor(send, 1);
        const float lo = odd ? recv : a, hh = odd ? b : recv;
        const int row = crow(2 * rp + odd, hib);
        *(unsigned*)(stg + row * 256 + (d0 * 32 + (r32b & ~1)) * 2) = cvtpk(lo, hh);
      }
  } else {
    float* X = (float*)(lds + LDS_X) + wq * (32 * 128);
    if (comp == 1) {
      const float lam = A.lam;
#pragma unroll
      for (int d0 = 0; d0 < 4; ++d0)
#pragma unroll
        for (int r = 0; r < 16; ++r) X[crow(r, hi) * 128 + d0 * 32 + r32] = o[d0][r] * rli[r] * lam;
    }
    __syncthreads();
    if (comp == 0) {
      float rs[16];
#pragma unroll
      for (int r = 0; r < 16; ++r) { float ss = 0.f;
#pragma unroll
        for (int d0 = 0; d0 < 4; ++d0) { const float v = o[d0][r] * rli[r] - X[crow(r, hi) * 128 + d0 * 32 + r32]; o[d0][r] = v; ss += v * v; }
        ss += __shfl_xor(ss, 1); ss += __shfl_xor(ss, 2); ss += __shfl_xor(ss, 4); ss += __shfl_xor(ss, 8); ss += __shfl_xor(ss, 16);
        rs[r] = __builtin_amdgcn_rsqf(ss * (1.f / 128.f) + 1e-6f) * 0.8f; }
      asm volatile("s_waitcnt lgkmcnt(0)" ::: "memory");
#pragma unroll
      for (int d0 = 0; d0 < 4; ++d0) { const float g = A.subg[d0 * 32 + r32];
#pragma unroll
        for (int rp = 0; rp < 8; ++rp) {
          const float a = o[d0][2 * rp] * rs[2 * rp] * g, b = o[d0][2 * rp + 1] * rs[2 * rp + 1] * g;
          const float send = odd ? a : b; const float recv = __shfl_xor(send, 1);
          const float lo = odd ? recv : a, hh = odd ? b : recv;
          const int row = crow(2 * rp + odd, hib);
          *(unsigned*)(stg + row * 256 + (d0 * 32 + (r32b & ~1)) * 2) = cvtpk(lo, hh);
        } }
    }
  }
  if (MODE == 0 || comp == 0) {
    asm volatile("s_waitcnt lgkmcnt(0)" ::: "memory");
    const int srow = lane2 >> 4, sch = lane2 & 15;
#pragma unroll
    for (int i = 0; i < 8; ++i) { const int row = srow + 4 * i; const u32x4 v = *(const u32x4*)(stg + row * 256 + sch * 16);
      *(u32x4*)(Ow + (long)row * A.ldo + sch * 8) = v; }
  }
#undef KOFF
#undef SLOAD
#undef SWRITE
#undef SWAIT
#undef RESC
#undef MASKT
}
#undef KSWZ
#undef GASQ
#undef SBAR
}

#define GAS __attribute__((address_space(1)))
#define LAS __attribute__((address_space(3)))
typedef unsigned short bf16;
typedef unsigned v4u __attribute__((ext_vector_type(4)));
typedef float f32x4 __attribute__((ext_vector_type(4)));
typedef short bf16x8 __attribute__((ext_vector_type(8)));
typedef GAS unsigned gu32;
typedef GAS unsigned long long gu64;
#define RLX_AGENT __ATOMIC_RELAXED, __HIP_MEMORY_SCOPE_AGENT
#define LDS_WAIT() asm volatile("s_waitcnt lgkmcnt(0)" ::: "memory")
#define VM_WAIT() asm volatile("s_waitcnt vmcnt(0)" ::: "memory")
__device__ __forceinline__ unsigned long long rt() { return __builtin_amdgcn_s_memrealtime(); }
__device__ __forceinline__ unsigned f2bf(float f) { unsigned u = __builtin_bit_cast(unsigned, f); return (u + 0x7fffu + ((u >> 16) & 1u)) >> 16; }
__device__ __forceinline__ unsigned pk2(float lo, float hi) { return f2bf(lo) | (f2bf(hi) << 16); }

#define XB_TMO      128
#define XB_XCNT(j)  (256  + 64 * (j))
#define XB_XSUB(j)  (1280 + 64 * (j))
#define XB_XGEN(j)  (2304 + 64 * (j))
#define XB_TOP      3328
#define XB_TOPGEN   3392
#define XCD_BAR_WORDS 3456
#define XB_SPIN_CAP (1u << 18)

__device__ __forceinline__ unsigned xb_ld(unsigned* p)              { return __hip_atomic_load(p, __ATOMIC_RELAXED, __HIP_MEMORY_SCOPE_AGENT); }
__device__ __forceinline__ unsigned xb_add(unsigned* p, unsigned v) { return __hip_atomic_fetch_add(p, v, __ATOMIC_RELAXED, __HIP_MEMORY_SCOPE_AGENT); }
__device__ __forceinline__ unsigned xb_xcc_id() { return (unsigned)__builtin_amdgcn_s_getreg((3 << 11) | 20) & 0xFu; }
#define XB_SPIN(cond, bar) do { unsigned _sp = 0; while (cond) { __builtin_amdgcn_s_sleep(1); \
    if ((++_sp & 255u) == 0u) { if (xb_ld(&(bar)[XB_TMO])) break; if (_sp > XB_SPIN_CAP) { atomicAdd(&(bar)[XB_TMO], 1u); break; } } } } while (0)

struct XcdBarrier {
    unsigned* bar; unsigned x;
    volatile LAS unsigned* st;
};

__device__ __forceinline__ XcdBarrier xcd_barrier_post(unsigned* bar, volatile LAS unsigned* st) {
    XcdBarrier b; b.bar = bar; b.x = xb_xcc_id(); b.st = st;
    if (threadIdx.x == 0) (void)xb_add(&bar[XB_XCNT(b.x)], 1u);
    return b;
}
__device__ __forceinline__ void xcd_barrier_complete(unsigned* bar, unsigned x, unsigned& nloc, unsigned& nx) {
    const unsigned G = gridDim.x * gridDim.y * gridDim.z;
    unsigned sum, cnt, mine, sp = 0u;
    for (;;) {
        sum = 0u; cnt = 0u; mine = 0u;
#pragma unroll
        for (unsigned j = 0; j < 16; ++j) { const unsigned c = xb_ld(&bar[XB_XCNT(j)]); sum += c; cnt += (c > 0u) ? 1u : 0u; mine = (j == x) ? c : mine; }
        if (sum == G) break;
        __builtin_amdgcn_s_sleep(1);
        if ((++sp & 255u) == 0u) { if (xb_ld(&bar[XB_TMO])) break; if (sp > XB_SPIN_CAP) { atomicAdd(&bar[XB_TMO], 1u); break; } }
    }
    nloc = mine > 0u ? mine : 1u; nx = cnt > 0u ? cnt : 1u;
}

__device__ __forceinline__ void xcd_barrier(const XcdBarrier& b) {
    asm volatile("s_waitcnt vmcnt(0)" ::: "memory");
    __syncthreads();
    if (threadIdx.x == 0) {
        unsigned* bar = b.bar;
        __builtin_amdgcn_s_waitcnt(0);
        unsigned nloc = b.st[0], nx = b.st[1];
        if (nloc == 0u) { xcd_barrier_complete(bar, b.x, nloc, nx); b.st[0] = nloc; b.st[1] = nx; }
        const unsigned old = xb_add(&bar[XB_XSUB(b.x)], 1u);
        const unsigned gen = old / nloc;
        if (old + 1u == (gen + 1u) * nloc) {
            __builtin_amdgcn_fence(__ATOMIC_RELEASE, "agent");
            asm volatile("s_waitcnt vmcnt(0)" ::: "memory");
            const unsigned og = xb_add(&bar[XB_TOP], 1u);
            const unsigned tg = og / nx;
            if (og + 1u == (tg + 1u) * nx) xb_add(&bar[XB_TOPGEN], 1u);
            else XB_SPIN(xb_ld(&bar[XB_TOPGEN]) == tg, bar);
            __builtin_amdgcn_fence(__ATOMIC_ACQUIRE, "agent");
            xb_add(&bar[XB_XGEN(b.x)], 1u);
            asm volatile("s_waitcnt vmcnt(0)" ::: "memory");
        } else {
            XB_SPIN(xb_ld(&bar[XB_XGEN(b.x)]) == gen, bar);
            __builtin_amdgcn_fence(__ATOMIC_ACQUIRE, "agent");
            asm volatile("s_waitcnt vmcnt(0)" ::: "memory");
        }
    }
    __syncthreads();
}
#ifndef MK_N_LAUNCHES
#define MK_N_LAUNCHES 1
#endif
constexpr int NPH = 9;
constexpr int N_LAUNCHES = MK_N_LAUNCHES;
constexpr int NWAVES = 8;

constexpr int DM = 4096, DIN = 6144, DFF = 16384, NMOD = 6 * DM;
constexpr int NB_P = 16, T_P = 256, NB_S = 8, T_S = 1024, LCTX = 512;
constexpr int M_P = NB_P * T_P, M_S = NB_S * T_S, MTOK = M_P + M_S;
constexpr int KSPLIT = 8;
constexpr int KVL = LCTX + T_S;
constexpr float EPS = 1e-6f;

constexpr size_t MiB = 1u << 20;
constexpr size_t WS_CTL = 0, CTL_ZERO_BYTES = 1 * MiB;
constexpr size_t WS_MODP = 1 * MiB;
constexpr size_t WS_MODF = 8 * MiB;
constexpr size_t WS_ROPE = 9 * MiB;
constexpr size_t WS_WIN = 16 * MiB, WS_WOUT = 64 * MiB, WS_WFC1 = 96 * MiB, WS_WFC2 = 224 * MiB;
constexpr size_t WS_H = 352 * MiB;
constexpr size_t WS_P = 448 * MiB;
constexpr size_t WS_O = 592 * MiB;
constexpr size_t WS_KVL = 688 * MiB, KVL_SZ = (size_t)NB_S * 4 * KVL * 128 * 2;
constexpr size_t WS_KVP = 736 * MiB, KVP_SZ = (size_t)NB_P * 4 * T_P * 128 * 2;
constexpr size_t WS_U = 752 * MiB;
constexpr size_t WS_X1B = 1136 * MiB;
constexpr size_t WS_END = 1232 * MiB;
static_assert(WS_MODP + (size_t)KSPLIT * 9 * NMOD * 4 <= WS_MODF && WS_MODF + (size_t)9 * NMOD * 4 <= WS_WIN, "ws map");
static_assert(KVL_SZ == 12 * MiB && KVP_SZ == 4 * MiB && WS_U + (size_t)MTOK * DFF * 2 == WS_X1B && WS_X1B + (size_t)MTOK * DM * 2 == WS_END, "ws map");
constexpr int CW_Q = 64;
constexpr int CW_BAR = 4096;

constexpr int RING_BYTES = 131072;
constexpr int MISC_OFF = 143360;
constexpr int LDS_BYTES = 147456;
static_assert(att::LDS_BYTES <= MISC_OFF && RING_BYTES <= MISC_OFF && MISC_OFF + 128 <= LDS_BYTES && 8 * 64 * 68 * 4 <= MISC_OFF, "LDS map");

__device__ __forceinline__ float wave_sum(float v) {
#pragma unroll
    for (int o = 1; o < 64; o <<= 1) v += __shfl_xor(v, o);
    return v;
}
__device__ __forceinline__ float bf2f(unsigned short b) { return __uint_as_float(((unsigned)b) << 16); }

__device__ __forceinline__ int fresh_tid() { int t = threadIdx.x; asm volatile("" : "+v"(t)); return t; }
struct Args { const float* in[26]; float* out; unsigned char* ws; int ph_lo, ph_hi; };

constexpr int TR_LDS = 64 * 68 * 4;
__device__ __forceinline__ unsigned cvtpk_rne(float lo, float hi) { unsigned r; asm volatile("v_cvt_pk_bf16_f32 %0, %1, %2" : "=v"(r) : "v"(lo), "v"(hi)); return r; }
__device__ __forceinline__ void p0_transpose_item(const float* W, int K, int N, bf16* WT, LAS float* scr, int item, int lane) {
    const int nblk = N / 64, kb = item / nblk, nb = item - kb * nblk, k0 = 64 * kb, n0 = 64 * nb;
    const int lr = lane >> 4, lc = (lane & 15) * 4;
    const GAS f32x4* src = (const GAS f32x4*)(W + (size_t)(k0 + lr) * N + n0 + lc);
    f32x4 v[16];
#pragma unroll
    for (int i = 0; i < 16; ++i) v[i] = src[(size_t)i * N];
#pragma unroll
    for (int i = 0; i < 16; ++i) { const int k = lr + 4 * i; *(LAS f32x4*)(scr + k * 68 + (lc ^ ((k >> 3) << 2))) = v[i]; }
    LDS_WAIT(); asm volatile("" ::: "memory");
    const int kc = lane & 7, nl = lane >> 3;
#pragma unroll
    for (int j = 0; j < 8; ++j) { const int n = nl + 8 * j; const LAS float* s = scr + (8 * kc) * 68 + (n ^ (kc << 2));
        v4u o; o.x = cvtpk_rne(s[0 * 68], s[1 * 68]); o.y = cvtpk_rne(s[2 * 68], s[3 * 68]); o.z = cvtpk_rne(s[4 * 68], s[5 * 68]); o.w = cvtpk_rne(s[6 * 68], s[7 * 68]);
        *(GAS v4u*)(WT + (size_t)(n0 + n) * K + k0 + 8 * kc) = o; }
    LDS_WAIT(); asm volatile("" ::: "memory");
}
__device__ __forceinline__ void mod_block_item(const Args& a, LAS unsigned char* ldsl, int cc, int kq8, int tid, int lane, int wave) {
    const float* cmat = a.in[6]; const float* cctx = a.in[7]; const float* Wm = a.in[8]; float* part = (float*)(a.ws + WS_MODP);
    f32x4 acc[9];
#pragma unroll
    for (int r = 0; r < 9; ++r) acc[r] = (f32x4){0.f, 0.f, 0.f, 0.f};
    const int krow = kq8 * 512 + wave * 64;
    const GAS f32x4* wp = (const GAS f32x4*)(Wm + (size_t)krow * NMOD + cc * 256) + lane;
    float sv[9];
#pragma unroll
    for (int r = 0; r < 9; ++r) { const float cv = (r < 8) ? cmat[r * DM + krow + lane] : cctx[krow + lane]; sv[r] = cv / (1.f + __expf(-cv)); }
    for (int i0 = 0; i0 < 64; i0 += 16) {
        f32x4 w[16];
#pragma unroll
        for (int i = 0; i < 16; ++i) w[i] = wp[(size_t)(i0 + i) * (NMOD / 4)];
#pragma unroll
        for (int i = 0; i < 16; ++i)
#pragma unroll
            for (int r = 0; r < 9; ++r) { const float s = __uint_as_float(__builtin_amdgcn_readlane(__float_as_uint(sv[r]), i0 + i)); acc[r] += w[i] * s; }
    }
    LAS f32x4* red = (LAS f32x4*)ldsl;
    __syncthreads();
#pragma unroll
    for (int r = 0; r < 9; ++r) red[(wave * 9 + r) * 64 + lane] = acc[r];
    __syncthreads();
    for (int o = tid; o < 9 * 64; o += NWAVES * 64) { const int r = o >> 6, l = o & 63; f32x4 s = red[r * 64 + l];
#pragma unroll
        for (int w2 = 1; w2 < NWAVES; ++w2) s += red[(w2 * 9 + r) * 64 + l];
        *((GAS f32x4*)(part + (size_t)(kq8 * 9 + r) * NMOD + cc * 256) + l) = s; }
    __syncthreads();
}
constexpr int BG_MOD = 64 * KSPLIT, BG_TR = ((DM / 64) * (DM / 64) + (DM / 64) * (DFF / 64) + (DFF / 64) * (DM / 64)) / 8, N_BG = BG_MOD + BG_TR;
#ifndef BG_Q2
#define BG_Q2 1400
#endif
__device__ __forceinline__ void bg_items(const Args& a, LAS unsigned char* ldsl, int lo, int hi, int start, int stride, int tid, int lane, int wave) {
    constexpr int I_OUT = (DM / 64) * (DM / 64), I_FC1 = (DM / 64) * (DFF / 64);
    LAS float* scr = (LAS float*)(ldsl + wave * TR_LDS);
    for (int bi = lo + start; bi < hi; bi += stride) {
        if (bi < BG_MOD) { mod_block_item(a, ldsl, 32 + (bi & 63), bi >> 6, tid, lane, wave); continue; }
        int r = (bi - BG_MOD) * 8 + wave;
        if (r < I_OUT) { p0_transpose_item(a.in[22], DM, DM, (bf16*)(a.ws + WS_WOUT), scr, r, lane); continue; } r -= I_OUT;
        if (r < I_FC1) { p0_transpose_item(a.in[24], DM, DFF, (bf16*)(a.ws + WS_WFC1), scr, r, lane); continue; } r -= I_FC1;
        p0_transpose_item(a.in[25], DFF, DM, (bf16*)(a.ws + WS_WFC2), scr, r, lane);
    }
}

template <int WHICH>
__device__ __forceinline__ void norm_phase(const Args& a, LAS unsigned char* lds, int vcu, int G, int wave) {
    const int tid = fresh_tid(), lane = tid & 63;
    LAS float* Gv = (LAS float*)lds; LAS float* Sv = Gv + DM;
    const float* bmod = a.in[9]; const float* part = (const float*)(a.ws + WS_MODP); float* modf = (float*)(a.ws + WS_MODF);
    const float* gn = WHICH == 0 ? a.in[10] : a.in[23];
    bf16* H = (bf16*)(a.ws + WS_H);
    const int rows_per = (MTOK + G - 1) / G; int m = vcu * rows_per; const int mend = (m + rows_per < MTOK) ? m + rows_per : MTOK;
    while (m < mend) {
        const int r = (m < M_P) ? 8 : (m - M_P) / T_S;
        const int bnd = (m < M_P) ? M_P : M_P + (r + 1) * T_S; const int send = bnd < mend ? bnd : mend;
        __syncthreads();
        for (int c = tid; c < DM; c += NWAVES * 64) {
            float sh, sc;
            if (WHICH == 0) { sh = bmod[c]; sc = bmod[DM + c];
#pragma unroll
                for (int p = 0; p < KSPLIT; ++p) { sh += part[((size_t)p * 9 + r) * NMOD + c]; sc += part[((size_t)p * 9 + r) * NMOD + DM + c]; } }
            else { sh = modf[(size_t)r * NMOD + 3 * DM + c]; sc = modf[(size_t)r * NMOD + 4 * DM + c]; }
            Gv[c] = gn[c] * (1.f + sc); Sv[c] = sh; }
        __syncthreads();
        for (int mm = m + wave; mm < send; mm += NWAVES) {
            if (WHICH == 0) {
                const float* xrow = (mm < M_P) ? a.in[0] + (size_t)mm * DM : a.in[1] + (size_t)(mm - M_P) * DM;
                const GAS f32x4* xr = (const GAS f32x4*)xrow + 2 * lane;
                f32x4 v[16]; float s = 0.f;
#pragma unroll
                for (int j = 0; j < 8; ++j) { v[2 * j] = xr[128 * j]; v[2 * j + 1] = xr[128 * j + 1]; }
#pragma unroll
                for (int j = 0; j < 16; ++j) s += (v[j].x * v[j].x + v[j].y * v[j].y) + (v[j].z * v[j].z + v[j].w * v[j].w);
                const float rstd = __builtin_amdgcn_rsqf(wave_sum(s) * (1.f / DM) + EPS);
                GAS v4u* o16 = (GAS v4u*)(H + (size_t)mm * DM) + lane;
#pragma unroll
                for (int j = 0; j < 8; ++j) { const int c0 = 8 * (lane + 64 * j);
                    const f32x4 g0 = *(const LAS f32x4*)(Gv + c0), g1 = *(const LAS f32x4*)(Gv + c0 + 4), s0 = *(const LAS f32x4*)(Sv + c0), s1 = *(const LAS f32x4*)(Sv + c0 + 4);
                    const f32x4 y0 = v[2 * j] * rstd * g0 + s0, y1 = v[2 * j + 1] * rstd * g1 + s1;
                    v4u o; o.x = pk2(y0.x, y0.y); o.y = pk2(y0.z, y0.w); o.z = pk2(y1.x, y1.y); o.w = pk2(y1.z, y1.w);
                    o16[64 * j] = o; }
            } else {
                const GAS v4u* xr = (const GAS v4u*)((const bf16*)(a.ws + WS_X1B) + (size_t)mm * DM) + lane;
                v4u v[8]; float s = 0.f;
#pragma unroll
                for (int j = 0; j < 8; ++j) { v[j] = xr[64 * j];
#pragma unroll
                    for (int e = 0; e < 4; ++e) { const float lo = __uint_as_float(v[j][e] << 16), hi = __uint_as_float(v[j][e] & 0xffff0000u); s += lo * lo + hi * hi; } }
                const float rstd = __builtin_amdgcn_rsqf(wave_sum(s) * (1.f / DM) + EPS);
                GAS v4u* o16 = (GAS v4u*)(H + (size_t)mm * DM) + lane;
#pragma unroll
                for (int j = 0; j < 8; ++j) { const int c0 = 8 * (lane + 64 * j); v4u o;
                    const f32x4 g0 = *(const LAS f32x4*)(Gv + c0), g1 = *(const LAS f32x4*)(Gv + c0 + 4), s0 = *(const LAS f32x4*)(Sv + c0), s1 = *(const LAS f32x4*)(Sv + c0 + 4);
                    const float x0 = __uint_as_float(v[j].x << 16), x1 = __uint_as_float(v[j].x & 0xffff0000u), x2 = __uint_as_float(v[j].y << 16), x3 = __uint_as_float(v[j].y & 0xffff0000u);
                    const float x4 = __uint_as_float(v[j].z << 16), x5 = __uint_as_float(v[j].z & 0xffff0000u), x6 = __uint_as_float(v[j].w << 16), x7 = __uint_as_float(v[j].w & 0xffff0000u);
                    o.x = pk2(x0 * rstd * g0.x + s0.x, x1 * rstd * g0.y + s0.y); o.y = pk2(x2 * rstd * g0.z + s0.z, x3 * rstd * g0.w + s0.w);
                    o.z = pk2(x4 * rstd * g1.x + s1.x, x5 * rstd * g1.y + s1.y); o.w = pk2(x6 * rstd * g1.z + s1.z, x7 * rstd * g1.w + s1.w);
                    o16[64 * j] = o; }
            }
        }
        m = send;
    }
    __syncthreads();
}

__device__ __forceinline__ void qk_item(const Args& a, const v4u raw, int it, int lane, bf16* P, float* onew, const LAS float* c128, const LAS float* s128, const LAS float* c64, const LAS float* s64) {
    const int sub = lane & 15, sg = lane >> 4;
    const int m = it >> 2, gi = it & 3, grp = (gi == 0) ? 4 : (gi == 1) ? 5 : (gi == 2) ? 10 : 11; bf16* src = P + (size_t)m * DIN + grp * 512 + lane * 8;
        float x[8];
        x[0] = __uint_as_float(raw.x << 16); x[1] = __uint_as_float(raw.x & 0xffff0000u); x[2] = __uint_as_float(raw.y << 16); x[3] = __uint_as_float(raw.y & 0xffff0000u);
        x[4] = __uint_as_float(raw.z << 16); x[5] = __uint_as_float(raw.z & 0xffff0000u); x[6] = __uint_as_float(raw.w << 16); x[7] = __uint_as_float(raw.w & 0xffff0000u);
        const bool lat = m >= M_P; const int t = lat ? (m - M_P) % T_S : m % T_P; const int b = lat ? (m - M_P) / T_S : m / T_P;
        const bool is_v = (grp == 5 || grp == 11);
        const bool is_a = grp < 6;
        if (!is_v) {
            float ss = 0.f;
#pragma unroll
            for (int e = 0; e < 8; ++e) ss += x[e] * x[e];
            ss += __shfl_xor(ss, 1); ss += __shfl_xor(ss, 2); ss += __shfl_xor(ss, 4);
            if (is_a) ss += __shfl_xor(ss, 8);
            const float rstd = __builtin_amdgcn_rsqf(ss * (is_a ? (1.f / 128.f) : (1.f / 64.f)) + EPS);
            const float* gp = (grp < 4) ? a.in[12] : (grp == 4) ? a.in[13] : (grp < 10) ? a.in[14] : a.in[15];
            const int goff = is_a ? sub * 8 : (sub & 7) * 8;
            const f32x4 g0 = *(const GAS f32x4*)(gp + goff), g1 = *(const GAS f32x4*)(gp + goff + 4);
            x[0] *= rstd * g0.x; x[1] *= rstd * g0.y; x[2] *= rstd * g0.z; x[3] *= rstd * g0.w; x[4] *= rstd * g1.x; x[5] *= rstd * g1.y; x[6] *= rstd * g1.z; x[7] *= rstd * g1.w;
            if (lat) {
                float px[8];
                if (is_a) {
#pragma unroll
                    for (int e = 0; e < 8; ++e) px[e] = __shfl_xor(x[e], 4);
                    const int axis = (sub >> 3) & 1, half = (sub >> 2) & 1, i0 = (sub & 3) * 8, pos = axis ? (t & 63) : (t >> 6);
#pragma unroll
                    for (int e = 0; e < 8; ++e) { const float cs = c128[pos * 32 + i0 + e], sn = s128[pos * 32 + i0 + e]; x[e] = half ? (x[e] * cs + px[e] * sn) : (x[e] * cs - px[e] * sn); }
                } else {
#pragma unroll
                    for (int e = 0; e < 8; ++e) px[e] = __shfl_xor(x[e], 2);
                    const int s8 = sub & 7, axis = (s8 >> 2) & 1, half = (s8 >> 1) & 1, i0 = (s8 & 1) * 8, pos = axis ? (t & 63) : (t >> 6);
#pragma unroll
                    for (int e = 0; e < 8; ++e) { const float cs = c64[pos * 16 + i0 + e], sn = s64[pos * 16 + i0 + e]; x[e] = half ? (x[e] * cs + px[e] * sn) : (x[e] * cs - px[e] * sn); }
                }
            }
        }
        v4u ob; ob.x = pk2(x[0], x[1]); ob.y = pk2(x[2], x[3]); ob.z = pk2(x[4], x[5]); ob.w = pk2(x[6], x[7]);
        const bool is_q = (grp < 4) || (grp >= 6 && grp < 10);
        if (is_q) { *(GAS v4u*)src = ob; }
        else {
            const int which = (grp == 4) ? 0 : (grp == 5) ? 1 : (grp == 10) ? 2 : 3;
            const int kv = sg;
            if (lat) { *(GAS v4u*)((bf16*)(a.ws + WS_KVL + (size_t)which * KVL_SZ) + ((size_t)(b * 4 + kv) * KVL + LCTX + t) * 128 + sub * 8) = ob; }
            else { *(GAS v4u*)((bf16*)(a.ws + WS_KVP + (size_t)which * KVP_SZ) + ((size_t)(b * 4 + kv) * T_P + t) * 128 + sub * 8) = ob;
                GAS f32x4* of = (GAS f32x4*)(onew + (size_t)which * M_P * 512 + (size_t)m * 512 + kv * 128 + sub * 8);
                of[0] = (f32x4){x[0], x[1], x[2], x[3]}; of[1] = (f32x4){x[4], x[5], x[6], x[7]}; }
        }

}
__device__ __forceinline__ void qk_phase(const Args& a, LAS unsigned char* lds, int vcu, int G, int wave) {
    const int tid = fresh_tid(), lane = tid & 63;
    LAS float* c128 = (LAS float*)lds; LAS float* s128 = c128 + 2048; LAS float* c64 = s128 + 2048; LAS float* s64 = c64 + 1024;
    for (int e = tid; e < 2048; e += NWAVES * 64) { const int pos = e >> 5, i = e & 31; const float f = exp2f(-(float)i * (13.287712379549449f / 32.f)); float sn, cs; sincosf((float)pos * f, &sn, &cs); c128[e] = cs; s128[e] = sn; }
    for (int e = tid; e < 1024; e += NWAVES * 64) { const int pos = e >> 4, i = e & 15; const float f = exp2f(-(float)i * (13.287712379549449f / 16.f)); float sn, cs; sincosf((float)pos * f, &sn, &cs); c64[e] = cs; s64[e] = sn; }
    __syncthreads();
    bf16* P = (bf16*)(a.ws + WS_P);
    float* onew = a.out + (size_t)MTOK * DM;
    const int gw = vcu * NWAVES + wave, NGW = G * NWAVES;
#define QK_GRP(gi_) ((gi_) == 0 ? 4 : (gi_) == 1 ? 5 : (gi_) == 2 ? 10 : 11)
#define QK_SRC(it_) (P + (size_t)((it_) >> 2) * DIN + QK_GRP((it_) & 3) * 512 + lane * 8)
    for (int it = gw; it < MTOK * 4; it += 4 * NGW) {
        const int it1 = it + NGW, it2 = it + 2 * NGW, it3 = it + 3 * NGW;
        v4u r0, r1 = {0u, 0u, 0u, 0u}, r2 = {0u, 0u, 0u, 0u}, r3 = {0u, 0u, 0u, 0u};
        r0 = *(const GAS v4u*)QK_SRC(it);
        if (it1 < MTOK * 4) r1 = *(const GAS v4u*)QK_SRC(it1);
        if (it2 < MTOK * 4) r2 = *(const GAS v4u*)QK_SRC(it2);
        if (it3 < MTOK * 4) r3 = *(const GAS v4u*)QK_SRC(it3);
        qk_item(a, r0, it, lane, P, onew, c128, s128, c64, s64);
        if (it1 < MTOK * 4) qk_item(a, r1, it1, lane, P, onew, c128, s128, c64, s64);
        if (it2 < MTOK * 4) qk_item(a, r2, it2, lane, P, onew, c128, s128, c64, s64);
        if (it3 < MTOK * 4) qk_item(a, r3, it3, lane, P, onew, c128, s128, c64, s64);
    }
#undef QK_SRC
#undef QK_GRP
    __syncthreads();
}

__device__ __forceinline__ void attn_phase(const Args& a, unsigned char* lds_g, int G, int wave) {
    const int lane = fresh_tid() & 63;
    const bf16* P = (const bf16*)(a.ws + WS_P); bf16* O = (bf16*)(a.ws + WS_O);
    const bf16* KA_l = (const bf16*)(a.ws + WS_KVL); const bf16* VA_l = (const bf16*)(a.ws + WS_KVL + KVL_SZ); const bf16* KB_l = (const bf16*)(a.ws + WS_KVL + 2 * KVL_SZ); const bf16* VB_l = (const bf16*)(a.ws + WS_KVL + 3 * KVL_SZ);
    const bf16* KA_p = (const bf16*)(a.ws + WS_KVP); const bf16* VA_p = (const bf16*)(a.ws + WS_KVP + KVP_SZ); const bf16* KB_p = (const bf16*)(a.ws + WS_KVP + 2 * KVP_SZ); const bf16* VB_p = (const bf16*)(a.ws + WS_KVP + 3 * KVP_SZ);
    float* misc = (float*)(lds_g + att::LDS_MISC);
    if (wave == 0) { const float p1 = a.in[17][lane] * a.in[18][lane], p2 = a.in[19][lane] * a.in[20][lane];
        const float s1 = wave_sum(p1), s2 = wave_sum(p2); if (lane == 0) misc[0] = __expf(s1) - __expf(s2) + 0.2f; }
    __syncthreads();
    const float lam = misc[0];
    const int nper = G / 8;
    const int c = blockIdx.x, x = c % 8, j = c / 8;
    att::UnitArgs U;
#ifndef ATT_NO_MODE1
    for (int u = c; u < NB_S * 16 * 8 + NB_P * 16 * 2; u += G) {
        const bool lat = u < NB_S * 16 * 8; const int uu = lat ? u : u - NB_S * 16 * 8; const int i = uu / G;
        int gid, g, qb;
        if (lat) { if (G == 256) { gid = i * 8 + x; g = j >> 3; qb = j & 7; } else { gid = uu >> 5; g = (uu >> 3) & 3; qb = uu & 7; } }
        else     { if (G == 256) { gid = (i * 8 + x) * 4 + (j >> 3); g = (j >> 1) & 3; qb = j & 1; } else { gid = uu >> 3; g = (uu >> 1) & 3; qb = uu & 1; } }
        const int b = gid >> 2, kv = gid & 3, h = kv * 4 + g; const int m0 = lat ? M_P + b * T_S + qb * 128 : b * T_P + qb * 128;
        const size_t kvoff = lat ? (size_t)(b * 4 + kv) * KVL * 128 : (size_t)(b * 4 + kv) * T_P * 128;
        U.Qb = P + (size_t)m0 * DIN + 3072 + h * 128; U.ldq = DIN; U.Kh = (lat ? KB_l : KB_p) + kvoff; U.Vh = (lat ? VB_l : VB_p) + kvoff;
        U.Ob = O + (size_t)m0 * DM + 2048 + h * 128; U.ldo = DM; U.NT = lat ? KVL / 64 : T_P / 64; U.jwin = 1 << 30; U.wadd = 0; U.masked = 0; U.t0 = 0; U.sinkl2 = 0.f; U.lam = lam; U.subg = a.in[21]; U.qg = a.in[14]; U.ropeT = (const float*)(a.ws + WS_ROPE); U.rope = lat ? 1 : 0; U.t0 = lat ? qb * 128 : 0;
        att::attn_unit<1>(U, (char*)lds_g);
    }
#endif
#ifndef ATT_NO_MODE0
    for (int u = c; u < NB_S * 16 * 4 + NB_P * 16; u += G) {
        const bool lat = u < NB_S * 16 * 4; const int uu = lat ? u : u - NB_S * 16 * 4; const int i = uu / G;
        int gid, g, qb2;
        if (lat) { if (G == 256) { gid = (i * 8 + x) * 2 + (j >> 4); g = (j >> 2) & 3; qb2 = j & 3; } else { gid = uu >> 4; g = (uu >> 2) & 3; qb2 = uu & 3; } }
        else     { if (G == 256) { gid = x * 8 + (j >> 2); g = j & 3; qb2 = 0; } else { gid = uu >> 2; g = uu & 3; qb2 = 0; } }
        const int b = gid >> 2, kv = gid & 3, h = kv * 4 + g; const int t0 = qb2 * 256, m0 = lat ? M_P + b * T_S + t0 : b * T_P;
        const int wstart = (t0 - 128 > 0) ? t0 - 128 : 0, wend = (t0 + 384 < T_S) ? t0 + 384 : T_S;
        const size_t kvoff = lat ? (size_t)(b * 4 + kv) * KVL * 128 : (size_t)(b * 4 + kv) * T_P * 128;
        U.Qb = P + (size_t)m0 * DIN + h * 128; U.ldq = DIN; U.Kh = (lat ? KA_l : KA_p) + kvoff; U.Vh = (lat ? VA_l : VA_p) + kvoff;
        U.Ob = O + (size_t)m0 * DM + h * 128; U.ldo = DM; U.NT = lat ? 8 + (wend - wstart) / 64 : T_P / 64; U.jwin = lat ? 8 : (1 << 30); U.wadd = lat ? wstart : 0; U.masked = lat ? 1 : 0; U.t0 = t0;
        U.sinkl2 = a.in[16][h] * att::LOG2E; U.lam = 0.f; U.subg = nullptr; U.qg = a.in[12]; U.ropeT = (const float*)(a.ws + WS_ROPE); U.rope = lat ? 1 : 0;
        att::attn_unit<0>(U, (char*)lds_g);
    }
#endif
    __syncthreads();
}


__device__ __forceinline__ void p0_phase(const Args& args, LAS unsigned char* ldsl, int vcu, int G, int wave) {
    const int tid = fresh_tid(), lane = tid & 63;
    for (int it = vcu; it < 32 * KSPLIT; it += G) mod_block_item(args, ldsl, it & 31, it >> 5, tid, lane, wave);
}
__device__ __forceinline__ void p1_extras(const Args& args, LAS unsigned char* ldsl, int vcu, int G, int wave) {
    const int lane = fresh_tid() & 63;
    LAS float* scr = (LAS float*)(ldsl + wave * TR_LDS);
    constexpr int I_IN = (DM / 64) * (DIN / 64);
    if (vcu == 0) { float* rt = (float*)(args.ws + WS_ROPE); const int tid = wave * 64 + lane;
        for (int e = tid; e < 2048; e += NWAVES * 64) { const int pos = e >> 5, i = e & 31; const float fq_ = exp2f(-(float)i * (13.287712379549449f / 32.f)); float sn, cs; sincosf((float)pos * fq_, &sn, &cs); rt[e] = cs; rt[2048 + e] = sn; }
        for (int e = tid; e < 1024; e += NWAVES * 64) { const int pos = e >> 4, i = e & 15; const float fq_ = exp2f(-(float)i * (13.287712379549449f / 16.f)); float sn, cs; sincosf((float)pos * fq_, &sn, &cs); rt[4096 + e] = cs; rt[5120 + e] = sn; } }
    for (int r = vcu * NWAVES + wave; r < I_IN; r += G * NWAVES) p0_transpose_item(args.in[11], DM, DIN, (bf16*)(args.ws + WS_WIN), scr, r, lane);
    for (int it = vcu * NWAVES + wave; it < 4 * 4096; it += G * NWAVES) {
        const int tsr = it >> 12, w = it & 4095; const size_t e = ((size_t)w * 64 + lane) * 8;
        const float* src = args.in[2 + tsr] + e; const f32x4 v0 = *(const GAS f32x4*)src, v1 = *(const GAS f32x4*)(src + 4);
        const int d = (int)(e & 127), kv = (int)((e >> 7) & 3), key = (int)((e >> 9) & 511), b = (int)(e >> 18);
        v4u o; o.x = pk2(v0.x, v0.y); o.y = pk2(v0.z, v0.w); o.z = pk2(v1.x, v1.y); o.w = pk2(v1.z, v1.w);
        *(GAS v4u*)((bf16*)(args.ws + WS_KVL + tsr * KVL_SZ) + ((size_t)(b * 4 + kv) * KVL + key) * 128 + d) = o; }
}
__device__ __forceinline__ void p3_extras(const Args& args, LAS unsigned char* ldsl, int vcu, int G, int q2, int wave) {
    const int tid = fresh_tid(), lane = tid & 63;
    bg_items(args, ldsl, q2, N_BG, vcu, G, tid, lane, wave);
    __syncthreads();
}
__device__ __forceinline__ void modf_rest(const Args& args, int vcu, int G) {
    const int tid = fresh_tid();
    const float* bmod = args.in[9]; const float* part = (const float*)(args.ws + WS_MODP); float* modf = (float*)(args.ws + WS_MODF);
    for (int e = vcu * (NWAVES * 64) + tid; e < 9 * 4 * DM; e += G * NWAVES * 64) { const int r = e / (4 * DM), n = 2 * DM + e % (4 * DM);
        float s = bmod[n];
#pragma unroll
        for (int p = 0; p < KSPLIT; ++p) s += part[((size_t)p * 9 + r) * NMOD + n];
        modf[(size_t)r * NMOD + n] = s; }
}
#ifndef GEMM_ORDER
#define GEMM_ORDER pg8::BlockOrder
#endif
#ifndef GEMM_ALIGN
#define GEMM_ALIGN true
#endif
#ifndef GEMM_SP2
#define GEMM_SP2 true
#endif
#ifndef U_TILED
#define U_TILED true
#endif
#ifndef U_NT
#define U_NT true
#endif
constexpr int P2_G = 232;
__device__ __forceinline__ void p2_phase(const Args& args, LAS unsigned char* ldsl, int G, int bx, int wave) {
    const bool split = (G == 256);
    if (!split || bx < P2_G) {
        pg8::Gemm g{(const pg8::bf16_t*)(args.ws + WS_H), (const pg8::bf16_t*)(args.ws + WS_WIN), MTOK, DIN, DM, 0}; pg8::StaticOrder S; S.init(MTOK, DIN, split ? P2_G : G, bx);
        pg8::EpiBf16<0> E{(pg8::bf16_t*)(args.ws + WS_P), DIN};
        pg8::gemm_phase<pg8::EpiBf16<0>, pg8::StaticOrder, GEMM_ALIGN, GEMM_SP2>(ldsl, g, S, E);
    } else {
        const int tid = fresh_tid(), lane = tid & 63;
        bg_items(args, ldsl, 0, BG_Q2, bx - P2_G, G - P2_G, tid, lane, wave);
    }
}
__device__ __forceinline__ void p5_phase(const Args& args, LAS unsigned char* ldsl, int G, int bx) {
    pg8::Gemm g{(const pg8::bf16_t*)(args.ws + WS_O), (const pg8::bf16_t*)(args.ws + WS_WOUT), MTOK, DM, DM, 0}; GEMM_ORDER S; S.init(MTOK, DM, G, bx);
    const float* modf = (const float*)(args.ws + WS_MODF);
    pg8::EpiResidB E{args.in[0], args.in[1], (pg8::bf16_t*)(args.ws + WS_X1B), DM, M_P / 256, modf + 2 * DM, NMOD, modf + (size_t)8 * NMOD + 2 * DM};
    pg8::gemm_phase<pg8::EpiResidB, GEMM_ORDER, GEMM_ALIGN, GEMM_SP2>(ldsl, g, S, E);
}
__device__ __forceinline__ void p7_phase(const Args& args, LAS unsigned char* ldsl, int G, int bx) {
    pg8::Gemm g{(const pg8::bf16_t*)(args.ws + WS_H), (const pg8::bf16_t*)(args.ws + WS_WFC1), MTOK, DFF, DM, 0}; GEMM_ORDER S; S.init(MTOK, DFF, G, bx);
    pg8::EpiBf16<1, U_NT, U_TILED> E{(pg8::bf16_t*)(args.ws + WS_U), DFF};
    pg8::gemm_phase<pg8::EpiBf16<1, U_NT, U_TILED>, GEMM_ORDER, GEMM_ALIGN, GEMM_SP2>(ldsl, g, S, E);
}
__device__ __forceinline__ void p7_null_phase(const Args& args, LAS unsigned char* ldsl, int G, int bx) {
    pg8::Gemm g{(const pg8::bf16_t*)(args.ws + WS_H), (const pg8::bf16_t*)(args.ws + WS_WFC1), MTOK, DFF, DM, 0}; pg8::StaticOrder S; S.init(MTOK, DFF, G, bx);
    pg8::EpiNull E{};
    pg8::gemm_phase<pg8::EpiNull, pg8::StaticOrder, GEMM_ALIGN, GEMM_SP2>(ldsl, g, S, E);
}
__device__ __forceinline__ void p8_null_phase(const Args& args, LAS unsigned char* ldsl, int G, int bx) {
    pg8::Gemm g{(const pg8::bf16_t*)(args.ws + WS_U), (const pg8::bf16_t*)(args.ws + WS_WFC2), MTOK, DM, DFF, U_TILED ? 1 : 0}; pg8::StaticOrder S; S.init(MTOK, DM, G, bx);
    pg8::EpiNull E{};
    pg8::gemm_phase<pg8::EpiNull, pg8::StaticOrder, GEMM_ALIGN, GEMM_SP2>(ldsl, g, S, E);
}
__device__ __forceinline__ void p8_phase(const Args& args, LAS unsigned char* ldsl, int G, int bx) {
    pg8::Gemm g{(const pg8::bf16_t*)(args.ws + WS_U), (const pg8::bf16_t*)(args.ws + WS_WFC2), MTOK, DM, DFF, U_TILED ? 1 : 0}; GEMM_ORDER S; S.init(MTOK, DM, G, bx);
    const float* modf = (const float*)(args.ws + WS_MODF);
    pg8::EpiResid E{(const pg8::bf16_t*)(args.ws + WS_X1B), args.out, DM, M_P / 256, modf + 5 * DM, NMOD, modf + (size_t)8 * NMOD + 5 * DM};
    pg8::gemm_phase<pg8::EpiResid, GEMM_ORDER, GEMM_ALIGN, GEMM_SP2>(ldsl, g, S, E);
}

__global__ void __launch_bounds__(NWAVES * 64, 2) fwd_kernel(Args args) {
    extern __shared__ __attribute__((aligned(16))) unsigned char lds[];
    LAS unsigned char* ldsl = (LAS unsigned char*)lds;
    volatile LAS unsigned* MISC = (volatile LAS unsigned*)(ldsl + MISC_OFF);
    const int tid = threadIdx.x, wave = __builtin_amdgcn_readfirstlane(tid >> 6);
    const int G = gridDim.x; const int bx = blockIdx.x; const int vcu = (G % 8 == 0) ? (bx % 8) * (G / 8) + bx / 8 : bx;
    gu32* ctl = (gu32*)(args.ws + WS_CTL);
    for (int u = tid; u < (LDS_BYTES - MISC_OFF) / 4; u += NWAVES * 64) ((LAS unsigned*)(ldsl + MISC_OFF))[u] = 0u;
    __syncthreads();
    XcdBarrier bar; bar.bar = (unsigned*)(ctl + CW_BAR); bar.x = 0; bar.st = nullptr;
    if (N_LAUNCHES == 1) bar = xcd_barrier_post((unsigned*)(ctl + CW_BAR), MISC + 8);
    const int lo = args.ph_lo, hi = args.ph_hi;
#ifndef PHASE_MASK
#define PHASE_MASK 0x1ff
#endif
#define IN(k) ((((PHASE_MASK) >> (k)) & 1) && lo <= (k) && (k) < hi)
#define SEAM(k) do { if (IN(k) && IN((k) + 1)) xcd_barrier(bar); } while (0)

#ifndef PROBE_REPEAT
#define PROBE_REPEAT (-1)
#endif
#if defined(PROBE_TIME)
    unsigned long long pt0 = 0, pt1 = 0;
#define PT_BEGIN(k) do { if (PROBE_TIME == (k)) pt0 = wall_clock64(); } while (0)
#define PT_END(k) do { if (PROBE_TIME == (k)) pt1 = wall_clock64(); } while (0)
#else
#define PT_BEGIN(k) do { } while (0)
#define PT_END(k) do { } while (0)
#endif
#define REP(k, call) do { if (PROBE_REPEAT == (k)) { call; xcd_barrier(bar); } } while (0)
    PT_BEGIN(0);
    if (IN(0)) p0_phase(args, ldsl, vcu, G, wave);
    SEAM(0); PT_END(0);
    PT_BEGIN(1);
    if (IN(1)) { norm_phase<0>(args, ldsl, vcu, G, wave); p1_extras(args, ldsl, vcu, G, wave); }
    SEAM(1); PT_END(1);
    PT_BEGIN(2);
    if (IN(2)) p2_phase(args, ldsl, G, bx, wave);
    SEAM(2); PT_END(2);
    PT_BEGIN(3);
    if (IN(3)) { p3_extras(args, ldsl, vcu, G, (G == 256) ? BG_Q2 : 0, wave); qk_phase(args, ldsl, vcu, G, wave); }
    SEAM(3); PT_END(3);
    PT_BEGIN(4);
    if (IN(4)) { modf_rest(args, vcu, G); attn_phase(args, lds, G, wave); }
    SEAM(4); PT_END(4); REP(4, attn_phase(args, lds, G, wave));
    PT_BEGIN(5);
    if (IN(5)) p5_phase(args, ldsl, G, bx);
    SEAM(5); PT_END(5); REP(5, p5_phase(args, ldsl, G, bx));
    PT_BEGIN(6);
    if (IN(6)) norm_phase<1>(args, ldsl, vcu, G, wave);
    SEAM(6); PT_END(6); REP(6, norm_phase<1>(args, ldsl, vcu, G, wave));
#if defined(PROBE_CLOCK)
    unsigned long long pc0 = 0, pr0 = 0, pc1 = 0, pr1 = 0;
    if (PROBE_CLOCK == 7) { pc0 = clock64(); pr0 = wall_clock64(); }
#endif
    PT_BEGIN(7);
    if (IN(7)) p7_phase(args, ldsl, G, bx);
#if defined(PROBE_CLOCK)
    if (PROBE_CLOCK == 7) { pc1 = clock64(); pr1 = wall_clock64(); }
#endif
    SEAM(7); PT_END(7); REP(7, p7_phase(args, ldsl, G, bx)); REP(17, p7_null_phase(args, ldsl, G, bx)); REP(18, p8_null_phase(args, ldsl, G, bx));
    PT_BEGIN(8);
    if (IN(8)) p8_phase(args, ldsl, G, bx);
#if defined(PROBE_TIME)
    PT_END(8);
    if (bx == 0 && tid == 0) { const unsigned long long t0 = wall_clock64(); while (wall_clock64() - t0 < (pt1 - pt0)) __builtin_amdgcn_s_sleep(8); }
#endif
#if defined(PROBE_CLOCK)
    if (bx == 0 && tid == 0) {
        const unsigned long long ticks = (pc1 - pc0) * 1000ull / (pr1 - pr0);
        const unsigned long long t0 = wall_clock64(); while (wall_clock64() - t0 < ticks) __builtin_amdgcn_s_sleep(8);
    }
#endif
#undef REP
#undef IN
#undef SEAM
}

extern "C" void kernel_launch(void* const* d_in, const int* in_sizes, int n_in, void* d_out, int out_size, void* d_ws, size_t ws_size, hipStream_t stream) {
    static int grid = 0;
    if (grid == 0) {
        if (n_in != 26 || in_sizes[0] != M_P * DM || in_sizes[1] != M_S * DM || out_size != MTOK * DM + 4 * M_P * 512 || ws_size < WS_END) {
            fprintf(stderr, "kernel_launch: shape mismatch (n_in %d in0 %d in1 %d out %d ws %zu, need ws >= %zu); nothing launched\n", n_in, n_in > 0 ? in_sizes[0] : -1, n_in > 1 ? in_sizes[1] : -1, out_size, ws_size, (size_t)WS_END); grid = -1; return; }
        int dev = 0, cus = 0, per_cu = 0;
        if (hipGetDevice(&dev) != hipSuccess || hipDeviceGetAttribute(&cus, hipDeviceAttributeMultiprocessorCount, dev) != hipSuccess) { grid = -1; return; }
        if (hipFuncSetAttribute((const void*)fwd_kernel, hipFuncAttributeMaxDynamicSharedMemorySize, LDS_BYTES) != hipSuccess) { fprintf(stderr, "kernel_launch: hipFuncSetAttribute failed\n"); grid = -1; return; }
        if (hipOccupancyMaxActiveBlocksPerMultiprocessor(&per_cu, (const void*)fwd_kernel, NWAVES * 64, LDS_BYTES) != hipSuccess || per_cu < 1) { fprintf(stderr, "kernel_launch: occupancy query says %d blocks per CU\n", per_cu); }
        (void)hipGetLastError();
        grid = cus;
    }
    if (grid < 0) return;
    if (hipMemsetAsync((char*)d_ws + WS_CTL, 0, CTL_ZERO_BYTES, stream) != hipSuccess) return;
    Args a{};
    for (int i = 0; i < 26; ++i) a.in[i] = (const float*)d_in[i];
    a.out = (float*)d_out; a.ws = (unsigned char*)d_ws;
    if (N_LAUNCHES == 1) { a.ph_lo = 0; a.ph_hi = NPH; hipLaunchKernelGGL(fwd_kernel, dim3(grid), dim3(NWAVES * 64), LDS_BYTES, stream, a); }
    else { for (int p = 0; p < NPH; ++p) { a.ph_lo = p; a.ph_hi = p + 1; hipLaunchKernelGGL(fwd_kernel, dim3(grid), dim3(NWAVES * 64), LDS_BYTES, stream, a); } }
    const hipError_t le = hipPeekAtLastError();
    if (le != hipSuccess) fprintf(stderr, "kernel_launch: launch failed: %s\n", hipGetErrorName(le));
}
```

```cpp
#include <hip/hip_runtime.h>
#include <cstdio>
#include <cstdint>
#ifndef PG8_WGM
#define PG8_WGM 8
#endif
namespace pg8 {
#define PG8_LAS __attribute__((address_space(3)))
typedef unsigned short bf16_t;
typedef short bf16x8 __attribute__((ext_vector_type(8)));
typedef float f32x4 __attribute__((ext_vector_type(4)));
typedef unsigned u32x4 __attribute__((ext_vector_type(4)));
constexpr int BM = 256, BK = 64, HALF = 128, HTB = HALF * BK * 2  , STAGE_BYTES = 8 * HTB, NXCD = 8, WGM = PG8_WGM;

__host__ __device__ __forceinline__ int lds_byte(int r, int c) { const int st = (r >> 4) * 2 + (c >> 5), rr = r & 15, cc = c & 31, ob = rr * 64 + cc * 2; return st * 1024 + (ob ^ (((ob >> 9) & 1) << 5)); }
__host__ __device__ __forceinline__ void stage_rc(int b, int& R, int& C) { const int st = b / 1024, sb = b % 1024, swz = sb ^ (((sb >> 9) & 1) << 5); R = (st >> 1) * 16 + swz / 64; C = (st & 1) * 32 + (swz % 64) / 2; }
__host__ __device__ __forceinline__ int perm32(int rho) { const int n = rho >> 4, i = rho & 15; return 8 * (i >> 2) + 4 * n + (i & 3); }

struct Unit { int pm, pn; };
struct Gemm { const bf16_t* A; const bf16_t* Bt; int M, N, K; int a_tiled; };

struct StaticOrder {
    int nM, nN, nwg, G, c;
    __host__ __device__ void init(int M, int N, int G_, int c_) { nM = M / BM; nN = N / BM; nwg = nM * nN; G = G_; c = c_; }
    __host__ __device__ bool next(int i, Unit& u) const {
        const long L = (long)i * G + c; if (L >= nwg) return false;
        int wgid = (int)L; { const int q = nwg / NXCD, r = nwg % NXCD, xcd = wgid % NXCD, off = wgid / NXCD; wgid = (xcd < r ? xcd * (q + 1) : r * (q + 1) + (xcd - r) * q) + off; }
        const int nig = WGM * nN, gid = wgid / nig, fm = gid * WGM, gsz = (nM - fm) < WGM ? (nM - fm) : WGM;
        u.pm = fm + ((wgid % nig) % gsz); u.pn = (wgid % nig) / gsz; return true;
    }
    __device__ __forceinline__ void a_ready(const Unit&) const {}
    __device__ __forceinline__ void done(const Unit&) const {}
};

struct BlockOrder {
    int nM, nN, nqb, nblk, c, G;
    __host__ __device__ void init(int M, int N, int G_, int c_) { nM = M / BM; nN = N / BM; nqb = nN / 4; nblk = (nM / 8) * nqb; c = c_; G = G_; }
    __host__ __device__ bool next(int i, Unit& u) const {
        if (G != 256 || (nM & 7) || (nN & 3)) { const long L = (long)i * G + c; if (L >= (long)nM * nN) return false; u.pm = (int)(L / nN); u.pn = (int)(L % nN); return true; }
        const int x = c & 7, j = c >> 3, b = i * 8 + x; if (b >= nblk) return false;
        const int g = b / nqb, q = b - g * nqb; u.pm = 8 * g + (j & 7); u.pn = 4 * q + (j >> 3); return true;
    }
    __device__ __forceinline__ void a_ready(const Unit&) const {}
    __device__ __forceinline__ void done(const Unit&) const {}
};

__device__ __forceinline__ unsigned cvt_pk_bf16(float lo, float hi) { unsigned r; asm volatile("v_cvt_pk_bf16_f32 %0, %1, %2" : "=v"(r) : "v"(lo), "v"(hi)); return r; }

template <int ACT, bool NT = false, bool TILED = false> struct EpiBf16 {
    static constexpr bool PERM = true, AFTER_DRAIN = false;
    bf16_t* O; int ldc;
    __device__ __forceinline__ void operator()(const f32x4 (&acc)[2][2][4][2], const Unit& u, int wr, int wc, int fr, int fq) const {
        const int row0 = u.pm * BM + wr * 64 + fr; const int col0 = u.pn * BM + wc * 32 + 8 * fq;
#pragma unroll
        for (int ai = 0; ai < 2; ++ai)
#pragma unroll
            for (int m = 0; m < 4; ++m) {
                bf16_t* rowp = TILED ? O + (((size_t)u.pm * (ldc / 64) + u.pn * 4 + (wc >> 1)) * BM + (wr * 64 + fr + ai * HALF + m * 16)) * 64 + (wc & 1) * 32 + 8 * fq
                                     : O + (size_t)(row0 + ai * HALF + m * 16) * ldc + col0;
                constexpr size_t BJ_STEP = TILED ? (size_t)2 * BM * 64 : (size_t)HALF;
#pragma unroll
                for (int bj = 0; bj < 2; ++bj) { f32x4 v0 = acc[ai][bj][m][0], v1 = acc[ai][bj][m][1];
                    if (ACT == 1) {
#pragma unroll
                        for (int j = 0; j < 4; ++j) { const float a = fmaxf(v0[j], 0.f), b = fmaxf(v1[j], 0.f); v0[j] = a * a; v1[j] = b * b; } }
                    u32x4 w; w.x = cvt_pk_bf16(v0[0], v0[1]); w.y = cvt_pk_bf16(v0[2], v0[3]); w.z = cvt_pk_bf16(v1[0], v1[1]); w.w = cvt_pk_bf16(v1[2], v1[3]);
                    if (NT) __builtin_nontemporal_store(w, (u32x4*)(rowp + bj * BJ_STEP)); else *(u32x4*)(rowp + bj * BJ_STEP) = w;
#if defined(PROBE_STORE)
                    if (ACT == 1) {
                        bf16_t* dp = O - ((size_t)304 << 20) / 2; const int pmw = u.pm & 31;
                        if (PROBE_STORE == 1) *(u32x4*)(dp + (size_t)(pmw * BM + wr * 64 + fr + ai * HALF + m * 16) * ldc + col0 + bj * HALF) = w;
                        else if (PROBE_STORE == 2) *(u32x4*)(dp + (size_t)(pmw * BM + wr * 64 + ai * HALF + m * 16 + (fr & 7) + 8 * bj) * ldc + u.pn * BM + wc * 64 + (fr >> 3) * 32 + 8 * fq) = w;
                        else *(u32x4*)(dp + ((size_t)(pmw * (ldc / BM) + u.pn) * BM + (wr * 64 + fr + ai * HALF + m * 16)) * BM + wc * 32 + 8 * fq + bj * HALF) = w;
                    }
#endif
                    } }
    }
};
struct EpiResidB {
    static constexpr bool PERM = true, AFTER_DRAIN = false;
    const float* base0; const float* base1; bf16_t* out; int ldc; int split; const float* gate; int gate_stride; const float* gate_ctx;
    __device__ __forceinline__ void operator()(const f32x4 (&acc)[2][2][4][2], const Unit& u, int wr, int wc, int fr, int fq) const {
        const int rloc = wr * 64 + fr, col0 = u.pn * BM + wc * 32 + 8 * fq;
        const float* bt = (u.pm < split) ? base0 + (size_t)u.pm * BM * ldc : base1 + (size_t)(u.pm - split) * BM * ldc;
        const float* gv = (u.pm < split) ? gate_ctx : gate + (size_t)((u.pm - split) >> 2) * gate_stride;
        bf16_t* ot = out + (size_t)u.pm * BM * ldc;
        f32x4 g[2][2];
#pragma unroll
        for (int bj = 0; bj < 2; ++bj)
#pragma unroll
            for (int n = 0; n < 2; ++n) g[bj][n] = *(const f32x4*)(gv + col0 + bj * HALF + 4 * n);
#pragma unroll
        for (int ai = 0; ai < 2; ++ai)
#pragma unroll
            for (int m = 0; m < 4; ++m) { const size_t off = (size_t)(rloc + ai * HALF + m * 16) * ldc + col0;
#pragma unroll
                for (int bj = 0; bj < 2; ++bj) { const f32x4 b0 = *(const f32x4*)(bt + off + bj * HALF), b1 = *(const f32x4*)(bt + off + bj * HALF + 4);
                    const f32x4 v0 = b0 + g[bj][0] * acc[ai][bj][m][0], v1 = b1 + g[bj][1] * acc[ai][bj][m][1];
                    u32x4 w; w.x = cvt_pk_bf16(v0[0], v0[1]); w.y = cvt_pk_bf16(v0[2], v0[3]); w.z = cvt_pk_bf16(v1[0], v1[1]); w.w = cvt_pk_bf16(v1[2], v1[3]);
                    *(u32x4*)(ot + off + bj * HALF) = w; }
                if (m & 1) asm volatile("" ::: "memory"); }
    }
};
struct EpiResid {
    static constexpr bool PERM = false, AFTER_DRAIN = false;
    const bf16_t* base; float* out; int ldc; int split; const float* gate; int gate_stride; const float* gate_ctx;
    __device__ __forceinline__ void operator()(const f32x4 (&acc)[2][2][4][2], const Unit& u, int wr, int wc, int fr, int fq) const {
        typedef unsigned u32x2 __attribute__((ext_vector_type(2)));
        const int rloc = wr * 64 + fr, col0 = u.pn * BM + wc * 32 + 4 * fq;
        const bf16_t* bt = base + (size_t)u.pm * BM * ldc;
        const float* gv = (u.pm < split) ? gate_ctx : gate + (size_t)((u.pm - split) >> 2) * gate_stride;
        float* ot = out + (size_t)u.pm * BM * ldc;
        f32x4 g[2][2];
#pragma unroll
        for (int bj = 0; bj < 2; ++bj)
#pragma unroll
            for (int n = 0; n < 2; ++n) g[bj][n] = *(const f32x4*)(gv + col0 + bj * HALF + n * 16);
#pragma unroll
        for (int ai = 0; ai < 2; ++ai)
#pragma unroll
            for (int m = 0; m < 4; ++m) { const size_t off = (size_t)(rloc + ai * HALF + m * 16) * ldc + col0;
#pragma unroll
                for (int bj = 0; bj < 2; ++bj)
#pragma unroll
                    for (int n = 0; n < 2; ++n) { const u32x2 b = *(const u32x2*)(bt + off + bj * HALF + n * 16);
                        const f32x4 bs = {__uint_as_float(b.x << 16), __uint_as_float(b.x & 0xffff0000u), __uint_as_float(b.y << 16), __uint_as_float(b.y & 0xffff0000u)};
                        *(f32x4*)(ot + off + bj * HALF + n * 16) = bs + g[bj][n] * acc[ai][bj][m][n]; }
                if (m & 1) asm volatile("" ::: "memory"); }
    }
};

struct EpiNull {
    static constexpr bool PERM = true, AFTER_DRAIN = false;
    __device__ __forceinline__ void operator()(const f32x4 (&acc)[2][2][4][2], const Unit& u, int wr, int wc, int fr, int fq) const {
#pragma unroll
        for (int ai = 0; ai < 2; ++ai)
#pragma unroll
            for (int bj = 0; bj < 2; ++bj)
#pragma unroll
                for (int m = 0; m < 4; ++m)
#pragma unroll
                    for (int n = 0; n < 2; ++n) asm volatile("" :: "v"(acc[ai][bj][m][n]));
    }
};

template <class Epi, class Sched, bool ALIGN_EPI = false, bool SP2 = false>
__device__ __forceinline__ void gemm_phase(PG8_LAS unsigned char* lds, const Gemm g, const Sched& S, const Epi& E) {
    int tid_ = threadIdx.x; asm volatile("" : "+v"(tid_));
    const int tid = tid_, wid = __builtin_amdgcn_readfirstlane(tid >> 6), lane = tid & 63, wr = wid >> 2, wc = wid & 3, fr = lane & 15, fq = lane >> 4;
    const int K = g.K, nt = K / BK;
    unsigned voffA[2], voffB[2];
#pragma unroll
    for (int i = 0; i < 2; ++i) { int R, C; stage_rc(tid * 16 + i * 8192, R, C); const int Rb = Epi::PERM ? ((R & ~31) + perm32(R & 31)) : R;
        voffA[i] = g.a_tiled ? (unsigned)(R * BK + C) * 2u : (unsigned)(R * K + C) * 2u; voffB[i] = (unsigned)(Rb * K + C) * 2u; }
    const size_t kstep = (size_t)(BK * 2);
    const size_t hstep = (size_t)HALF * K * 2;
    const size_t tstep = 2 * hstep;
    const size_t kstepA = g.a_tiled ? (size_t)(BM * BK * 2) : kstep, hstepA = g.a_tiled ? (size_t)(HALF * BK * 2) : hstep, tstepA = g.a_tiled ? (size_t)(K / BK) * (BM * BK * 2) : tstep;
    const unsigned ldsw = (unsigned)wid * 1024u;
    const int aoff = lds_byte(wr * 64 + fr, fq * 8), boff = lds_byte(wc * 32 + fr, fq * 8);
#define PG8_SA(b, h) (((b) * 2 + (h)) * HTB)
#define PG8_SB(b, h) ((4 + (b) * 2 + (h)) * HTB)
#define PG8_STAGE(bufoff, gbase, voff) do { _Pragma("unroll") for (int _i = 0; _i < 2; ++_i) \
        __builtin_amdgcn_global_load_lds((const unsigned*)((const char*)(gbase) + (voff)[_i]), (PG8_LAS unsigned*)(lds + (bufoff) + ldsw + _i * 8192), 16, 0, 0); } while (0)
#define PG8_LDA(dst, b, h) do { _Pragma("unroll") for (int m = 0; m < 4; ++m) _Pragma("unroll") for (int k = 0; k < 2; ++k) dst[m][k] = *(const PG8_LAS bf16x8*)(lds + PG8_SA(b, h) + aoff + m * 2048 + k * 1024); } while (0)
#define PG8_LDB(dst, b, h) do { _Pragma("unroll") for (int n = 0; n < 2; ++n) _Pragma("unroll") for (int k = 0; k < 2; ++k) dst[n][k] = *(const PG8_LAS bf16x8*)(lds + PG8_SB(b, h) + boff + n * 2048 + k * 1024); } while (0)
#define PG8_MMA(ai, bj, At, Bt) do { __builtin_amdgcn_s_setprio(1); _Pragma("unroll") for (int m = 0; m < 4; ++m) _Pragma("unroll") for (int n = 0; n < 2; ++n) _Pragma("unroll") for (int k = 0; k < 2; ++k) \
        acc[ai][bj][m][n] = __builtin_amdgcn_mfma_f32_16x16x32_bf16(Bt[n][k], At[m][k], acc[ai][bj][m][n], 0, 0, 0); __builtin_amdgcn_s_setprio(0); } while (0)
#define PG8_WAIT_V(n) asm volatile("s_waitcnt vmcnt(" #n ")" ::: "memory")
#define PG8_WAIT_L(n) asm volatile("s_waitcnt lgkmcnt(" #n ")" ::: "memory")
#define PG8_BAR __builtin_amdgcn_s_barrier()
#define PG8_SCHED __builtin_amdgcn_sched_barrier(0)
    Unit cur, nxt; int ui = 0;
    if (!S.next(0, cur)) return;
    f32x4 acc[2][2][4][2];
#pragma unroll
    for (int a = 0; a < 2; ++a)
#pragma unroll
        for (int b = 0; b < 2; ++b)
#pragma unroll
            for (int m = 0; m < 4; ++m)
#pragma unroll
                for (int n = 0; n < 2; ++n) acc[a][b][m][n] = (f32x4){0.f, 0.f, 0.f, 0.f};
    bf16x8 At[4][2], B0[2][2], B1[2][2];
    const char* cA = (const char*)g.A + (size_t)cur.pm * tstepA; const char* cB = (const char*)g.Bt + (size_t)cur.pn * tstep;
    S.a_ready(cur);
    if constexpr (SP2) {
        PG8_STAGE(PG8_SB(0, 0), cB, voffB); PG8_STAGE(PG8_SB(0, 1), cB + hstep, voffB); PG8_STAGE(PG8_SA(0, 0), cA, voffA); PG8_STAGE(PG8_SA(0, 1), cA + hstepA, voffA);
        if (wr == 1) PG8_BAR;
        PG8_WAIT_V(2); PG8_BAR;
        PG8_STAGE(PG8_SB(1, 0), cB + kstep, voffB); PG8_STAGE(PG8_SA(1, 0), cA + kstepA, voffA); PG8_STAGE(PG8_SB(1, 1), cB + hstep + kstep, voffB);
        PG8_WAIT_V(6); PG8_BAR;
    } else {
        PG8_STAGE(PG8_SB(0, 0), cB, voffB); PG8_STAGE(PG8_SA(0, 0), cA, voffA); PG8_STAGE(PG8_SB(0, 1), cB + hstep, voffB); PG8_STAGE(PG8_SA(0, 1), cA + hstepA, voffA);
        if (wr == 1) PG8_BAR;
        PG8_WAIT_V(4); PG8_BAR;
        PG8_STAGE(PG8_SB(1, 0), cB + kstep, voffB); PG8_STAGE(PG8_SA(1, 0), cA + kstepA, voffA); PG8_STAGE(PG8_SB(1, 1), cB + hstep + kstep, voffB);
        PG8_WAIT_V(6); PG8_BAR;
    }
    for (;;) {
        const bool has_next = S.next(ui + 1, nxt);
        const char* nA = has_next ? (const char*)g.A + (size_t)nxt.pm * tstepA : cA; const char* nB = has_next ? (const char*)g.Bt + (size_t)nxt.pn * tstep : cB;
        for (int t = 0; t < nt; t += 2) {
            const bool last = (t == nt - 2);
            const char* a1 = cA + (size_t)(t + 1) * kstepA;
            const char* a2 = last ? nA : cA + (size_t)(t + 2) * kstepA; const char* b2 = last ? nB : cB + (size_t)(t + 2) * kstep;
            const char* a3 = a2 + kstepA; const char* b3 = b2 + kstep;
            if (last && has_next) S.a_ready(nxt);
            if constexpr (SP2) {
            PG8_LDB(B0, 0, 0); PG8_LDB(B1, 0, 1); PG8_SCHED; PG8_LDA(At, 0, 0); PG8_STAGE(PG8_SA(1, 1), a1 + hstepA, voffA);
            PG8_WAIT_V(8); PG8_WAIT_L(0); PG8_BAR; PG8_MMA(0, 0, At, B0); PG8_MMA(0, 1, At, B1); PG8_BAR; PG8_SCHED;
            PG8_LDA(At, 0, 1); PG8_STAGE(PG8_SB(0, 0), b2, voffB); PG8_STAGE(PG8_SB(0, 1), b2 + hstep, voffB); PG8_STAGE(PG8_SA(0, 0), a2, voffA);
            PG8_WAIT_V(8); PG8_WAIT_L(0); PG8_BAR; PG8_MMA(1, 0, At, B0); PG8_MMA(1, 1, At, B1); PG8_BAR; PG8_SCHED;
            PG8_LDB(B0, 1, 0); PG8_LDB(B1, 1, 1); PG8_SCHED; PG8_LDA(At, 1, 0); PG8_STAGE(PG8_SA(0, 1), a2 + hstepA, voffA);
            PG8_WAIT_V(8); PG8_WAIT_L(0); PG8_BAR; PG8_MMA(0, 0, At, B0); PG8_MMA(0, 1, At, B1); PG8_BAR; PG8_SCHED;
            PG8_LDA(At, 1, 1); PG8_STAGE(PG8_SB(1, 0), b3, voffB); PG8_STAGE(PG8_SB(1, 1), b3 + hstep, voffB); PG8_STAGE(PG8_SA(1, 0), a3, voffA);
            PG8_WAIT_V(8); PG8_WAIT_L(0); PG8_BAR; PG8_MMA(1, 0, At, B0); PG8_MMA(1, 1, At, B1); PG8_BAR; PG8_SCHED;
            } else {
            PG8_LDB(B0, 0, 0); PG8_SCHED; PG8_LDA(At, 0, 0); PG8_STAGE(PG8_SA(1, 1), a1 + hstepA, voffA);
            PG8_WAIT_L(8); PG8_BAR; PG8_WAIT_L(0); PG8_MMA(0, 0, At, B0); PG8_BAR; PG8_SCHED;
            PG8_LDB(B1, 0, 1); PG8_STAGE(PG8_SB(0, 0), b2, voffB);
            PG8_BAR; PG8_WAIT_L(0); PG8_MMA(0, 1, At, B1); PG8_BAR;
            PG8_LDA(At, 0, 1); PG8_STAGE(PG8_SA(0, 0), a2, voffA);
            PG8_BAR; PG8_WAIT_L(0); PG8_MMA(1, 0, At, B0); PG8_BAR; PG8_SCHED;
            PG8_STAGE(PG8_SB(0, 1), b2 + hstep, voffB);
            PG8_WAIT_V(6); PG8_BAR; PG8_MMA(1, 1, At, B1); PG8_BAR;
            PG8_LDB(B0, 1, 0); PG8_SCHED; PG8_LDA(At, 1, 0); PG8_STAGE(PG8_SA(0, 1), a2 + hstepA, voffA);
            PG8_WAIT_L(8); PG8_BAR; PG8_WAIT_L(0); PG8_MMA(0, 0, At, B0); PG8_BAR; PG8_SCHED;
            PG8_LDB(B1, 1, 1); PG8_STAGE(PG8_SB(1, 0), b3, voffB);
            PG8_BAR; PG8_WAIT_L(0); PG8_MMA(0, 1, At, B1); PG8_BAR;
            PG8_LDA(At, 1, 1); PG8_STAGE(PG8_SA(1, 0), a3, voffA);
            PG8_BAR; PG8_WAIT_L(0); PG8_MMA(1, 0, At, B0); PG8_BAR; PG8_SCHED;
            PG8_STAGE(PG8_SB(1, 1), b3 + hstep, voffB);
            PG8_WAIT_V(6); PG8_BAR; PG8_MMA(1, 1, At, B1); PG8_BAR;
            }
        }
        if constexpr (ALIGN_EPI) { if (wr == 0) PG8_BAR; }
        if constexpr (!Epi::AFTER_DRAIN) { E(acc, cur, wr, wc, fr, fq); S.done(cur); }
        if (!has_next) break;
#pragma unroll
        for (int a = 0; a < 2; ++a)
#pragma unroll
            for (int b = 0; b < 2; ++b)
#pragma unroll
                for (int m = 0; m < 4; ++m)
#pragma unroll
                    for (int n = 0; n < 2; ++n) acc[a][b][m][n] = (f32x4){0.f, 0.f, 0.f, 0.f};
        cur = nxt; cA = nA; cB = nB; ++ui;
        if constexpr (ALIGN_EPI) { if (wr == 1) PG8_BAR; }
    }
    PG8_WAIT_V(0);
    if constexpr (!ALIGN_EPI) { if (wr == 0) PG8_BAR; }
    PG8_BAR;
    if constexpr (Epi::AFTER_DRAIN) { E.fused(acc, cur, wr, wc, fr, fq, lds, wid, lane); S.done(cur); }
#undef PG8_SA
#undef PG8_SB
#undef PG8_STAGE
#undef PG8_LDA
#undef PG8_LDB
#undef PG8_MMA
#undef PG8_WAIT_V
#undef PG8_WAIT_L
#undef PG8_BAR
#undef PG8_SCHED
}
}
namespace att {
#ifdef ATT_NOMASK
constexpr bool defined_NOMASK = true;
#else
constexpr bool defined_NOMASK = false;
#endif
typedef unsigned short bf16_t;
using bf16x8 = __attribute__((ext_vector_type(8))) short;
using s16x4  = __attribute__((ext_vector_type(4))) short;
using f32x16 = __attribute__((ext_vector_type(16))) float;
using u32x4  = __attribute__((ext_vector_type(4))) unsigned;
constexpr int KVBLK = 64;
constexpr int SHM_V = 16384, SHM_K = 16384;
constexpr int LDS_WS = 2 * SHM_V + 2 * SHM_K;
constexpr int LDS_X = LDS_WS + 8 * 64 * 4;
constexpr int LDS_MISC = LDS_X + 4 * 32 * 128 * 4;
constexpr int LDS_BYTES = LDS_MISC + 64;
constexpr float LOG2E = 1.4426950408889634f;
#define GASQ __attribute__((address_space(1)))
#define KSWZ(row, colB) ((row) * 256 + ((colB) ^ (((row) & 7) << 4)))
#define SBAR() __builtin_amdgcn_sched_barrier(0)
__device__ __forceinline__ int crow(int r, int hi) { return (r & 3) + 8 * (r >> 2) + 4 * hi; }
__device__ __forceinline__ unsigned cvtpk(float lo, float hi) { unsigned r; asm volatile("v_cvt_pk_bf16_f32 %0, %1, %2" : "=v"(r) : "v"(lo), "v"(hi)); return r; }

#ifndef ATT_SDEPTH0
#define ATT_SDEPTH0 2
#endif
#ifndef ATT_QLDS0
#define ATT_QLDS0 1
#endif
template <int MODE> struct Cfg {
    static constexpr float SCALE = (MODE == 0) ? 0.088388347648318440f : 0.125f;
    static constexpr float C = SCALE * LOG2E;
    static constexpr float THRS = 8.f / SCALE;
    static constexpr int ND0 = (MODE == 0) ? 8 : 4;
    static constexpr int SDEPTH = (MODE == 0) ? ATT_SDEPTH0 : 2;
    static constexpr bool QLDS = (MODE == 0) && (ATT_QLDS0 != 0);
};

template <int MODE>
__device__ __forceinline__ void partialSM(f32x16& p0, f32x16& p1, float& m_reg, float& mn, float& alpha) {
  constexpr float C = Cfg<MODE>::C;
  float pmax = p0[0];
#pragma unroll
  for (int r = 1; r < 16; ++r) pmax = fmaxf(pmax, p0[r]);
#pragma unroll
  for (int r = 0; r < 16; ++r) pmax = fmaxf(pmax, p1[r]);
  { auto rr = __builtin_amdgcn_permlane32_swap(__float_as_uint(pmax), __float_as_uint(pmax), false, false);
    pmax = fmaxf(__uint_as_float(rr[0]), __uint_as_float(rr[1])); }
  if (__builtin_expect(__all(pmax - m_reg <= Cfg<MODE>::THRS), 1)) { mn = m_reg; alpha = 1.f; }
  else { mn = fmaxf(m_reg, pmax); alpha = __builtin_amdgcn_exp2f((m_reg - mn) * C); m_reg = mn; }
  const float mnC = -mn * C;
#pragma unroll
  for (int r = 0; r < 16; ++r) p0[r] = fmaf(p0[r], C, mnC);
#pragma unroll
  for (int r = 0; r < 16; ++r) p1[r] = fmaf(p1[r], C, mnC);
#pragma unroll
  for (int r = 0; r < 16; ++r) p0[r] = __builtin_amdgcn_exp2f(p0[r]);
}
__device__ __forceinline__ void finishSM(f32x16& p0, f32x16& p1, float alpha, float& l_reg, bf16x8& pa0, bf16x8& pa1, bf16x8& pa2, bf16x8& pa3) {
#pragma unroll
  for (int r = 0; r < 16; ++r) p1[r] = __builtin_amdgcn_exp2f(p1[r]);
  float ps = 0;
#pragma unroll
  for (int r = 0; r < 16; ++r) ps += p0[r];
#pragma unroll
  for (int r = 0; r < 16; ++r) ps += p1[r];
  { auto rr = __builtin_amdgcn_permlane32_swap(__float_as_uint(ps), __float_as_uint(ps), false, false);
    ps = __uint_as_float(rr[0]) + __uint_as_float(rr[1]); }
  l_reg = l_reg * alpha + ps;
#define PK4(P, BASE, OUT) do { unsigned a0 = cvtpk(P[BASE + 0], P[BASE + 1]), a1 = cvtpk(P[BASE + 2], P[BASE + 3]);   \
    unsigned b0 = cvtpk(P[BASE + 4], P[BASE + 5]), b1 = cvtpk(P[BASE + 6], P[BASE + 7]);                              \
    auto r0 = __builtin_amdgcn_permlane32_swap(a0, b0, false, false); auto r1 = __builtin_amdgcn_permlane32_swap(a1, b1, false, false); \
    u32x4 w = {r0[0], r1[0], r0[1], r1[1]}; OUT = *reinterpret_cast<bf16x8*>(&w); } while (0)
  PK4(p0, 0, pa0); PK4(p0, 8, pa1); PK4(p1, 0, pa2); PK4(p1, 8, pa3);
#undef PK4
}
template <int MODE, bool QLDS>
__device__ __forceinline__ void qkt(f32x16& p0, f32x16& p1, const char* Ks, const bf16x8* qr, const char* qs, int r32, int hi, int comp) {
  p0 = f32x16{}; p1 = f32x16{};
  int rb = r32; asm volatile("" : "+v"(rb));
  const int swz = (rb & 7) << 4, rowb = rb * 256 + comp * 128;
  const char* a0 = Ks + rowb + ((0 * 32 + hi * 16) ^ swz); const char* a1 = Ks + rowb + ((1 * 32 + hi * 16) ^ swz);
  const char* a2 = Ks + rowb + ((2 * 32 + hi * 16) ^ swz); const char* a3 = Ks + rowb + ((3 * 32 + hi * 16) ^ swz);
#pragma unroll
  for (int d0 = 0; d0 < Cfg<MODE>::ND0; ++d0) { const int dl = d0 & 3, dh = d0 >> 2; const char* ap = (dl == 0 ? a0 : dl == 1 ? a1 : dl == 2 ? a2 : a3) + dh * 128;
    bf16x8 b0 = *reinterpret_cast<const bf16x8*>(ap);
    bf16x8 b1 = *reinterpret_cast<const bf16x8*>(ap + 8192);
    bf16x8 q; if constexpr (QLDS) q = *reinterpret_cast<const bf16x8*>(qs + d0 * 1024); else q = qr[d0];
    p0 = __builtin_amdgcn_mfma_f32_32x32x16_bf16(b0, q, p0, 0, 0, 0);
    p1 = __builtin_amdgcn_mfma_f32_32x32x16_bf16(b1, q, p1, 0, 0, 0); }
}
__device__ __forceinline__ int v_st(int k, int c) { const int kk = (k & ~0xC) | ((k & 4) << 1) | ((k & 8) >> 1); return ((kk >> 3) * 4 + (c >> 5)) * 512 + ((kk & 7) * 32 + (c & 31)) * 2; }
__device__ __forceinline__ int v_rd_base(int lane) { return ((lane & 3) << 3) | (((lane >> 2) & 3) << 6) | (((lane >> 4) & 1) << 5) | (((lane >> 5) & 1) << 8); }
constexpr int v_rd_off(int d0, int ks, int half) { return d0 * 512 + ks * 4096 + half * 2048; }
template <int OFF> __device__ __forceinline__ s16x4 tr_read(int vb) {
  s16x4 r; asm volatile("ds_read_b64_tr_b16 %0, %1 offset:%2" : "=&v"(r) : "v"(vb), "i"(OFF) : "memory"); return r;
}
template <int D0> __device__ __forceinline__ void pv_one(f32x16& od, int vb, bf16x8 pa0, bf16x8 pa1, bf16x8 pa2, bf16x8 pa3) {
  const s16x4 l0 = tr_read<v_rd_off(D0, 0, 0)>(vb), h0 = tr_read<v_rd_off(D0, 0, 1)>(vb), l1 = tr_read<v_rd_off(D0, 1, 0)>(vb), h1 = tr_read<v_rd_off(D0, 1, 1)>(vb);
  const s16x4 l2 = tr_read<v_rd_off(D0, 2, 0)>(vb), h2 = tr_read<v_rd_off(D0, 2, 1)>(vb), l3 = tr_read<v_rd_off(D0, 3, 0)>(vb), h3 = tr_read<v_rd_off(D0, 3, 1)>(vb);
  asm volatile("s_waitcnt lgkmcnt(0)" ::: "memory"); SBAR();
#define PK(L, H) (bf16x8){L[0], L[1], L[2], L[3], H[0], H[1], H[2], H[3]}
  od = __builtin_amdgcn_mfma_f32_32x32x16_bf16(pa0, PK(l0, h0), od, 0, 0, 0);
  od = __builtin_amdgcn_mfma_f32_32x32x16_bf16(pa1, PK(l1, h1), od, 0, 0, 0);
  od = __builtin_amdgcn_mfma_f32_32x32x16_bf16(pa2, PK(l2, h2), od, 0, 0, 0);
  od = __builtin_amdgcn_mfma_f32_32x32x16_bf16(pa3, PK(l3, h3), od, 0, 0, 0);
#undef PK
}
__device__ __forceinline__ void pv_d0(f32x16* o, int vb, bf16x8 pa0, bf16x8 pa1, bf16x8 pa2, bf16x8 pa3) {
  pv_one<0>(o[0], vb, pa0, pa1, pa2, pa3); pv_one<1>(o[1], vb, pa0, pa1, pa2, pa3); pv_one<2>(o[2], vb, pa0, pa1, pa2, pa3); pv_one<3>(o[3], vb, pa0, pa1, pa2, pa3);
}

struct UnitArgs {
    const bf16_t* Qb; int ldq;
    const bf16_t* Kh; const bf16_t* Vh;
    bf16_t* Ob; int ldo;
    int NT;
    int jwin, wadd;
    int masked, t0;
    float sinkl2;
    float lam;
    const float* subg;
    const float* qg;
    const float* ropeT;
    int rope;
};

template <int MODE>
__device__ __forceinline__ void attn_unit(const UnitArgs& A, char* lds) {
  constexpr float C = Cfg<MODE>::C; constexpr int ND0 = Cfg<MODE>::ND0;
  int tid_ = threadIdx.x; asm volatile("" : "+v"(tid_));
  const int tid = tid_, wid = tid >> 6, lane = tid & 63, r32 = lane & 31, hi = lane >> 5;
  const int wq = (MODE == 0) ? wid : (wid & 3), comp = (MODE == 0) ? 0 : (wid >> 2);
  char* V_lds = lds; char* K_lds = lds + 2 * SHM_V;
  float* ws = (float*)(lds + LDS_WS) + wid * 64; float* li_l = ws; float* al_l = ws + 32;
  constexpr bool QLDS = Cfg<MODE>::QLDS;
  __syncthreads();
  float m_reg = -1e30f, l_reg = 0; f32x16 o[4] = {}; bf16x8 qr[QLDS ? 1 : ND0];
  char* qs = lds + LDS_X + wid * 8192 + lane * 16;
  const bf16_t* Qw = A.Qb + (long)(wq * 32 + r32) * A.ldq + comp * 64 + hi * 8;
  const int sr = tid >> 4, sc = (tid & 15) * 8, vst0 = v_st(sr, sc), vst1 = v_st(32 + sr, sc);
  const int vb0 = (int)(uintptr_t)V_lds + v_rd_base(lane);
  const unsigned loff0 = (unsigned)(sr * 128 + sc) * 2u, loff1 = loff0 + 32u * 256u;
  const bf16_t* Kh = A.Kh; const bf16_t* Vh = A.Vh; const int NT = A.NT, jwin = A.jwin, wadd = A.wadd;
  constexpr int SDEPTH = Cfg<MODE>::SDEPTH;
  struct { bf16x8 vs0, vs1, ks0, ks1; } sr_[SDEPTH];
#define KOFF(j) (64 * (j) + (((j) >= jwin) ? wadd : 0))
#define SLOAD(i, k0) do { const size_t _kb = (size_t)(k0) * 256; const char* _vp = (const char*)Vh + _kb; const char* _kp = (const char*)Kh + _kb; \
    sr_[i].vs0 = *(const GASQ bf16x8*)(_vp + loff0); sr_[i].vs1 = *(const GASQ bf16x8*)(_vp + loff1); \
    sr_[i].ks0 = *(const GASQ bf16x8*)(_kp + loff0); sr_[i].ks1 = *(const GASQ bf16x8*)(_kp + loff1); } while (0)
#define SWRITE(b, i) do { *(bf16x8*)(V_lds + (b) * SHM_V + vst0) = sr_[i].vs0;          \
    *(bf16x8*)(V_lds + (b) * SHM_V + vst1) = sr_[i].vs1; const int kc = sc * 2;               \
    *(bf16x8*)(K_lds + (b) * SHM_K + KSWZ(sr, kc)) = sr_[i].ks0;                       \
    *(bf16x8*)(K_lds + (b) * SHM_K + KSWZ(32 + sr, kc)) = sr_[i].ks1; } while (0)
#define SWAIT() do { if constexpr (SDEPTH == 2) asm volatile("s_waitcnt vmcnt(4)" ::: "memory"); else asm volatile("s_waitcnt vmcnt(0)" ::: "memory"); } while (0)
#define RESC(a) do { if (__any((a) < 1.f)) { if (hi == 0) al_l[r32] = (a); asm volatile("s_waitcnt lgkmcnt(0)" ::: "memory"); \
    _Pragma("unroll") for (int d = 0; d < 4; ++d) _Pragma("unroll") for (int r = 0; r < 16; ++r) o[d][r] *= al_l[crow(r, hi)]; } } while (0)
#define MASKT(P0, P1, j) do { if (MODE == 0 && !defined_NOMASK && A.masked && (j) >= jwin) { const int kp0 = KOFF(j) - 512, qw0 = A.t0 + wq * 32; \
    if (kp0 < qw0 + 31 - 128 || kp0 + 63 > qw0 + 128) { const int dkb = kp0 - qw0 - r32 + 4 * hi + 128; \
      _Pragma("unroll") for (int r = 0; r < 16; ++r) { const int cr = (r & 3) + 8 * (r >> 2); if ((unsigned)(dkb + cr) > 256u) P0[r] = -1e30f; if ((unsigned)(dkb + cr + 32) > 256u) P1[r] = -1e30f; } } } } while (0)
  constexpr int SE = 0, SO = SDEPTH - 1;
  {
    typedef float f32x4q __attribute__((ext_vector_type(4)));
    float x[ND0][8]; float ss = 0.f;
#pragma unroll
    for (int d0 = 0; d0 < ND0; ++d0) { const u32x4 raw = *reinterpret_cast<const u32x4*>(Qw + d0 * 16);
#pragma unroll
      for (int e = 0; e < 4; ++e) { x[d0][2 * e] = __uint_as_float(raw[e] << 16); x[d0][2 * e + 1] = __uint_as_float(raw[e] & 0xffff0000u); }
#pragma unroll
      for (int j = 0; j < 8; ++j) ss += x[d0][j] * x[d0][j]; }
    ss += __shfl_xor(ss, 32);
    const float rstd = __builtin_amdgcn_rsqf(ss * (1.f / (16.f * ND0)) + 1e-6f);
#pragma unroll
    for (int d0 = 0; d0 < ND0; ++d0) { const f32x4q g0 = *(const GASQ f32x4q*)(A.qg + d0 * 16 + hi * 8), g1 = *(const GASQ f32x4q*)(A.qg + d0 * 16 + hi * 8 + 4);
      x[d0][0] *= rstd * g0.x; x[d0][1] *= rstd * g0.y; x[d0][2] *= rstd * g0.z; x[d0][3] *= rstd * g0.w; x[d0][4] *= rstd * g1.x; x[d0][5] *= rstd * g1.y; x[d0][6] *= rstd * g1.z; x[d0][7] *= rstd * g1.w; }
    if (A.rope) {
      const int t = A.t0 + wq * 32 + r32;
      if (MODE == 0) {
#pragma unroll
        for (int ax = 0; ax < 2; ++ax) { const int pos = ax ? (t & 63) : (t >> 6);
#pragma unroll
          for (int e = 0; e < 2; ++e) { const float* cp = A.ropeT + pos * 32 + 16 * e + 8 * hi;
            const f32x4q c0 = *(const GASQ f32x4q*)(cp), c1 = *(const GASQ f32x4q*)(cp + 4), s0 = *(const GASQ f32x4q*)(cp + 2048), s1 = *(const GASQ f32x4q*)(cp + 2048 + 4);
            const float cs[8] = {c0.x, c0.y, c0.z, c0.w, c1.x, c1.y, c1.z, c1.w}, sn[8] = {s0.x, s0.y, s0.z, s0.w, s1.x, s1.y, s1.z, s1.w};
            const int d1 = 4 * ax + e, d2 = d1 + 2;
#pragma unroll
            for (int j = 0; j < 8; ++j) { const float x1 = x[d1 % ND0][j], x2 = x[d2 % ND0][j]; x[d1 % ND0][j] = x1 * cs[j] - x2 * sn[j]; x[d2 % ND0][j] = x2 * cs[j] + x1 * sn[j]; } } }
      } else {
#pragma unroll
        for (int ax = 0; ax < 2; ++ax) { const int pos = ax ? (t & 63) : (t >> 6); const float* cp = A.ropeT + 4096 + pos * 16 + 8 * hi;
          const f32x4q c0 = *(const GASQ f32x4q*)(cp), c1 = *(const GASQ f32x4q*)(cp + 4), s0 = *(const GASQ f32x4q*)(cp + 1024), s1 = *(const GASQ f32x4q*)(cp + 1024 + 4);
          const float cs[8] = {c0.x, c0.y, c0.z, c0.w, c1.x, c1.y, c1.z, c1.w}, sn[8] = {s0.x, s0.y, s0.z, s0.w, s1.x, s1.y, s1.z, s1.w};
          const int d1 = (2 * ax) % ND0, d2 = (2 * ax + 1) % ND0;
#pragma unroll
          for (int j = 0; j < 8; ++j) { const float x1 = x[d1][j], x2 = x[d2][j]; x[d1][j] = x1 * cs[j] - x2 * sn[j]; x[d2][j] = x2 * cs[j] + x1 * sn[j]; } }
      }
    }
#pragma unroll
    for (int d0 = 0; d0 < ND0; ++d0) { u32x4 w = {cvtpk(x[d0][0], x[d0][1]), cvtpk(x[d0][2], x[d0][3]), cvtpk(x[d0][4], x[d0][5]), cvtpk(x[d0][6], x[d0][7])};
      if constexpr (QLDS) *reinterpret_cast<u32x4*>(qs + d0 * 1024) = w; else qr[d0] = *reinterpret_cast<bf16x8*>(&w); }
  }
  f32x16 pA0, pA1, pB0, pB1; float mnA, mnB, alA, alB; bf16x8 pa0, pa1, pa2, pa3;
  SLOAD(SE, KOFF(0)); asm volatile("s_waitcnt vmcnt(0)" ::: "memory"); SWRITE(0, SE); __syncthreads();
  qkt<MODE, QLDS>(pA0, pA1, K_lds, qr, qs, r32, hi, comp); MASKT(pA0, pA1, 0); partialSM<MODE>(pA0, pA1, m_reg, mnA, alA);
  SLOAD(SO, KOFF(1)); if constexpr (SDEPTH == 2) { if (2 < NT) SLOAD(SE, KOFF(2)); }
  SWAIT(); SWRITE(1, SO); __syncthreads();
  for (int j = 1; j + 1 < NT; j += 2) {
    SBAR(); qkt<MODE, QLDS>(pB0, pB1, K_lds + SHM_K, qr, qs, r32, hi, comp);
    finishSM(pA0, pA1, alA, l_reg, pa0, pa1, pa2, pa3); SBAR();
    SLOAD(SO, KOFF(j + SDEPTH)); SBAR();
    pv_d0(o, vb0, pa0, pa1, pa2, pa3); MASKT(pB0, pB1, j); partialSM<MODE>(pB0, pB1, m_reg, mnB, alB);
    __syncthreads(); SWAIT(); SWRITE(0, SE);
    RESC(alB); __syncthreads();
    SBAR(); qkt<MODE, QLDS>(pA0, pA1, K_lds, qr, qs, r32, hi, comp);
    finishSM(pB0, pB1, alB, l_reg, pa0, pa1, pa2, pa3); SBAR();
    if (SDEPTH == 1 || j + 3 < NT) SLOAD(SE, KOFF(j + 1 + SDEPTH)); SBAR();
    pv_d0(o, vb0 + SHM_V, pa0, pa1, pa2, pa3); MASKT(pA0, pA1, j + 1); partialSM<MODE>(pA0, pA1, m_reg, mnA, alA);
    __syncthreads(); SWAIT(); SWRITE(1, SO);
    RESC(alA); __syncthreads();
  }
  SBAR(); qkt<MODE, QLDS>(pB0, pB1, K_lds + SHM_K, qr, qs, r32, hi, comp);
  finishSM(pA0, pA1, alA, l_reg, pa0, pa1, pa2, pa3); SBAR();
  pv_d0(o, vb0, pa0, pa1, pa2, pa3); MASKT(pB0, pB1, NT - 1); partialSM<MODE>(pB0, pB1, m_reg, mnB, alB);
  __syncthreads(); RESC(alB);
  finishSM(pB0, pB1, alB, l_reg, pa0, pa1, pa2, pa3); SBAR();
  pv_d0(o, vb0 + SHM_V, pa0, pa1, pa2, pa3);
  if (MODE == 0) l_reg += __builtin_amdgcn_exp2f(A.sinkl2 - m_reg * C);
  if (hi == 0) li_l[r32] = l_reg;
  asm volatile("s_waitcnt lgkmcnt(0)" ::: "memory");
  float rli[16];
#pragma unroll
  for (int r = 0; r < 16; ++r) rli[r] = __builtin_amdgcn_rcpf(li_l[crow(r, hi)]);
  bf16_t* Ow = A.Ob + (long)(wq * 32) * A.ldo;
  const int odd = lane & 1;
  int t2_ = threadIdx.x; asm volatile("" : "+v"(t2_));
  const int lane2 = t2_ & 63, r32b = lane2 & 31, hib = lane2 >> 5;
  char* stg = lds + LDS_X + ((MODE == 0) ? (t2_ >> 6) * 8192 : ((t2_ >> 6) & 3) * 16384);
  if (MODE == 0) {
#pragma unroll
    for (int d0 = 0; d0 < 4; ++d0)
#pragma unroll
      for (int rp = 0; rp < 8; ++rp) {
        const float a = o[d0][2 * rp] * rli[2 * rp], b = o[d0][2 * rp + 1] * rli[2 * rp + 1];
        const float send = odd ? a : b; const float recv = __shfl_xor(send, 1);
        const float lo = odd ? recv : a, hh = odd ? b : recv;
        const int row = crow(2 * rp + odd, hib);
        *(unsigned*)(stg + row * 256 + (d0 * 32 + (r32b & ~1)) * 2) = cvtpk(lo, hh);
      }
  } else {
    float* X = (float*)(lds + LDS_X) + wq * (32 * 128);
    if (comp == 1) {
      const float lam = A.lam;
#pragma unroll
      for (int d0 = 0; d0 < 4; ++d0)
#pragma unroll
        for (int r = 0; r < 16; ++r) X[crow(r, hi) * 128 + d0 * 32 + r32] = o[d0][r] * rli[r] * lam;
    }
    __syncthreads();
    if (comp == 0) {
      float rs[16];
#pragma unroll
      for (int r = 0; r < 16; ++r) { float ss = 0.f;
#pragma unroll
        for (int d0 = 0; d0 < 4; ++d0) { const float v = o[d0][r] * rli[r] - X[crow(r, hi) * 128 + d0 * 32 + r32]; o[d0][r] = v; ss += v * v; }
        ss += __shfl_xor(ss, 1); ss += __shfl_xor(ss, 2); ss += __shfl_xor(ss, 4); ss += __shfl_xor(ss, 8); ss += __shfl_xor(ss, 16);
        rs[r] = __builtin_amdgcn_rsqf(ss * (1.f / 128.f) + 1e-6f) * 0.8f; }
      asm volatile("s_waitcnt lgkmcnt(0)" ::: "memory");
#pragma unroll
      for (int d0 = 0; d0 < 4; ++d0) { const float g = A.subg[d0 * 32 + r32];
#pragma unroll
        for (int rp = 0; rp < 8; ++rp) {
          const float a = o[d0][2 * rp] * rs[2 * rp] * g, b = o[d0][2 * rp + 1] * rs[2 * rp + 1] * g;
          const float send = odd ? a : b; const float recv = __shfl_xor(send, 1);
          const float lo = odd ? recv : a, hh = odd ? b : recv;
          const int row = crow(2 * rp + odd, hib);
          *(unsigned*)(stg + row * 256 + (d0 * 32 + (r32b & ~1)) * 2) = cvtpk(lo, hh);
        } }
    }
  }
  if (MODE == 0 || comp == 0) {
    asm volatile("s_waitcnt lgkmcnt(0)" ::: "memory");
    const int srow = lane2 >> 4, sch = lane2 & 15;
#pragma unroll
    for (int i = 0; i < 8; ++i) { const int row = srow + 4 * i; const u32x4 v = *(const u32x4*)(stg + row * 256 + sch * 16);
      *(u32x4*)(Ow + (long)row * A.ldo + sch * 8) = v; }
  }
#undef KOFF
#undef SLOAD
#undef SWRITE
#undef SWAIT
#undef RESC
#undef MASKT
}
#undef KSWZ
#undef GASQ
#undef SBAR
}

#define GAS __attribute__((address_space(1)))
#define LAS __attribute__((address_space(3)))
typedef unsigned short bf16;
typedef unsigned v4u __attribute__((ext_vector_type(4)));
typedef float f32x4 __attribute__((ext_vector_type(4)));
typedef short bf16x8 __attribute__((ext_vector_type(8)));
typedef GAS unsigned gu32;
typedef GAS unsigned long long gu64;
#define RLX_AGENT __ATOMIC_RELAXED, __HIP_MEMORY_SCOPE_AGENT
#define LDS_WAIT() asm volatile("s_waitcnt lgkmcnt(0)" ::: "memory")
#define VM_WAIT() asm volatile("s_waitcnt vmcnt(0)" ::: "memory")
__device__ __forceinline__ unsigned long long rt() { return __builtin_amdgcn_s_memrealtime(); }
__device__ __forceinline__ unsigned f2bf(float f) { unsigned u = __builtin_bit_cast(unsigned, f); return (u + 0x7fffu + ((u >> 16) & 1u)) >> 16; }
__device__ __forceinline__ unsigned pk2(float lo, float hi) { return f2bf(lo) | (f2bf(hi) << 16); }

#define XB_TMO      128
#define XB_XCNT(j)  (256  + 64 * (j))
#define XB_XSUB(j)  (1280 + 64 * (j))
#define XB_XGEN(j)  (2304 + 64 * (j))
#define XB_TOP      3328
#define XB_TOPGEN   3392
#define XCD_BAR_WORDS 3456
#define XB_SPIN_CAP (1u << 18)

__device__ __forceinline__ unsigned xb_ld(unsigned* p)              { return __hip_atomic_load(p, __ATOMIC_RELAXED, __HIP_MEMORY_SCOPE_AGENT); }
__device__ __forceinline__ unsigned xb_add(unsigned* p, unsigned v) { return __hip_atomic_fetch_add(p, v, __ATOMIC_RELAXED, __HIP_MEMORY_SCOPE_AGENT); }
__device__ __forceinline__ unsigned xb_xcc_id() { return (unsigned)__builtin_amdgcn_s_getreg((3 << 11) | 20) & 0xFu; }
#define XB_SPIN(cond, bar) do { unsigned _sp = 0; while (cond) { __builtin_amdgcn_s_sleep(1); \
    if ((++_sp & 255u) == 0u) { if (xb_ld(&(bar)[XB_TMO])) break; if (_sp > XB_SPIN_CAP) { atomicAdd(&(bar)[XB_TMO], 1u); break; } } } } while (0)

struct XcdBarrier {
    unsigned* bar; unsigned x;
    volatile LAS unsigned* st;
};

__device__ __forceinline__ XcdBarrier xcd_barrier_post(unsigned* bar, volatile LAS unsigned* st) {
    XcdBarrier b; b.bar = bar; b.x = xb_xcc_id(); b.st = st;
    if (threadIdx.x == 0) (void)xb_add(&bar[XB_XCNT(b.x)], 1u);
    return b;
}
__device__ __forceinline__ void xcd_barrier_complete(unsigned* bar, unsigned x, unsigned& nloc, unsigned& nx) {
    const unsigned G = gridDim.x * gridDim.y * gridDim.z;
    unsigned sum, cnt, mine, sp = 0u;
    for (;;) {
        sum = 0u; cnt = 0u; mine = 0u;
#pragma unroll
        for (unsigned j = 0; j < 16; ++j) { const unsigned c = xb_ld(&bar[XB_XCNT(j)]); sum += c; cnt += (c > 0u) ? 1u : 0u; mine = (j == x) ? c : mine; }
        if (sum == G) break;
        __builtin_amdgcn_s_sleep(1);
        if ((++sp & 255u) == 0u) { if (xb_ld(&bar[XB_TMO])) break; if (sp > XB_SPIN_CAP) { atomicAdd(&bar[XB_TMO], 1u); break; } }
    }
    nloc = mine > 0u ? mine : 1u; nx = cnt > 0u ? cnt : 1u;
}

__device__ __forceinline__ void xcd_barrier(const XcdBarrier& b) {
    asm volatile("s_waitcnt vmcnt(0)" ::: "memory");
    __syncthreads();
    if (threadIdx.x == 0) {
        unsigned* bar = b.bar;
        __builtin_amdgcn_s_waitcnt(0);
        unsigned nloc = b.st[0], nx = b.st[1];
        if (nloc == 0u) { xcd_barrier_complete(bar, b.x, nloc, nx); b.st[0] = nloc; b.st[1] = nx; }
        const unsigned old = xb_add(&bar[XB_XSUB(b.x)], 1u);
        const unsigned gen = old / nloc;
        if (old + 1u == (gen + 1u) * nloc) {
            __builtin_amdgcn_fence(__ATOMIC_RELEASE, "agent");
            asm volatile("s_waitcnt vmcnt(0)" ::: "memory");
            const unsigned og = xb_add(&bar[XB_TOP], 1u);
            const unsigned tg = og / nx;
            if (og + 1u == (tg + 1u) * nx) xb_add(&bar[XB_TOPGEN], 1u);
            else XB_SPIN(xb_ld(&bar[XB_TOPGEN]) == tg, bar);
            __builtin_amdgcn_fence(__ATOMIC_ACQUIRE, "agent");
            xb_add(&bar[XB_XGEN(b.x)], 1u);
            asm volatile("s_waitcnt vmcnt(0)" ::: "memory");
        } else {
            XB_SPIN(xb_ld(&bar[XB_XGEN(b.x)]) == gen, bar);
            __builtin_amdgcn_fence(__ATOMIC_ACQUIRE, "agent");
            asm volatile("s_waitcnt vmcnt(0)" ::: "memory");
        }
    }
    __syncthreads();
}
#ifndef MK_N_LAUNCHES
#define MK_N_LAUNCHES 1
#endif
constexpr int NPH = 9;
constexpr int N_LAUNCHES = MK_N_LAUNCHES;
constexpr int NWAVES = 8;

constexpr int DM = 4096, DIN = 6144, DFF = 16384, NMOD = 6 * DM;
constexpr int NB_P = 16, T_P = 256, NB_S = 8, T_S = 1024, LCTX = 512;
constexpr int M_P = NB_P * T_P, M_S = NB_S * T_S, MTOK = M_P + M_S;
constexpr int KSPLIT = 8;
constexpr int KVL = LCTX + T_S;
constexpr float EPS = 1e-6f;

constexpr size_t MiB = 1u << 20;
constexpr size_t WS_CTL = 0, CTL_ZERO_BYTES = 64 * 1024;
constexpr size_t WS_MODP = 1 * MiB;
constexpr size_t WS_MODF = 8 * MiB;
constexpr size_t WS_ROPE = 9 * MiB;
constexpr size_t WS_WIN = 16 * MiB, WS_WOUT = 64 * MiB, WS_WFC1 = 96 * MiB, WS_WFC2 = 224 * MiB;
constexpr size_t WS_H = 352 * MiB;
constexpr size_t WS_P = 448 * MiB;
constexpr size_t WS_O = 592 * MiB;
constexpr size_t WS_KVL = 688 * MiB, KVL_SZ = (size_t)NB_S * 4 * KVL * 128 * 2;
constexpr size_t WS_KVP = 736 * MiB, KVP_SZ = (size_t)NB_P * 4 * T_P * 128 * 2;
constexpr size_t WS_U = 752 * MiB;
constexpr size_t WS_X1B = 1136 * MiB;
constexpr size_t WS_END = 1232 * MiB;
static_assert(WS_MODP + (size_t)KSPLIT * 9 * NMOD * 4 <= WS_MODF && WS_MODF + (size_t)9 * NMOD * 4 <= WS_WIN, "ws map");
static_assert(KVL_SZ == 12 * MiB && KVP_SZ == 4 * MiB && WS_U + (size_t)MTOK * DFF * 2 == WS_X1B && WS_X1B + (size_t)MTOK * DM * 2 == WS_END, "ws map");
constexpr int CW_Q = 64;
constexpr int CW_BAR = 4096;
static_assert((CW_BAR + 3456) * 4 <= (int)CTL_ZERO_BYTES, "barrier words inside the per-call memset");

constexpr int RING_BYTES = 131072;
constexpr int MISC_OFF = 143360;
constexpr int LDS_BYTES = 147456;
static_assert(att::LDS_BYTES <= MISC_OFF && RING_BYTES <= MISC_OFF && MISC_OFF + 128 <= LDS_BYTES && 8 * 64 * 68 * 4 <= MISC_OFF, "LDS map");

__device__ __forceinline__ float wave_sum(float v) {
#pragma unroll
    for (int o = 1; o < 64; o <<= 1) v += __shfl_xor(v, o);
    return v;
}
__device__ __forceinline__ float bf2f(unsigned short b) { return __uint_as_float(((unsigned)b) << 16); }

__device__ __forceinline__ int fresh_tid() { int t = threadIdx.x; asm volatile("" : "+v"(t)); return t; }
struct Args { const float* in[26]; float* out; unsigned char* ws; int ph_lo, ph_hi; };

constexpr int TR_LDS = 64 * 68 * 4;
__device__ __forceinline__ unsigned cvtpk_rne(float lo, float hi) { unsigned r; asm volatile("v_cvt_pk_bf16_f32 %0, %1, %2" : "=v"(r) : "v"(lo), "v"(hi)); return r; }
__device__ __forceinline__ void p0_transpose_item(const float* W, int K, int N, bf16* WT, LAS float* scr, int item, int lane) {
    const int nblk = N / 64, kb = item / nblk, nb = item - kb * nblk, k0 = 64 * kb, n0 = 64 * nb;
    const int lr = lane >> 4, lc = (lane & 15) * 4;
    const GAS f32x4* src = (const GAS f32x4*)(W + (size_t)(k0 + lr) * N + n0 + lc);
    f32x4 v[16];
#pragma unroll
    for (int i = 0; i < 16; ++i) v[i] = src[(size_t)i * N];
#pragma unroll
    for (int i = 0; i < 16; ++i) { const int k = lr + 4 * i; *(LAS f32x4*)(scr + k * 68 + (lc ^ ((k >> 3) << 2))) = v[i]; }
    LDS_WAIT(); asm volatile("" ::: "memory");
    const int kc = lane & 7, nl = lane >> 3;
#pragma unroll
    for (int j = 0; j < 8; ++j) { const int n = nl + 8 * j; const LAS float* s = scr + (8 * kc) * 68 + (n ^ (kc << 2));
        v4u o; o.x = cvtpk_rne(s[0 * 68], s[1 * 68]); o.y = cvtpk_rne(s[2 * 68], s[3 * 68]); o.z = cvtpk_rne(s[4 * 68], s[5 * 68]); o.w = cvtpk_rne(s[6 * 68], s[7 * 68]);
        *(GAS v4u*)(WT + (size_t)(n0 + n) * K + k0 + 8 * kc) = o; }
    LDS_WAIT(); asm volatile("" ::: "memory");
}
__device__ __forceinline__ void mod_block_item(const Args& a, LAS unsigned char* ldsl, int cc, int kq8, int tid, int lane, int wave) {
    const float* cmat = a.in[6]; const float* cctx = a.in[7]; const float* Wm = a.in[8]; float* part = (float*)(a.ws + WS_MODP);
    f32x4 acc[9];
#pragma unroll
    for (int r = 0; r < 9; ++r) acc[r] = (f32x4){0.f, 0.f, 0.f, 0.f};
    const int krow = kq8 * 512 + wave * 64;
    const GAS f32x4* wp = (const GAS f32x4*)(Wm + (size_t)krow * NMOD + cc * 256) + lane;
    float sv[9];
#pragma unroll
    for (int r = 0; r < 9; ++r) { const float cv = (r < 8) ? cmat[r * DM + krow + lane] : cctx[krow + lane]; sv[r] = cv / (1.f + __expf(-cv)); }
    for (int i0 = 0; i0 < 64; i0 += 16) {
        f32x4 w[16];
#pragma unroll
        for (int i = 0; i < 16; ++i) w[i] = wp[(size_t)(i0 + i) * (NMOD / 4)];
#pragma unroll
        for (int i = 0; i < 16; ++i)
#pragma unroll
            for (int r = 0; r < 9; ++r) { const float s = __uint_as_float(__builtin_amdgcn_readlane(__float_as_uint(sv[r]), i0 + i)); acc[r] += w[i] * s; }
    }
    LAS f32x4* red = (LAS f32x4*)ldsl;
    __syncthreads();
#pragma unroll
    for (int r = 0; r < 9; ++r) red[(wave * 9 + r) * 64 + lane] = acc[r];
    __syncthreads();
    for (int o = tid; o < 9 * 64; o += NWAVES * 64) { const int r = o >> 6, l = o & 63; f32x4 s = red[r * 64 + l];
#pragma unroll
        for (int w2 = 1; w2 < NWAVES; ++w2) s += red[(w2 * 9 + r) * 64 + l];
        *((GAS f32x4*)(part + (size_t)(kq8 * 9 + r) * NMOD + cc * 256) + l) = s; }
    __syncthreads();
}
constexpr int BG_MOD = 64 * KSPLIT, BG_TR = ((DM / 64) * (DM / 64) + (DM / 64) * (DFF / 64) + (DFF / 64) * (DM / 64)) / 8, N_BG = BG_MOD + BG_TR;
#ifndef BG_Q2
#define BG_Q2 1400
#endif
__device__ __forceinline__ void bg_items(const Args& a, LAS unsigned char* ldsl, int lo, int hi, int start, int stride, int tid, int lane, int wave) {
    constexpr int I_OUT = (DM / 64) * (DM / 64), I_FC1 = (DM / 64) * (DFF / 64);
    LAS float* scr = (LAS float*)(ldsl + wave * TR_LDS);
    for (int bi = lo + start; bi < hi; bi += stride) {
        if (bi < BG_MOD) { mod_block_item(a, ldsl, 32 + (bi & 63), bi >> 6, tid, lane, wave); continue; }
        int r = (bi - BG_MOD) * 8 + wave;
        if (r < I_OUT) { p0_transpose_item(a.in[22], DM, DM, (bf16*)(a.ws + WS_WOUT), scr, r, lane); continue; } r -= I_OUT;
        if (r < I_FC1) { p0_transpose_item(a.in[24], DM, DFF, (bf16*)(a.ws + WS_WFC1), scr, r, lane); continue; } r -= I_FC1;
        p0_transpose_item(a.in[25], DFF, DM, (bf16*)(a.ws + WS_WFC2), scr, r, lane);
    }
}

template <int WHICH>
__device__ __forceinline__ void norm_phase(const Args& a, LAS unsigned char* lds, int vcu, int G, int wave) {
    const int tid = fresh_tid(), lane = tid & 63;
    LAS float* Gv = (LAS float*)lds; LAS float* Sv = Gv + DM;
    const float* bmod = a.in[9]; const float* part = (const float*)(a.ws + WS_MODP); float* modf = (float*)(a.ws + WS_MODF);
    const float* gn = WHICH == 0 ? a.in[10] : a.in[23];
    bf16* H = (bf16*)(a.ws + WS_H);
    const int rows_per = (MTOK + G - 1) / G; int m = vcu * rows_per; const int mend = (m + rows_per < MTOK) ? m + rows_per : MTOK;
    while (m < mend) {
        const int r = (m < M_P) ? 8 : (m - M_P) / T_S;
        const int bnd = (m < M_P) ? M_P : M_P + (r + 1) * T_S; const int send = bnd < mend ? bnd : mend;
        __syncthreads();
        for (int c = tid; c < DM; c += NWAVES * 64) {
            float sh, sc;
            if (WHICH == 0) { sh = bmod[c]; sc = bmod[DM + c];
#pragma unroll
                for (int p = 0; p < KSPLIT; ++p) { sh += part[((size_t)p * 9 + r) * NMOD + c]; sc += part[((size_t)p * 9 + r) * NMOD + DM + c]; } }
            else { sh = modf[(size_t)r * NMOD + 3 * DM + c]; sc = modf[(size_t)r * NMOD + 4 * DM + c]; }
            Gv[c] = gn[c] * (1.f + sc); Sv[c] = sh; }
        __syncthreads();
        for (int mm = m + wave; mm < send; mm += NWAVES) {
            if (WHICH == 0) {
                const float* xrow = (mm < M_P) ? a.in[0] + (size_t)mm * DM : a.in[1] + (size_t)(mm - M_P) * DM;
                const GAS f32x4* xr = (const GAS f32x4*)xrow + 2 * lane;
                f32x4 v[16]; float s = 0.f;
#pragma unroll
                for (int j = 0; j < 8; ++j) { v[2 * j] = xr[128 * j]; v[2 * j + 1] = xr[128 * j + 1]; }
#pragma unroll
                for (int j = 0; j < 16; ++j) s += (v[j].x * v[j].x + v[j].y * v[j].y) + (v[j].z * v[j].z + v[j].w * v[j].w);
                const float rstd = __builtin_amdgcn_rsqf(wave_sum(s) * (1.f / DM) + EPS);
                GAS v4u* o16 = (GAS v4u*)(H + (size_t)mm * DM) + lane;
#pragma unroll
                for (int j = 0; j < 8; ++j) { const int c0 = 8 * (lane + 64 * j);
                    const f32x4 g0 = *(const LAS f32x4*)(Gv + c0), g1 = *(const LAS f32x4*)(Gv + c0 + 4), s0 = *(const LAS f32x4*)(Sv + c0), s1 = *(const LAS f32x4*)(Sv + c0 + 4);
                    const f32x4 y0 = v[2 * j] * rstd * g0 + s0, y1 = v[2 * j + 1] * rstd * g1 + s1;
                    v4u o; o.x = pk2(y0.x, y0.y); o.y = pk2(y0.z, y0.w); o.z = pk2(y1.x, y1.y); o.w = pk2(y1.z, y1.w);
                    o16[64 * j] = o; }
            } else {
                const GAS v4u* xr = (const GAS v4u*)((const bf16*)(a.ws + WS_X1B) + (size_t)mm * DM) + lane;
                v4u v[8]; float s = 0.f;
#pragma unroll
                for (int j = 0; j < 8; ++j) { v[j] = xr[64 * j];
#pragma unroll
                    for (int e = 0; e < 4; ++e) { const float lo = __uint_as_float(v[j][e] << 16), hi = __uint_as_float(v[j][e] & 0xffff0000u); s += lo * lo + hi * hi; } }
                const float rstd = __builtin_amdgcn_rsqf(wave_sum(s) * (1.f / DM) + EPS);
                GAS v4u* o16 = (GAS v4u*)(H + (size_t)mm * DM) + lane;
#pragma unroll
                for (int j = 0; j < 8; ++j) { const int c0 = 8 * (lane + 64 * j); v4u o;
                    const f32x4 g0 = *(const LAS f32x4*)(Gv + c0), g1 = *(const LAS f32x4*)(Gv + c0 + 4), s0 = *(const LAS f32x4*)(Sv + c0), s1 = *(const LAS f32x4*)(Sv + c0 + 4);
                    const float x0 = __uint_as_float(v[j].x << 16), x1 = __uint_as_float(v[j].x & 0xffff0000u), x2 = __uint_as_float(v[j].y << 16), x3 = __uint_as_float(v[j].y & 0xffff0000u);
                    const float x4 = __uint_as_float(v[j].z << 16), x5 = __uint_as_float(v[j].z & 0xffff0000u), x6 = __uint_as_float(v[j].w << 16), x7 = __uint_as_float(v[j].w & 0xffff0000u);
                    o.x = pk2(x0 * rstd * g0.x + s0.x, x1 * rstd * g0.y + s0.y); o.y = pk2(x2 * rstd * g0.z + s0.z, x3 * rstd * g0.w + s0.w);
                    o.z = pk2(x4 * rstd * g1.x + s1.x, x5 * rstd * g1.y + s1.y); o.w = pk2(x6 * rstd * g1.z + s1.z, x7 * rstd * g1.w + s1.w);
                    o16[64 * j] = o; }
            }
        }
        m = send;
    }
    __syncthreads();
}

__device__ __forceinline__ void qk_item(const Args& a, const v4u raw, int it, int lane, bf16* P, float* onew, const LAS float* c128, const LAS float* s128, const LAS float* c64, const LAS float* s64) {
    const int sub = lane & 15, sg = lane >> 4;
    const int m = it >> 2, gi = it & 3, grp = (gi == 0) ? 4 : (gi == 1) ? 5 : (gi == 2) ? 10 : 11; bf16* src = P + (size_t)m * DIN + grp * 512 + lane * 8;
        float x[8];
        x[0] = __uint_as_float(raw.x << 16); x[1] = __uint_as_float(raw.x & 0xffff0000u); x[2] = __uint_as_float(raw.y << 16); x[3] = __uint_as_float(raw.y & 0xffff0000u);
        x[4] = __uint_as_float(raw.z << 16); x[5] = __uint_as_float(raw.z & 0xffff0000u); x[6] = __uint_as_float(raw.w << 16); x[7] = __uint_as_float(raw.w & 0xffff0000u);
        const bool lat = m >= M_P; const int t = lat ? (m - M_P) % T_S : m % T_P; const int b = lat ? (m - M_P) / T_S : m / T_P;
        const bool is_v = (grp == 5 || grp == 11);
        const bool is_a = grp < 6;
        if (!is_v) {
            float ss = 0.f;
#pragma unroll
            for (int e = 0; e < 8; ++e) ss += x[e] * x[e];
            ss += __shfl_xor(ss, 1); ss += __shfl_xor(ss, 2); ss += __shfl_xor(ss, 4);
            if (is_a) ss += __shfl_xor(ss, 8);
            const float rstd = __builtin_amdgcn_rsqf(ss * (is_a ? (1.f / 128.f) : (1.f / 64.f)) + EPS);
            const float* gp = (grp < 4) ? a.in[12] : (grp == 4) ? a.in[13] : (grp < 10) ? a.in[14] : a.in[15];
            const int goff = is_a ? sub * 8 : (sub & 7) * 8;
            const f32x4 g0 = *(const GAS f32x4*)(gp + goff), g1 = *(const GAS f32x4*)(gp + goff + 4);
            x[0] *= rstd * g0.x; x[1] *= rstd * g0.y; x[2] *= rstd * g0.z; x[3] *= rstd * g0.w; x[4] *= rstd * g1.x; x[5] *= rstd * g1.y; x[6] *= rstd * g1.z; x[7] *= rstd * g1.w;
            if (lat) {
                float px[8];
                if (is_a) {
#pragma unroll
                    for (int e = 0; e < 8; ++e) px[e] = __shfl_xor(x[e], 4);
                    const int axis = (sub >> 3) & 1, half = (sub >> 2) & 1, i0 = (sub & 3) * 8, pos = axis ? (t & 63) : (t >> 6);
#pragma unroll
                    for (int e = 0; e < 8; ++e) { const float cs = c128[pos * 32 + i0 + e], sn = s128[pos * 32 + i0 + e]; x[e] = half ? (x[e] * cs + px[e] * sn) : (x[e] * cs - px[e] * sn); }
                } else {
#pragma unroll
                    for (int e = 0; e < 8; ++e) px[e] = __shfl_xor(x[e], 2);
                    const int s8 = sub & 7, axis = (s8 >> 2) & 1, half = (s8 >> 1) & 1, i0 = (s8 & 1) * 8, pos = axis ? (t & 63) : (t >> 6);
#pragma unroll
                    for (int e = 0; e < 8; ++e) { const float cs = c64[pos * 16 + i0 + e], sn = s64[pos * 16 + i0 + e]; x[e] = half ? (x[e] * cs + px[e] * sn) : (x[e] * cs - px[e] * sn); }
                }
            }
        }
        v4u ob; ob.x = pk2(x[0], x[1]); ob.y = pk2(x[2], x[3]); ob.z = pk2(x[4], x[5]); ob.w = pk2(x[6], x[7]);
        const bool is_q = (grp < 4) || (grp >= 6 && grp < 10);
        if (is_q) { *(GAS v4u*)src = ob; }
        else {
            const int which = (grp == 4) ? 0 : (grp == 5) ? 1 : (grp == 10) ? 2 : 3;
            const int kv = sg;
            if (lat) { *(GAS v4u*)((bf16*)(a.ws + WS_KVL + (size_t)which * KVL_SZ) + ((size_t)(b * 4 + kv) * KVL + LCTX + t) * 128 + sub * 8) = ob; }
            else { *(GAS v4u*)((bf16*)(a.ws + WS_KVP + (size_t)which * KVP_SZ) + ((size_t)(b * 4 + kv) * T_P + t) * 128 + sub * 8) = ob;
                GAS f32x4* of = (GAS f32x4*)(onew + (size_t)which * M_P * 512 + (size_t)m * 512 + kv * 128 + sub * 8);
                of[0] = (f32x4){x[0], x[1], x[2], x[3]}; of[1] = (f32x4){x[4], x[5], x[6], x[7]}; }
        }

}
__device__ __forceinline__ void qk_phase(const Args& a, LAS unsigned char* lds, int vcu, int G, int wave) {
    const int tid = fresh_tid(), lane = tid & 63;
    LAS float* c128 = (LAS float*)lds; LAS float* s128 = c128 + 2048; LAS float* c64 = s128 + 2048; LAS float* s64 = c64 + 1024;
    for (int e = tid; e < 2048; e += NWAVES * 64) { const int pos = e >> 5, i = e & 31; const float f = exp2f(-(float)i * (13.287712379549449f / 32.f)); float sn, cs; sincosf((float)pos * f, &sn, &cs); c128[e] = cs; s128[e] = sn; }
    for (int e = tid; e < 1024; e += NWAVES * 64) { const int pos = e >> 4, i = e & 15; const float f = exp2f(-(float)i * (13.287712379549449f / 16.f)); float sn, cs; sincosf((float)pos * f, &sn, &cs); c64[e] = cs; s64[e] = sn; }
    __syncthreads();
    bf16* P = (bf16*)(a.ws + WS_P);
    float* onew = a.out + (size_t)MTOK * DM;
    const int gw = vcu * NWAVES + wave, NGW = G * NWAVES;
#define QK_GRP(gi_) ((gi_) == 0 ? 4 : (gi_) == 1 ? 5 : (gi_) == 2 ? 10 : 11)
#define QK_SRC(it_) (P + (size_t)((it_) >> 2) * DIN + QK_GRP((it_) & 3) * 512 + lane * 8)
    for (int it = gw; it < MTOK * 4; it += 4 * NGW) {
        const int it1 = it + NGW, it2 = it + 2 * NGW, it3 = it + 3 * NGW;
        v4u r0, r1 = {0u, 0u, 0u, 0u}, r2 = {0u, 0u, 0u, 0u}, r3 = {0u, 0u, 0u, 0u};
        r0 = *(const GAS v4u*)QK_SRC(it);
        if (it1 < MTOK * 4) r1 = *(const GAS v4u*)QK_SRC(it1);
        if (it2 < MTOK * 4) r2 = *(const GAS v4u*)QK_SRC(it2);
        if (it3 < MTOK * 4) r3 = *(const GAS v4u*)QK_SRC(it3);
        qk_item(a, r0, it, lane, P, onew, c128, s128, c64, s64);
        if (it1 < MTOK * 4) qk_item(a, r1, it1, lane, P, onew, c128, s128, c64, s64);
        if (it2 < MTOK * 4) qk_item(a, r2, it2, lane, P, onew, c128, s128, c64, s64);
        if (it3 < MTOK * 4) qk_item(a, r3, it3, lane, P, onew, c128, s128, c64, s64);
    }
#undef QK_SRC
#undef QK_GRP
    __syncthreads();
}

__device__ __forceinline__ void attn_phase(const Args& a, unsigned char* lds_g, int G, int wave) {
    const int lane = fresh_tid() & 63;
    const bf16* P = (const bf16*)(a.ws + WS_P); bf16* O = (bf16*)(a.ws + WS_O);
    const bf16* KA_l = (const bf16*)(a.ws + WS_KVL); const bf16* VA_l = (const bf16*)(a.ws + WS_KVL + KVL_SZ); const bf16* KB_l = (const bf16*)(a.ws + WS_KVL + 2 * KVL_SZ); const bf16* VB_l = (const bf16*)(a.ws + WS_KVL + 3 * KVL_SZ);
    const bf16* KA_p = (const bf16*)(a.ws + WS_KVP); const bf16* VA_p = (const bf16*)(a.ws + WS_KVP + KVP_SZ); const bf16* KB_p = (const bf16*)(a.ws + WS_KVP + 2 * KVP_SZ); const bf16* VB_p = (const bf16*)(a.ws + WS_KVP + 3 * KVP_SZ);
    float* misc = (float*)(lds_g + att::LDS_MISC);
    if (wave == 0) { const float p1 = a.in[17][lane] * a.in[18][lane], p2 = a.in[19][lane] * a.in[20][lane];
        const float s1 = wave_sum(p1), s2 = wave_sum(p2); if (lane == 0) misc[0] = __expf(s1) - __expf(s2) + 0.2f; }
    __syncthreads();
    const float lam = misc[0];
    const int nper = G / 8;
    const int c = blockIdx.x, x = c % 8, j = c / 8;
    att::UnitArgs U;
#ifndef ATT_NO_MODE1
    for (int u = c; u < NB_S * 16 * 8 + NB_P * 16 * 2; u += G) {
        const bool lat = u < NB_S * 16 * 8; const int uu = lat ? u : u - NB_S * 16 * 8; const int i = uu / G;
        int gid, g, qb;
        if (lat) { if (G == 256) { gid = i * 8 + x; g = j >> 3; qb = j & 7; } else { gid = uu >> 5; g = (uu >> 3) & 3; qb = uu & 7; } }
        else     { if (G == 256) { gid = (i * 8 + x) * 4 + (j >> 3); g = (j >> 1) & 3; qb = j & 1; } else { gid = uu >> 3; g = (uu >> 1) & 3; qb = uu & 1; } }
        const int b = gid >> 2, kv = gid & 3, h = kv * 4 + g; const int m0 = lat ? M_P + b * T_S + qb * 128 : b * T_P + qb * 128;
        const size_t kvoff = lat ? (size_t)(b * 4 + kv) * KVL * 128 : (size_t)(b * 4 + kv) * T_P * 128;
        U.Qb = P + (size_t)m0 * DIN + 3072 + h * 128; U.ldq = DIN; U.Kh = (lat ? KB_l : KB_p) + kvoff; U.Vh = (lat ? VB_l : VB_p) + kvoff;
        U.Ob = O + (size_t)m0 * DM + 2048 + h * 128; U.ldo = DM; U.NT = lat ? KVL / 64 : T_P / 64; U.jwin = 1 << 30; U.wadd = 0; U.masked = 0; U.t0 = 0; U.sinkl2 = 0.f; U.lam = lam; U.subg = a.in[21]; U.qg = a.in[14]; U.ropeT = (const float*)(a.ws + WS_ROPE); U.rope = lat ? 1 : 0; U.t0 = lat ? qb * 128 : 0;
        att::attn_unit<1>(U, (char*)lds_g);
    }
#endif
#ifndef ATT_NO_MODE0
    for (int u = c; u < NB_S * 16 * 4 + NB_P * 16; u += G) {
        const bool lat = u < NB_S * 16 * 4; const int uu = lat ? u : u - NB_S * 16 * 4; const int i = uu / G;
        int gid, g, qb2;
        if (lat) { if (G == 256) { gid = (i * 8 + x) * 2 + (j >> 4); g = (j >> 2) & 3; qb2 = (j & 3) ^ (i & 1); } else { gid = uu >> 4; g = (uu >> 2) & 3; qb2 = uu & 3; } }
        else     { if (G == 256) { gid = x * 8 + (j >> 2); g = j & 3; qb2 = 0; } else { gid = uu >> 2; g = uu & 3; qb2 = 0; } }
        const int b = gid >> 2, kv = gid & 3, h = kv * 4 + g; const int t0 = qb2 * 256, m0 = lat ? M_P + b * T_S + t0 : b * T_P;
        const int wstart = (t0 - 128 > 0) ? t0 - 128 : 0, wend = (t0 + 384 < T_S) ? t0 + 384 : T_S;
        const size_t kvoff = lat ? (size_t)(b * 4 + kv) * KVL * 128 : (size_t)(b * 4 + kv) * T_P * 128;
        U.Qb = P + (size_t)m0 * DIN + h * 128; U.ldq = DIN; U.Kh = (lat ? KA_l : KA_p) + kvoff; U.Vh = (lat ? VA_l : VA_p) + kvoff;
        U.Ob = O + (size_t)m0 * DM + h * 128; U.ldo = DM; U.NT = lat ? 8 + (wend - wstart) / 64 : T_P / 64; U.jwin = lat ? 8 : (1 << 30); U.wadd = lat ? wstart : 0; U.masked = lat ? 1 : 0; U.t0 = t0;
        U.sinkl2 = a.in[16][h] * att::LOG2E; U.lam = 0.f; U.subg = nullptr; U.qg = a.in[12]; U.ropeT = (const float*)(a.ws + WS_ROPE); U.rope = lat ? 1 : 0;
        att::attn_unit<0>(U, (char*)lds_g);
    }
#endif
    __syncthreads();
}


__device__ __forceinline__ void p0_phase(const Args& args, LAS unsigned char* ldsl, int vcu, int G, int wave) {
    const int tid = fresh_tid(), lane = tid & 63;
    for (int it = vcu; it < 32 * KSPLIT; it += G) mod_block_item(args, ldsl, it & 31, it >> 5, tid, lane, wave);
}
__device__ __forceinline__ void p1_extras(const Args& args, LAS unsigned char* ldsl, int vcu, int G, int wave) {
    const int lane = fresh_tid() & 63;
    LAS float* scr = (LAS float*)(ldsl + wave * TR_LDS);
    constexpr int I_IN = (DM / 64) * (DIN / 64);
    if (vcu == 0) { float* rt = (float*)(args.ws + WS_ROPE); const int tid = wave * 64 + lane;
        for (int e = tid; e < 2048; e += NWAVES * 64) { const int pos = e >> 5, i = e & 31; const float fq_ = exp2f(-(float)i * (13.287712379549449f / 32.f)); float sn, cs; sincosf((float)pos * fq_, &sn, &cs); rt[e] = cs; rt[2048 + e] = sn; }
        for (int e = tid; e < 1024; e += NWAVES * 64) { const int pos = e >> 4, i = e & 15; const float fq_ = exp2f(-(float)i * (13.287712379549449f / 16.f)); float sn, cs; sincosf((float)pos * fq_, &sn, &cs); rt[4096 + e] = cs; rt[5120 + e] = sn; } }
    for (int r = vcu * NWAVES + wave; r < I_IN; r += G * NWAVES) p0_transpose_item(args.in[11], DM, DIN, (bf16*)(args.ws + WS_WIN), scr, r, lane);
    for (int it = vcu * NWAVES + wave; it < 4 * 4096; it += G * NWAVES) {
        const int tsr = it >> 12, w = it & 4095; const size_t e = ((size_t)w * 64 + lane) * 8;
        const float* src = args.in[2 + tsr] + e; const f32x4 v0 = *(const GAS f32x4*)src, v1 = *(const GAS f32x4*)(src + 4);
        const int d = (int)(e & 127), kv = (int)((e >> 7) & 3), key = (int)((e >> 9) & 511), b = (int)(e >> 18);
        v4u o; o.x = pk2(v0.x, v0.y); o.y = pk2(v0.z, v0.w); o.z = pk2(v1.x, v1.y); o.w = pk2(v1.z, v1.w);
        *(GAS v4u*)((bf16*)(args.ws + WS_KVL + tsr * KVL_SZ) + ((size_t)(b * 4 + kv) * KVL + key) * 128 + d) = o; }
}
__device__ __forceinline__ void p3_extras(const Args& args, LAS unsigned char* ldsl, int vcu, int G, int q2, int wave) {
    const int tid = fresh_tid(), lane = tid & 63;
    bg_items(args, ldsl, q2, N_BG, vcu, G, tid, lane, wave);
    __syncthreads();
}
__device__ __forceinline__ void modf_rest(const Args& args, int vcu, int G) {
    const int tid = fresh_tid();
    const float* bmod = args.in[9]; const float* part = (const float*)(args.ws + WS_MODP); float* modf = (float*)(args.ws + WS_MODF);
    for (int e = vcu * (NWAVES * 64) + tid; e < 9 * 4 * DM; e += G * NWAVES * 64) { const int r = e / (4 * DM), n = 2 * DM + e % (4 * DM);
        float s = bmod[n];
#pragma unroll
        for (int p = 0; p < KSPLIT; ++p) s += part[((size_t)p * 9 + r) * NMOD + n];
        modf[(size_t)r * NMOD + n] = s; }
}
#ifndef GEMM_ORDER
#define GEMM_ORDER pg8::BlockOrder
#endif
#ifndef GEMM_ALIGN
#define GEMM_ALIGN true
#endif
#ifndef GEMM_SP2
#define GEMM_SP2 true
#endif
#ifndef U_TILED
#define U_TILED true
#endif
#ifndef U_NT
#define U_NT true
#endif
constexpr int P2_G = 232;
__device__ __forceinline__ void p2_phase(const Args& args, LAS unsigned char* ldsl, int G, int bx, int wave) {
    const bool split = (G == 256);
    if (!split || bx < P2_G) {
        pg8::Gemm g{(const pg8::bf16_t*)(args.ws + WS_H), (const pg8::bf16_t*)(args.ws + WS_WIN), MTOK, DIN, DM, 0}; pg8::StaticOrder S; S.init(MTOK, DIN, split ? P2_G : G, bx);
        pg8::EpiBf16<0> E{(pg8::bf16_t*)(args.ws + WS_P), DIN};
        pg8::gemm_phase<pg8::EpiBf16<0>, pg8::StaticOrder, GEMM_ALIGN, GEMM_SP2>(ldsl, g, S, E);
    } else {
        const int tid = fresh_tid(), lane = tid & 63;
        bg_items(args, ldsl, 0, BG_Q2, bx - P2_G, G - P2_G, tid, lane, wave);
    }
}
__device__ __forceinline__ void p5_phase(const Args& args, LAS unsigned char* ldsl, int G, int bx) {
    pg8::Gemm g{(const pg8::bf16_t*)(args.ws + WS_O), (const pg8::bf16_t*)(args.ws + WS_WOUT), MTOK, DM, DM, 0}; GEMM_ORDER S; S.init(MTOK, DM, G, bx);
    const float* modf = (const float*)(args.ws + WS_MODF);
    pg8::EpiResidB E{args.in[0], args.in[1], (pg8::bf16_t*)(args.ws + WS_X1B), DM, M_P / 256, modf + 2 * DM, NMOD, modf + (size_t)8 * NMOD + 2 * DM};
    pg8::gemm_phase<pg8::EpiResidB, GEMM_ORDER, GEMM_ALIGN, GEMM_SP2>(ldsl, g, S, E);
}
__device__ __forceinline__ void p7_phase(const Args& args, LAS unsigned char* ldsl, int G, int bx) {
    pg8::Gemm g{(const pg8::bf16_t*)(args.ws + WS_H), (const pg8::bf16_t*)(args.ws + WS_WFC1), MTOK, DFF, DM, 0}; GEMM_ORDER S; S.init(MTOK, DFF, G, bx);
    pg8::EpiBf16<1, U_NT, U_TILED> E{(pg8::bf16_t*)(args.ws + WS_U), DFF};
    pg8::gemm_phase<pg8::EpiBf16<1, U_NT, U_TILED>, GEMM_ORDER, GEMM_ALIGN, GEMM_SP2>(ldsl, g, S, E);
}
__device__ __forceinline__ void p7_null_phase(const Args& args, LAS unsigned char* ldsl, int G, int bx) {
    pg8::Gemm g{(const pg8::bf16_t*)(args.ws + WS_H), (const pg8::bf16_t*)(args.ws + WS_WFC1), MTOK, DFF, DM, 0}; pg8::StaticOrder S; S.init(MTOK, DFF, G, bx);
    pg8::EpiNull E{};
    pg8::gemm_phase<pg8::EpiNull, pg8::StaticOrder, GEMM_ALIGN, GEMM_SP2>(ldsl, g, S, E);
}
__device__ __forceinline__ void p8_null_phase(const Args& args, LAS unsigned char* ldsl, int G, int bx) {
    pg8::Gemm g{(const pg8::bf16_t*)(args.ws + WS_U), (const pg8::bf16_t*)(args.ws + WS_WFC2), MTOK, DM, DFF, U_TILED ? 1 : 0}; pg8::StaticOrder S; S.init(MTOK, DM, G, bx);
    pg8::EpiNull E{};
    pg8::gemm_phase<pg8::EpiNull, pg8::StaticOrder, GEMM_ALIGN, GEMM_SP2>(ldsl, g, S, E);
}
__device__ __forceinline__ void p8_phase(const Args& args, LAS unsigned char* ldsl, int G, int bx) {
    pg8::Gemm g{(const pg8::bf16_t*)(args.ws + WS_U), (const pg8::bf16_t*)(args.ws + WS_WFC2), MTOK, DM, DFF, U_TILED ? 1 : 0}; GEMM_ORDER S; S.init(MTOK, DM, G, bx);
    const float* modf = (const float*)(args.ws + WS_MODF);
    pg8::EpiResid E{(const pg8::bf16_t*)(args.ws + WS_X1B), args.out, DM, M_P / 256, modf + 5 * DM, NMOD, modf + (size_t)8 * NMOD + 5 * DM};
    pg8::gemm_phase<pg8::EpiResid, GEMM_ORDER, GEMM_ALIGN, GEMM_SP2>(ldsl, g, S, E);
}

__global__ void __launch_bounds__(NWAVES * 64, 2) fwd_kernel(Args args) {
    extern __shared__ __attribute__((aligned(16))) unsigned char lds[];
    LAS unsigned char* ldsl = (LAS unsigned char*)lds;
    volatile LAS unsigned* MISC = (volatile LAS unsigned*)(ldsl + MISC_OFF);
    const int tid = threadIdx.x, wave = __builtin_amdgcn_readfirstlane(tid >> 6);
    const int G = gridDim.x; const int bx = blockIdx.x; const int vcu = (G % 8 == 0) ? (bx % 8) * (G / 8) + bx / 8 : bx;
    gu32* ctl = (gu32*)(args.ws + WS_CTL);
    for (int u = tid; u < (LDS_BYTES - MISC_OFF) / 4; u += NWAVES * 64) ((LAS unsigned*)(ldsl + MISC_OFF))[u] = 0u;
    __syncthreads();
    XcdBarrier bar; bar.bar = (unsigned*)(ctl + CW_BAR); bar.x = 0; bar.st = nullptr;
    if (N_LAUNCHES == 1) bar = xcd_barrier_post((unsigned*)(ctl + CW_BAR), MISC + 8);
    const int lo = args.ph_lo, hi = args.ph_hi;
#ifndef PHASE_MASK
#define PHASE_MASK 0x1ff
#endif
#define IN(k) ((((PHASE_MASK) >> (k)) & 1) && lo <= (k) && (k) < hi)
#define SEAM(k) do { if (IN(k) && IN((k) + 1)) xcd_barrier(bar); } while (0)

#ifndef PROBE_REPEAT
#define PROBE_REPEAT (-1)
#endif
#if defined(PROBE_TIME)
    unsigned long long pt0 = 0, pt1 = 0;
#define PT_BEGIN(k) do { if (PROBE_TIME == (k)) pt0 = wall_clock64(); } while (0)
#define PT_END(k) do { if (PROBE_TIME == (k)) pt1 = wall_clock64(); } while (0)
#else
#define PT_BEGIN(k) do { } while (0)
#define PT_END(k) do { } while (0)
#endif
#define REP(k, call) do { if (PROBE_REPEAT == (k)) { call; xcd_barrier(bar); } } while (0)
    PT_BEGIN(0);
    if (IN(0)) p0_phase(args, ldsl, vcu, G, wave);
    SEAM(0); PT_END(0);
    PT_BEGIN(1);
    if (IN(1)) { norm_phase<0>(args, ldsl, vcu, G, wave); p1_extras(args, ldsl, vcu, G, wave); }
    SEAM(1); PT_END(1);
    PT_BEGIN(2);
    if (IN(2)) p2_phase(args, ldsl, G, bx, wave);
    SEAM(2); PT_END(2);
    PT_BEGIN(3);
    if (IN(3)) { p3_extras(args, ldsl, vcu, G, (G == 256) ? BG_Q2 : 0, wave); qk_phase(args, ldsl, vcu, G, wave); }
    SEAM(3); PT_END(3);
    PT_BEGIN(4);
    if (IN(4)) { modf_rest(args, vcu, G); attn_phase(args, lds, G, wave); }
    SEAM(4); PT_END(4); REP(4, attn_phase(args, lds, G, wave));
    PT_BEGIN(5);
    if (IN(5)) p5_phase(args, ldsl, G, bx);
    SEAM(5); PT_END(5); REP(5, p5_phase(args, ldsl, G, bx));
    PT_BEGIN(6);
    if (IN(6)) norm_phase<1>(args, ldsl, vcu, G, wave);
    SEAM(6); PT_END(6); REP(6, norm_phase<1>(args, ldsl, vcu, G, wave));
#if defined(PROBE_CLOCK)
    unsigned long long pc0 = 0, pr0 = 0, pc1 = 0, pr1 = 0;
    if (PROBE_CLOCK == 7) { pc0 = clock64(); pr0 = wall_clock64(); }
#endif
    PT_BEGIN(7);
    if (IN(7)) p7_phase(args, ldsl, G, bx);
#if defined(PROBE_CLOCK)
    if (PROBE_CLOCK == 7) { pc1 = clock64(); pr1 = wall_clock64(); }
#endif
    SEAM(7); PT_END(7); REP(7, p7_phase(args, ldsl, G, bx)); REP(17, p7_null_phase(args, ldsl, G, bx)); REP(18, p8_null_phase(args, ldsl, G, bx));
    PT_BEGIN(8);
    if (IN(8)) p8_phase(args, ldsl, G, bx);
#if defined(PROBE_TIME)
    PT_END(8);
    if (bx == 0 && tid == 0) { const unsigned long long t0 = wall_clock64(); while (wall_clock64() - t0 < (pt1 - pt0)) __builtin_amdgcn_s_sleep(8); }
#endif
#if defined(PROBE_CLOCK)
    if (bx == 0 && tid == 0) {
        const unsigned long long ticks = (pc1 - pc0) * 1000ull / (pr1 - pr0);
        const unsigned long long t0 = wall_clock64(); while (wall_clock64() - t0 < ticks) __builtin_amdgcn_s_sleep(8);
    }
#endif
#undef REP
#undef IN
#undef SEAM
}

extern "C" void kernel_launch(void* const* d_in, const int* in_sizes, int n_in, void* d_out, int out_size, void* d_ws, size_t ws_size, hipStream_t stream) {
    static int grid = 0;
    if (grid == 0) {
        if (n_in != 26 || in_sizes[0] != M_P * DM || in_sizes[1] != M_S * DM || out_size != MTOK * DM + 4 * M_P * 512 || ws_size < WS_END) {
            fprintf(stderr, "kernel_launch: shape mismatch (n_in %d in0 %d in1 %d out %d ws %zu, need ws >= %zu); nothing launched\n", n_in, n_in > 0 ? in_sizes[0] : -1, n_in > 1 ? in_sizes[1] : -1, out_size, ws_size, (size_t)WS_END); grid = -1; return; }
        int dev = 0, cus = 0, per_cu = 0;
        if (hipGetDevice(&dev) != hipSuccess || hipDeviceGetAttribute(&cus, hipDeviceAttributeMultiprocessorCount, dev) != hipSuccess) { grid = -1; return; }
        if (hipFuncSetAttribute((const void*)fwd_kernel, hipFuncAttributeMaxDynamicSharedMemorySize, LDS_BYTES) != hipSuccess) { fprintf(stderr, "kernel_launch: hipFuncSetAttribute failed\n"); grid = -1; return; }
        if (hipOccupancyMaxActiveBlocksPerMultiprocessor(&per_cu, (const void*)fwd_kernel, NWAVES * 64, LDS_BYTES) != hipSuccess || per_cu < 1) { fprintf(stderr, "kernel_launch: occupancy query says %d blocks per CU\n", per_cu); }
        (void)hipGetLastError();
        grid = cus;
    }
    if (grid < 0) return;
    if (hipMemsetAsync((char*)d_ws + WS_CTL, 0, CTL_ZERO_BYTES, stream) != hipSuccess) return;
    Args a{};
    for (int i = 0; i < 26; ++i) a.in[i] = (const float*)d_in[i];
    a.out = (float*)d_out; a.ws = (unsigned char*)d_ws;
    if (N_LAUNCHES == 1) { a.ph_lo = 0; a.ph_hi = NPH; hipLaunchKernelGGL(fwd_kernel, dim3(grid), dim3(NWAVES * 64), LDS_BYTES, stream, a); }
    else { for (int p = 0; p < NPH; ++p) { a.ph_lo = p; a.ph_hi = p + 1; hipLaunchKernelGGL(fwd_kernel, dim3(grid), dim3(NWAVES * 64), LDS_BYTES, stream, a); } }
    const hipError_t le = hipPeekAtLastError();
    if (le != hipSuccess) fprintf(stderr, "kernel_launch: launch failed: %s\n", hipGetErrorName(le));
}
```

```cpp
#define ST_CLS 4
#include <hip/hip_runtime.h>
#include <cstdio>
#include <cstdint>
#ifndef PG8_WGM
#define PG8_WGM 8
#endif
namespace pg8 {
#define PG8_LAS __attribute__((address_space(3)))
typedef unsigned short bf16_t;
typedef short bf16x8 __attribute__((ext_vector_type(8)));
typedef float f32x4 __attribute__((ext_vector_type(4)));
typedef unsigned u32x4 __attribute__((ext_vector_type(4)));
constexpr int BM = 256, BK = 64, HALF = 128, HTB = HALF * BK * 2  , STAGE_BYTES = 8 * HTB, NXCD = 8, WGM = PG8_WGM;

__host__ __device__ __forceinline__ int lds_byte(int r, int c) { const int st = (r >> 4) * 2 + (c >> 5), rr = r & 15, cc = c & 31, ob = rr * 64 + cc * 2; return st * 1024 + (ob ^ (((ob >> 9) & 1) << 5)); }
__host__ __device__ __forceinline__ void stage_rc(int b, int& R, int& C) { const int st = b / 1024, sb = b % 1024, swz = sb ^ (((sb >> 9) & 1) << 5); R = (st >> 1) * 16 + swz / 64; C = (st & 1) * 32 + (swz % 64) / 2; }
__host__ __device__ __forceinline__ int perm32(int rho) { const int n = rho >> 4, i = rho & 15; return 8 * (i >> 2) + 4 * n + (i & 3); }

struct Unit { int pm, pn; };
struct Gemm { const bf16_t* A; const bf16_t* Bt; int M, N, K; int a_tiled; };

struct StaticOrder {
    int nM, nN, nwg, G, c;
    __host__ __device__ void init(int M, int N, int G_, int c_) { nM = M / BM; nN = N / BM; nwg = nM * nN; G = G_; c = c_; }
    __host__ __device__ bool next(int i, Unit& u) const {
        const long L = (long)i * G + c; if (L >= nwg) return false;
        int wgid = (int)L; { const int q = nwg / NXCD, r = nwg % NXCD, xcd = wgid % NXCD, off = wgid / NXCD; wgid = (xcd < r ? xcd * (q + 1) : r * (q + 1) + (xcd - r) * q) + off; }
        const int nig = WGM * nN, gid = wgid / nig, fm = gid * WGM, gsz = (nM - fm) < WGM ? (nM - fm) : WGM;
        u.pm = fm + ((wgid % nig) % gsz); u.pn = (wgid % nig) / gsz; return true;
    }
    __device__ __forceinline__ void a_ready(const Unit&) const {}
    __device__ __forceinline__ void done(const Unit&) const {}
};

struct BlockOrder {
    int nM, nN, nqb, nblk, c, G;
    __host__ __device__ void init(int M, int N, int G_, int c_) { nM = M / BM; nN = N / BM; nqb = nN / 4; nblk = (nM / 8) * nqb; c = c_; G = G_; }
    __host__ __device__ bool next(int i, Unit& u) const {
        if (G != 256 || (nM & 7) || (nN & 3)) { const long L = (long)i * G + c; if (L >= (long)nM * nN) return false; u.pm = (int)(L / nN); u.pn = (int)(L % nN); return true; }
        const int x = c & 7, j = c >> 3, b = i * 8 + x; if (b >= nblk) return false;
        const int g = b / nqb, q = b - g * nqb; u.pm = 8 * g + (j & 7); u.pn = 4 * q + (j >> 3); return true;
    }
    __device__ __forceinline__ void a_ready(const Unit&) const {}
    __device__ __forceinline__ void done(const Unit&) const {}
};

__device__ __forceinline__ unsigned cvt_pk_bf16(float lo, float hi) { unsigned r; asm volatile("v_cvt_pk_bf16_f32 %0, %1, %2" : "=v"(r) : "v"(lo), "v"(hi)); return r; }

template <int ACT, bool NT = false, bool TILED = false> struct EpiBf16 {
    static constexpr bool PERM = true, AFTER_DRAIN = false;
    bf16_t* O; int ldc;
    __device__ __forceinline__ void operator()(const f32x4 (&acc)[2][2][4][2], const Unit& u, int wr, int wc, int fr, int fq) const {
        const int row0 = u.pm * BM + wr * 64 + fr; const int col0 = u.pn * BM + wc * 32 + 8 * fq;
#pragma unroll
        for (int ai = 0; ai < 2; ++ai)
#pragma unroll
            for (int m = 0; m < 4; ++m) {
                bf16_t* rowp = TILED ? O + (((size_t)u.pm * (ldc / 64) + u.pn * 4 + (wc >> 1)) * BM + (wr * 64 + fr + ai * HALF + m * 16)) * 64 + (wc & 1) * 32 + 8 * fq
                                     : O + (size_t)(row0 + ai * HALF + m * 16) * ldc + col0;
                constexpr size_t BJ_STEP = TILED ? (size_t)2 * BM * 64 : (size_t)HALF;
#pragma unroll
                for (int bj = 0; bj < 2; ++bj) { f32x4 v0 = acc[ai][bj][m][0], v1 = acc[ai][bj][m][1];
                    if (ACT == 1) {
#pragma unroll
                        for (int j = 0; j < 4; ++j) { const float a = fmaxf(v0[j], 0.f), b = fmaxf(v1[j], 0.f); v0[j] = a * a; v1[j] = b * b; } }
                    u32x4 w; w.x = cvt_pk_bf16(v0[0], v0[1]); w.y = cvt_pk_bf16(v0[2], v0[3]); w.z = cvt_pk_bf16(v1[0], v1[1]); w.w = cvt_pk_bf16(v1[2], v1[3]);
                    if (NT) __builtin_nontemporal_store(w, (u32x4*)(rowp + bj * BJ_STEP)); else *(u32x4*)(rowp + bj * BJ_STEP) = w;
#if defined(PROBE_STORE)
                    if (ACT == 1) {
                        bf16_t* dp = O - ((size_t)304 << 20) / 2; const int pmw = u.pm & 31;
                        if (PROBE_STORE == 1) *(u32x4*)(dp + (size_t)(pmw * BM + wr * 64 + fr + ai * HALF + m * 16) * ldc + col0 + bj * HALF) = w;
                        else if (PROBE_STORE == 2) *(u32x4*)(dp + (size_t)(pmw * BM + wr * 64 + ai * HALF + m * 16 + (fr & 7) + 8 * bj) * ldc + u.pn * BM + wc * 64 + (fr >> 3) * 32 + 8 * fq) = w;
                        else *(u32x4*)(dp + ((size_t)(pmw * (ldc / BM) + u.pn) * BM + (wr * 64 + fr + ai * HALF + m * 16)) * BM + wc * 32 + 8 * fq + bj * HALF) = w;
                    }
#endif
                    } }
    }
};
struct EpiResidB {
    static constexpr bool PERM = true, AFTER_DRAIN = false;
    const float* base0; const float* base1; bf16_t* out; int ldc; int split; const float* gate; int gate_stride; const float* gate_ctx;
    __device__ __forceinline__ void operator()(const f32x4 (&acc)[2][2][4][2], const Unit& u, int wr, int wc, int fr, int fq) const {
        const int rloc = wr * 64 + fr, col0 = u.pn * BM + wc * 32 + 8 * fq;
        const float* bt = (u.pm < split) ? base0 + (size_t)u.pm * BM * ldc : base1 + (size_t)(u.pm - split) * BM * ldc;
        const float* gv = (u.pm < split) ? gate_ctx : gate + (size_t)((u.pm - split) >> 2) * gate_stride;
        bf16_t* ot = out + (size_t)u.pm * BM * ldc;
        f32x4 g[2][2];
#pragma unroll
        for (int bj = 0; bj < 2; ++bj)
#pragma unroll
            for (int n = 0; n < 2; ++n) g[bj][n] = *(const f32x4*)(gv + col0 + bj * HALF + 4 * n);
#pragma unroll
        for (int ai = 0; ai < 2; ++ai)
#pragma unroll
            for (int m = 0; m < 4; ++m) { const size_t off = (size_t)(rloc + ai * HALF + m * 16) * ldc + col0;
#pragma unroll
                for (int bj = 0; bj < 2; ++bj) { const f32x4 b0 = *(const f32x4*)(bt + off + bj * HALF), b1 = *(const f32x4*)(bt + off + bj * HALF + 4);
                    const f32x4 v0 = b0 + g[bj][0] * acc[ai][bj][m][0], v1 = b1 + g[bj][1] * acc[ai][bj][m][1];
                    u32x4 w; w.x = cvt_pk_bf16(v0[0], v0[1]); w.y = cvt_pk_bf16(v0[2], v0[3]); w.z = cvt_pk_bf16(v1[0], v1[1]); w.w = cvt_pk_bf16(v1[2], v1[3]);
                    *(u32x4*)(ot + off + bj * HALF) = w; }
                if (m & 1) asm volatile("" ::: "memory"); }
    }
};
struct EpiResid {
    static constexpr bool PERM = false, AFTER_DRAIN = false;
    const bf16_t* base; float* out; int ldc; int split; const float* gate; int gate_stride; const float* gate_ctx;
    __device__ __forceinline__ void operator()(const f32x4 (&acc)[2][2][4][2], const Unit& u, int wr, int wc, int fr, int fq) const {
        typedef unsigned u32x2 __attribute__((ext_vector_type(2)));
        const int rloc = wr * 64 + fr, col0 = u.pn * BM + wc * 32 + 4 * fq;
        const bf16_t* bt = base + (size_t)u.pm * BM * ldc;
        const float* gv = (u.pm < split) ? gate_ctx : gate + (size_t)((u.pm - split) >> 2) * gate_stride;
        float* ot = out + (size_t)u.pm * BM * ldc;
        f32x4 g[2][2];
#pragma unroll
        for (int bj = 0; bj < 2; ++bj)
#pragma unroll
            for (int n = 0; n < 2; ++n) g[bj][n] = *(const f32x4*)(gv + col0 + bj * HALF + n * 16);
#pragma unroll
        for (int ai = 0; ai < 2; ++ai)
#pragma unroll
            for (int m = 0; m < 4; ++m) { const size_t off = (size_t)(rloc + ai * HALF + m * 16) * ldc + col0;
#pragma unroll
                for (int bj = 0; bj < 2; ++bj)
#pragma unroll
                    for (int n = 0; n < 2; ++n) { const u32x2 b = *(const u32x2*)(bt + off + bj * HALF + n * 16);
                        const f32x4 bs = {__uint_as_float(b.x << 16), __uint_as_float(b.x & 0xffff0000u), __uint_as_float(b.y << 16), __uint_as_float(b.y & 0xffff0000u)};
                        *(f32x4*)(ot + off + bj * HALF + n * 16) = bs + g[bj][n] * acc[ai][bj][m][n]; }
                if (m & 1) asm volatile("" ::: "memory"); }
    }
};

struct EpiNull {
    static constexpr bool PERM = true, AFTER_DRAIN = false;
    __device__ __forceinline__ void operator()(const f32x4 (&acc)[2][2][4][2], const Unit& u, int wr, int wc, int fr, int fq) const {
#pragma unroll
        for (int ai = 0; ai < 2; ++ai)
#pragma unroll
            for (int bj = 0; bj < 2; ++bj)
#pragma unroll
                for (int m = 0; m < 4; ++m)
#pragma unroll
                    for (int n = 0; n < 2; ++n) asm volatile("" :: "v"(acc[ai][bj][m][n]));
    }
};

template <class Epi, class Sched, bool ALIGN_EPI = false, bool SP2 = false>
__device__ __forceinline__ void gemm_phase(PG8_LAS unsigned char* lds, const Gemm g, const Sched& S, const Epi& E) {
    int tid_ = threadIdx.x; asm volatile("" : "+v"(tid_));
    const int tid = tid_, wid = __builtin_amdgcn_readfirstlane(tid >> 6), lane = tid & 63, wr = wid >> 2, wc = wid & 3, fr = lane & 15, fq = lane >> 4;
    const int K = g.K, nt = K / BK;
    unsigned voffA[2], voffB[2];
#pragma unroll
    for (int i = 0; i < 2; ++i) { int R, C; stage_rc(tid * 16 + i * 8192, R, C); const int Rb = Epi::PERM ? ((R & ~31) + perm32(R & 31)) : R;
        voffA[i] = g.a_tiled ? (unsigned)(R * BK + C) * 2u : (unsigned)(R * K + C) * 2u; voffB[i] = (unsigned)(Rb * K + C) * 2u; }
    const size_t kstep = (size_t)(BK * 2);
    const size_t hstep = (size_t)HALF * K * 2;
    const size_t tstep = 2 * hstep;
    const size_t kstepA = g.a_tiled ? (size_t)(BM * BK * 2) : kstep, hstepA = g.a_tiled ? (size_t)(HALF * BK * 2) : hstep, tstepA = g.a_tiled ? (size_t)(K / BK) * (BM * BK * 2) : tstep;
    const unsigned ldsw = (unsigned)wid * 1024u;
    const int aoff = lds_byte(wr * 64 + fr, fq * 8), boff = lds_byte(wc * 32 + fr, fq * 8);
#define PG8_SA(b, h) (((b) * 2 + (h)) * HTB)
#define PG8_SB(b, h) ((4 + (b) * 2 + (h)) * HTB)
#define PG8_STAGE(bufoff, gbase, voff) do { _Pragma("unroll") for (int _i = 0; _i < 2; ++_i) \
        __builtin_amdgcn_global_load_lds((const unsigned*)((const char*)(gbase) + (voff)[_i]), (PG8_LAS unsigned*)(lds + (bufoff) + ldsw + _i * 8192), 16, 0, 0); } while (0)
#define PG8_LDA(dst, b, h) do { _Pragma("unroll") for (int m = 0; m < 4; ++m) _Pragma("unroll") for (int k = 0; k < 2; ++k) dst[m][k] = *(const PG8_LAS bf16x8*)(lds + PG8_SA(b, h) + aoff + m * 2048 + k * 1024); } while (0)
#define PG8_LDB(dst, b, h) do { _Pragma("unroll") for (int n = 0; n < 2; ++n) _Pragma("unroll") for (int k = 0; k < 2; ++k) dst[n][k] = *(const PG8_LAS bf16x8*)(lds + PG8_SB(b, h) + boff + n * 2048 + k * 1024); } while (0)
#define PG8_MMA(ai, bj, At, Bt) do { __builtin_amdgcn_s_setprio(1); _Pragma("unroll") for (int m = 0; m < 4; ++m) _Pragma("unroll") for (int n = 0; n < 2; ++n) _Pragma("unroll") for (int k = 0; k < 2; ++k) \
        acc[ai][bj][m][n] = __builtin_amdgcn_mfma_f32_16x16x32_bf16(Bt[n][k], At[m][k], acc[ai][bj][m][n], 0, 0, 0); __builtin_amdgcn_s_setprio(0); } while (0)
#define PG8_WAIT_V(n) asm volatile("s_waitcnt vmcnt(" #n ")" ::: "memory")
#define PG8_WAIT_L(n) asm volatile("s_waitcnt lgkmcnt(" #n ")" ::: "memory")
#define PG8_BAR __builtin_amdgcn_s_barrier()
#define PG8_SCHED __builtin_amdgcn_sched_barrier(0)
    Unit cur, nxt; int ui = 0;
    if (!S.next(0, cur)) return;
    f32x4 acc[2][2][4][2];
#pragma unroll
    for (int a = 0; a < 2; ++a)
#pragma unroll
        for (int b = 0; b < 2; ++b)
#pragma unroll
            for (int m = 0; m < 4; ++m)
#pragma unroll
                for (int n = 0; n < 2; ++n) acc[a][b][m][n] = (f32x4){0.f, 0.f, 0.f, 0.f};
    bf16x8 At[4][2], B0[2][2], B1[2][2];
    const char* cA = (const char*)g.A + (size_t)cur.pm * tstepA; const char* cB = (const char*)g.Bt + (size_t)cur.pn * tstep;
    S.a_ready(cur);
    if constexpr (SP2) {
        PG8_STAGE(PG8_SB(0, 0), cB, voffB); PG8_STAGE(PG8_SB(0, 1), cB + hstep, voffB); PG8_STAGE(PG8_SA(0, 0), cA, voffA); PG8_STAGE(PG8_SA(0, 1), cA + hstepA, voffA);
        if (wr == 1) PG8_BAR;
        PG8_WAIT_V(2); PG8_BAR;
        PG8_STAGE(PG8_SB(1, 0), cB + kstep, voffB); PG8_STAGE(PG8_SA(1, 0), cA + kstepA, voffA); PG8_STAGE(PG8_SB(1, 1), cB + hstep + kstep, voffB);
        PG8_WAIT_V(6); PG8_BAR;
    } else {
        PG8_STAGE(PG8_SB(0, 0), cB, voffB); PG8_STAGE(PG8_SA(0, 0), cA, voffA); PG8_STAGE(PG8_SB(0, 1), cB + hstep, voffB); PG8_STAGE(PG8_SA(0, 1), cA + hstepA, voffA);
        if (wr == 1) PG8_BAR;
        PG8_WAIT_V(4); PG8_BAR;
        PG8_STAGE(PG8_SB(1, 0), cB + kstep, voffB); PG8_STAGE(PG8_SA(1, 0), cA + kstepA, voffA); PG8_STAGE(PG8_SB(1, 1), cB + hstep + kstep, voffB);
        PG8_WAIT_V(6); PG8_BAR;
    }
    for (;;) {
        const bool has_next = S.next(ui + 1, nxt);
        const char* nA = has_next ? (const char*)g.A + (size_t)nxt.pm * tstepA : cA; const char* nB = has_next ? (const char*)g.Bt + (size_t)nxt.pn * tstep : cB;
        for (int t = 0; t < nt; t += 2) {
            const bool last = (t == nt - 2);
            const char* a1 = cA + (size_t)(t + 1) * kstepA;
            const char* a2 = last ? nA : cA + (size_t)(t + 2) * kstepA; const char* b2 = last ? nB : cB + (size_t)(t + 2) * kstep;
            const char* a3 = a2 + kstepA; const char* b3 = b2 + kstep;
            if (last && has_next) S.a_ready(nxt);
            if constexpr (SP2) {
            PG8_LDB(B0, 0, 0); PG8_LDB(B1, 0, 1); PG8_SCHED; PG8_LDA(At, 0, 0); PG8_STAGE(PG8_SA(1, 1), a1 + hstepA, voffA);
            PG8_WAIT_V(8); PG8_WAIT_L(0); PG8_BAR; PG8_MMA(0, 0, At, B0); PG8_MMA(0, 1, At, B1); PG8_BAR; PG8_SCHED;
            PG8_LDA(At, 0, 1); PG8_STAGE(PG8_SB(0, 0), b2, voffB); PG8_STAGE(PG8_SB(0, 1), b2 + hstep, voffB); PG8_STAGE(PG8_SA(0, 0), a2, voffA);
            PG8_WAIT_V(8); PG8_WAIT_L(0); PG8_BAR; PG8_MMA(1, 0, At, B0); PG8_MMA(1, 1, At, B1); PG8_BAR; PG8_SCHED;
            PG8_LDB(B0, 1, 0); PG8_LDB(B1, 1, 1); PG8_SCHED; PG8_LDA(At, 1, 0); PG8_STAGE(PG8_SA(0, 1), a2 + hstepA, voffA);
            PG8_WAIT_V(8); PG8_WAIT_L(0); PG8_BAR; PG8_MMA(0, 0, At, B0); PG8_MMA(0, 1, At, B1); PG8_BAR; PG8_SCHED;
            PG8_LDA(At, 1, 1); PG8_STAGE(PG8_SB(1, 0), b3, voffB); PG8_STAGE(PG8_SB(1, 1), b3 + hstep, voffB); PG8_STAGE(PG8_SA(1, 0), a3, voffA);
            PG8_WAIT_V(8); PG8_WAIT_L(0); PG8_BAR; PG8_MMA(1, 0, At, B0); PG8_MMA(1, 1, At, B1); PG8_BAR; PG8_SCHED;
            } else {
            PG8_LDB(B0, 0, 0); PG8_SCHED; PG8_LDA(At, 0, 0); PG8_STAGE(PG8_SA(1, 1), a1 + hstepA, voffA);
            PG8_WAIT_L(8); PG8_BAR; PG8_WAIT_L(0); PG8_MMA(0, 0, At, B0); PG8_BAR; PG8_SCHED;
            PG8_LDB(B1, 0, 1); PG8_STAGE(PG8_SB(0, 0), b2, voffB);
            PG8_BAR; PG8_WAIT_L(0); PG8_MMA(0, 1, At, B1); PG8_BAR;
            PG8_LDA(At, 0, 1); PG8_STAGE(PG8_SA(0, 0), a2, voffA);
            PG8_BAR; PG8_WAIT_L(0); PG8_MMA(1, 0, At, B0); PG8_BAR; PG8_SCHED;
            PG8_STAGE(PG8_SB(0, 1), b2 + hstep, voffB);
            PG8_WAIT_V(6); PG8_BAR; PG8_MMA(1, 1, At, B1); PG8_BAR;
            PG8_LDB(B0, 1, 0); PG8_SCHED; PG8_LDA(At, 1, 0); PG8_STAGE(PG8_SA(0, 1), a2 + hstepA, voffA);
            PG8_WAIT_L(8); PG8_BAR; PG8_WAIT_L(0); PG8_MMA(0, 0, At, B0); PG8_BAR; PG8_SCHED;
            PG8_LDB(B1, 1, 1); PG8_STAGE(PG8_SB(1, 0), b3, voffB);
            PG8_BAR; PG8_WAIT_L(0); PG8_MMA(0, 1, At, B1); PG8_BAR;
            PG8_LDA(At, 1, 1); PG8_STAGE(PG8_SA(1, 0), a3, voffA);
            PG8_BAR; PG8_WAIT_L(0); PG8_MMA(1, 0, At, B0); PG8_BAR; PG8_SCHED;
            PG8_STAGE(PG8_SB(1, 1), b3 + hstep, voffB);
            PG8_WAIT_V(6); PG8_BAR; PG8_MMA(1, 1, At, B1); PG8_BAR;
            }
        }
        if constexpr (ALIGN_EPI) { if (wr == 0) PG8_BAR; }
        if constexpr (!Epi::AFTER_DRAIN) { E(acc, cur, wr, wc, fr, fq); S.done(cur); }
        if (!has_next) break;
#pragma unroll
        for (int a = 0; a < 2; ++a)
#pragma unroll
            for (int b = 0; b < 2; ++b)
#pragma unroll
                for (int m = 0; m < 4; ++m)
#pragma unroll
                    for (int n = 0; n < 2; ++n) acc[a][b][m][n] = (f32x4){0.f, 0.f, 0.f, 0.f};
        cur = nxt; cA = nA; cB = nB; ++ui;
        if constexpr (ALIGN_EPI) { if (wr == 1) PG8_BAR; }
    }
    PG8_WAIT_V(0);
    if constexpr (!ALIGN_EPI) { if (wr == 0) PG8_BAR; }
    PG8_BAR;
    if constexpr (Epi::AFTER_DRAIN) { E.fused(acc, cur, wr, wc, fr, fq, lds, wid, lane); S.done(cur); }
#undef PG8_SA
#undef PG8_SB
#undef PG8_STAGE
#undef PG8_LDA
#undef PG8_LDB
#undef PG8_MMA
#undef PG8_WAIT_V
#undef PG8_WAIT_L
#undef PG8_BAR
#undef PG8_SCHED
}
}
namespace att {
#ifdef ATT_NOMASK
constexpr bool defined_NOMASK = true;
#else
constexpr bool defined_NOMASK = false;
#endif
typedef unsigned short bf16_t;
using bf16x8 = __attribute__((ext_vector_type(8))) short;
using s16x4  = __attribute__((ext_vector_type(4))) short;
using f32x16 = __attribute__((ext_vector_type(16))) float;
using u32x4  = __attribute__((ext_vector_type(4))) unsigned;
constexpr int KVBLK = 64;
constexpr int SHM_V = 16384, SHM_K = 16384;
constexpr int LDS_WS = 2 * SHM_V + 2 * SHM_K;
constexpr int LDS_X = LDS_WS + 8 * 64 * 4;
constexpr int LDS_MISC = LDS_X + 4 * 32 * 128 * 4;
constexpr int LDS_BYTES = LDS_MISC + 64;
constexpr float LOG2E = 1.4426950408889634f;
#define GASQ __attribute__((address_space(1)))
#define KSWZ(row, colB) ((row) * 256 + ((colB) ^ (((row) & 7) << 4)))
#define SBAR() __builtin_amdgcn_sched_barrier(0)
__device__ __forceinline__ int crow(int r, int hi) { return (r & 3) + 8 * (r >> 2) + 4 * hi; }
__device__ __forceinline__ unsigned cvtpk(float lo, float hi) { unsigned r; asm volatile("v_cvt_pk_bf16_f32 %0, %1, %2" : "=v"(r) : "v"(lo), "v"(hi)); return r; }

#ifndef ATT_SDEPTH0
#define ATT_SDEPTH0 2
#endif
#ifndef ATT_QLDS0
#define ATT_QLDS0 1
#endif
template <int MODE> struct Cfg {
    static constexpr float SCALE = (MODE == 0) ? 0.088388347648318440f : 0.125f;
    static constexpr float C = SCALE * LOG2E;
    static constexpr float THRS = 8.f / SCALE;
    static constexpr int ND0 = (MODE == 0) ? 8 : 4;
    static constexpr int SDEPTH = (MODE == 0) ? ATT_SDEPTH0 : 2;
    static constexpr bool QLDS = (MODE == 0) && (ATT_QLDS0 != 0);
};

template <int MODE>
__device__ __forceinline__ void partialSM(f32x16& p0, f32x16& p1, float& m_reg, float& mn, float& alpha) {
  constexpr float C = Cfg<MODE>::C;
  float pmax = p0[0];
#pragma unroll
  for (int r = 1; r < 16; ++r) pmax = fmaxf(pmax, p0[r]);
#pragma unroll
  for (int r = 0; r < 16; ++r) pmax = fmaxf(pmax, p1[r]);
  { auto rr = __builtin_amdgcn_permlane32_swap(__float_as_uint(pmax), __float_as_uint(pmax), false, false);
    pmax = fmaxf(__uint_as_float(rr[0]), __uint_as_float(rr[1])); }
  if (__builtin_expect(__all(pmax - m_reg <= Cfg<MODE>::THRS), 1)) { mn = m_reg; alpha = 1.f; }
  else { mn = fmaxf(m_reg, pmax); alpha = __builtin_amdgcn_exp2f((m_reg - mn) * C); m_reg = mn; }
  const float mnC = -mn * C;
#pragma unroll
  for (int r = 0; r < 16; ++r) p0[r] = fmaf(p0[r], C, mnC);
#pragma unroll
  for (int r = 0; r < 16; ++r) p1[r] = fmaf(p1[r], C, mnC);
#pragma unroll
  for (int r = 0; r < 16; ++r) p0[r] = __builtin_amdgcn_exp2f(p0[r]);
}
__device__ __forceinline__ void finishSM(f32x16& p0, f32x16& p1, float alpha, float& l_reg, bf16x8& pa0, bf16x8& pa1, bf16x8& pa2, bf16x8& pa3) {
#pragma unroll
  for (int r = 0; r < 16; ++r) p1[r] = __builtin_amdgcn_exp2f(p1[r]);
  float ps = 0;
#pragma unroll
  for (int r = 0; r < 16; ++r) ps += p0[r];
#pragma unroll
  for (int r = 0; r < 16; ++r) ps += p1[r];
  { auto rr = __builtin_amdgcn_permlane32_swap(__float_as_uint(ps), __float_as_uint(ps), false, false);
    ps = __uint_as_float(rr[0]) + __uint_as_float(rr[1]); }
  l_reg = l_reg * alpha + ps;
#define PK4(P, BASE, OUT) do { unsigned a0 = cvtpk(P[BASE + 0], P[BASE + 1]), a1 = cvtpk(P[BASE + 2], P[BASE + 3]);   \
    unsigned b0 = cvtpk(P[BASE + 4], P[BASE + 5]), b1 = cvtpk(P[BASE + 6], P[BASE + 7]);                              \
    auto r0 = __builtin_amdgcn_permlane32_swap(a0, b0, false, false); auto r1 = __builtin_amdgcn_permlane32_swap(a1, b1, false, false); \
    u32x4 w = {r0[0], r1[0], r0[1], r1[1]}; OUT = *reinterpret_cast<bf16x8*>(&w); } while (0)
  PK4(p0, 0, pa0); PK4(p0, 8, pa1); PK4(p1, 0, pa2); PK4(p1, 8, pa3);
#undef PK4
}
template <int MODE, bool QLDS>
__device__ __forceinline__ void qkt(f32x16& p0, f32x16& p1, const char* Ks, const bf16x8* qr, const char* qs, int r32, int hi, int comp) {
  p0 = f32x16{}; p1 = f32x16{};
  int rb = r32; asm volatile("" : "+v"(rb));
  const int swz = (rb & 7) << 4, rowb = rb * 256 + comp * 128;
  const char* a0 = Ks + rowb + ((0 * 32 + hi * 16) ^ swz); const char* a1 = Ks + rowb + ((1 * 32 + hi * 16) ^ swz);
  const char* a2 = Ks + rowb + ((2 * 32 + hi * 16) ^ swz); const char* a3 = Ks + rowb + ((3 * 32 + hi * 16) ^ swz);
#pragma unroll
  for (int d0 = 0; d0 < Cfg<MODE>::ND0; ++d0) { const int dl = d0 & 3, dh = d0 >> 2; const char* ap = (dl == 0 ? a0 : dl == 1 ? a1 : dl == 2 ? a2 : a3) + dh * 128;
    bf16x8 b0 = *reinterpret_cast<const bf16x8*>(ap);
    bf16x8 b1 = *reinterpret_cast<const bf16x8*>(ap + 8192);
    bf16x8 q; if constexpr (QLDS) q = *reinterpret_cast<const bf16x8*>(qs + d0 * 1024); else q = qr[d0];
    p0 = __builtin_amdgcn_mfma_f32_32x32x16_bf16(b0, q, p0, 0, 0, 0);
    p1 = __builtin_amdgcn_mfma_f32_32x32x16_bf16(b1, q, p1, 0, 0, 0); }
}
__device__ __forceinline__ int v_st(int k, int c) { const int kk = (k & ~0xC) | ((k & 4) << 1) | ((k & 8) >> 1); return ((kk >> 3) * 4 + (c >> 5)) * 512 + ((kk & 7) * 32 + (c & 31)) * 2; }
__device__ __forceinline__ int v_rd_base(int lane) { return ((lane & 3) << 3) | (((lane >> 2) & 3) << 6) | (((lane >> 4) & 1) << 5) | (((lane >> 5) & 1) << 8); }
constexpr int v_rd_off(int d0, int ks, int half) { return d0 * 512 + ks * 4096 + half * 2048; }
template <int OFF> __device__ __forceinline__ s16x4 tr_read(int vb) {
  s16x4 r; asm volatile("ds_read_b64_tr_b16 %0, %1 offset:%2" : "=&v"(r) : "v"(vb), "i"(OFF) : "memory"); return r;
}
template <int D0> __device__ __forceinline__ void pv_one(f32x16& od, int vb, bf16x8 pa0, bf16x8 pa1, bf16x8 pa2, bf16x8 pa3) {
  const s16x4 l0 = tr_read<v_rd_off(D0, 0, 0)>(vb), h0 = tr_read<v_rd_off(D0, 0, 1)>(vb), l1 = tr_read<v_rd_off(D0, 1, 0)>(vb), h1 = tr_read<v_rd_off(D0, 1, 1)>(vb);
  const s16x4 l2 = tr_read<v_rd_off(D0, 2, 0)>(vb), h2 = tr_read<v_rd_off(D0, 2, 1)>(vb), l3 = tr_read<v_rd_off(D0, 3, 0)>(vb), h3 = tr_read<v_rd_off(D0, 3, 1)>(vb);
  asm volatile("s_waitcnt lgkmcnt(0)" ::: "memory"); SBAR();
#define PK(L, H) (bf16x8){L[0], L[1], L[2], L[3], H[0], H[1], H[2], H[3]}
  od = __builtin_amdgcn_mfma_f32_32x32x16_bf16(pa0, PK(l0, h0), od, 0, 0, 0);
  od = __builtin_amdgcn_mfma_f32_32x32x16_bf16(pa1, PK(l1, h1), od, 0, 0, 0);
  od = __builtin_amdgcn_mfma_f32_32x32x16_bf16(pa2, PK(l2, h2), od, 0, 0, 0);
  od = __builtin_amdgcn_mfma_f32_32x32x16_bf16(pa3, PK(l3, h3), od, 0, 0, 0);
#undef PK
}
__device__ __forceinline__ void pv_d0(f32x16* o, int vb, bf16x8 pa0, bf16x8 pa1, bf16x8 pa2, bf16x8 pa3) {
  pv_one<0>(o[0], vb, pa0, pa1, pa2, pa3); pv_one<1>(o[1], vb, pa0, pa1, pa2, pa3); pv_one<2>(o[2], vb, pa0, pa1, pa2, pa3); pv_one<3>(o[3], vb, pa0, pa1, pa2, pa3);
}

struct UnitArgs {
    const bf16_t* Qb; int ldq;
    const bf16_t* Kh; const bf16_t* Vh;
    bf16_t* Ob; int ldo;
    int NT;
    int jwin, wadd;
    int masked, t0;
    float sinkl2;
    float lam;
    const float* subg;
    const float* qg;
    const float* ropeT;
    int rope;
};

template <int MODE>
__device__ __forceinline__ void attn_unit(const UnitArgs& A, char* lds) {
  constexpr float C = Cfg<MODE>::C; constexpr int ND0 = Cfg<MODE>::ND0;
  int tid_ = threadIdx.x; asm volatile("" : "+v"(tid_));
  const int tid = tid_, wid = tid >> 6, lane = tid & 63, r32 = lane & 31, hi = lane >> 5;
  const int wq = (MODE == 0) ? wid : (wid & 3), comp = (MODE == 0) ? 0 : (wid >> 2);
  char* V_lds = lds; char* K_lds = lds + 2 * SHM_V;
  float* ws = (float*)(lds + LDS_WS) + wid * 64; float* li_l = ws; float* al_l = ws + 32;
  constexpr bool QLDS = Cfg<MODE>::QLDS;
  __syncthreads();
  float m_reg = -1e30f, l_reg = 0; f32x16 o[4] = {}; bf16x8 qr[QLDS ? 1 : ND0];
  char* qs = lds + LDS_X + wid * 8192 + lane * 16;
  const bf16_t* Qw = A.Qb + (long)(wq * 32 + r32) * A.ldq + comp * 64 + hi * 8;
  const int sr = tid >> 4, sc = (tid & 15) * 8, vst0 = v_st(sr, sc), vst1 = v_st(32 + sr, sc);
  const int vb0 = (int)(uintptr_t)V_lds + v_rd_base(lane);
  const unsigned loff0 = (unsigned)(sr * 128 + sc) * 2u, loff1 = loff0 + 32u * 256u;
  const bf16_t* Kh = A.Kh; const bf16_t* Vh = A.Vh; const int NT = A.NT, jwin = A.jwin, wadd = A.wadd;
  constexpr int SDEPTH = Cfg<MODE>::SDEPTH;
  struct { bf16x8 vs0, vs1, ks0, ks1; } sr_[SDEPTH];
#define KOFF(j) (64 * (j) + (((j) >= jwin) ? wadd : 0))
#define SLOAD(i, k0) do { const size_t _kb = (size_t)(k0) * 256; const char* _vp = (const char*)Vh + _kb; const char* _kp = (const char*)Kh + _kb; \
    sr_[i].vs0 = *(const GASQ bf16x8*)(_vp + loff0); sr_[i].vs1 = *(const GASQ bf16x8*)(_vp + loff1); \
    sr_[i].ks0 = *(const GASQ bf16x8*)(_kp + loff0); sr_[i].ks1 = *(const GASQ bf16x8*)(_kp + loff1); } while (0)
#define SWRITE(b, i) do { *(bf16x8*)(V_lds + (b) * SHM_V + vst0) = sr_[i].vs0;          \
    *(bf16x8*)(V_lds + (b) * SHM_V + vst1) = sr_[i].vs1; const int kc = sc * 2;               \
    *(bf16x8*)(K_lds + (b) * SHM_K + KSWZ(sr, kc)) = sr_[i].ks0;                       \
    *(bf16x8*)(K_lds + (b) * SHM_K + KSWZ(32 + sr, kc)) = sr_[i].ks1; } while (0)
#define SWAIT() do { if constexpr (SDEPTH == 2) asm volatile("s_waitcnt vmcnt(4)" ::: "memory"); else asm volatile("s_waitcnt vmcnt(0)" ::: "memory"); } while (0)
#define RESC(a) do { if (__any((a) < 1.f)) { if (hi == 0) al_l[r32] = (a); asm volatile("s_waitcnt lgkmcnt(0)" ::: "memory"); \
    _Pragma("unroll") for (int d = 0; d < 4; ++d) _Pragma("unroll") for (int r = 0; r < 16; ++r) o[d][r] *= al_l[crow(r, hi)]; } } while (0)
#define MASKT(P0, P1, j) do { if (MODE == 0 && !defined_NOMASK && A.masked && (j) >= jwin) { const int kp0 = KOFF(j) - 512, qw0 = A.t0 + wq * 32; \
    if (kp0 < qw0 + 31 - 128 || kp0 + 63 > qw0 + 128) { const int dkb = kp0 - qw0 - r32 + 4 * hi + 128; \
      _Pragma("unroll") for (int r = 0; r < 16; ++r) { const int cr = (r & 3) + 8 * (r >> 2); if ((unsigned)(dkb + cr) > 256u) P0[r] = -1e30f; if ((unsigned)(dkb + cr + 32) > 256u) P1[r] = -1e30f; } } } } while (0)
  constexpr int SE = 0, SO = SDEPTH - 1;
  {
    typedef float f32x4q __attribute__((ext_vector_type(4)));
    float x[ND0][8]; float ss = 0.f;
#pragma unroll
    for (int d0 = 0; d0 < ND0; ++d0) { const u32x4 raw = *reinterpret_cast<const u32x4*>(Qw + d0 * 16);
#pragma unroll
      for (int e = 0; e < 4; ++e) { x[d0][2 * e] = __uint_as_float(raw[e] << 16); x[d0][2 * e + 1] = __uint_as_float(raw[e] & 0xffff0000u); }
#pragma unroll
      for (int j = 0; j < 8; ++j) ss += x[d0][j] * x[d0][j]; }
    ss += __shfl_xor(ss, 32);
    const float rstd = __builtin_amdgcn_rsqf(ss * (1.f / (16.f * ND0)) + 1e-6f);
#pragma unroll
    for (int d0 = 0; d0 < ND0; ++d0) { const f32x4q g0 = *(const GASQ f32x4q*)(A.qg + d0 * 16 + hi * 8), g1 = *(const GASQ f32x4q*)(A.qg + d0 * 16 + hi * 8 + 4);
      x[d0][0] *= rstd * g0.x; x[d0][1] *= rstd * g0.y; x[d0][2] *= rstd * g0.z; x[d0][3] *= rstd * g0.w; x[d0][4] *= rstd * g1.x; x[d0][5] *= rstd * g1.y; x[d0][6] *= rstd * g1.z; x[d0][7] *= rstd * g1.w; }
    if (A.rope) {
      const int t = A.t0 + wq * 32 + r32;
      if (MODE == 0) {
#pragma unroll
        for (int ax = 0; ax < 2; ++ax) { const int pos = ax ? (t & 63) : (t >> 6);
#pragma unroll
          for (int e = 0; e < 2; ++e) { const float* cp = A.ropeT + pos * 32 + 16 * e + 8 * hi;
            const f32x4q c0 = *(const GASQ f32x4q*)(cp), c1 = *(const GASQ f32x4q*)(cp + 4), s0 = *(const GASQ f32x4q*)(cp + 2048), s1 = *(const GASQ f32x4q*)(cp + 2048 + 4);
            const float cs[8] = {c0.x, c0.y, c0.z, c0.w, c1.x, c1.y, c1.z, c1.w}, sn[8] = {s0.x, s0.y, s0.z, s0.w, s1.x, s1.y, s1.z, s1.w};
            const int d1 = 4 * ax + e, d2 = d1 + 2;
#pragma unroll
            for (int j = 0; j < 8; ++j) { const float x1 = x[d1 % ND0][j], x2 = x[d2 % ND0][j]; x[d1 % ND0][j] = x1 * cs[j] - x2 * sn[j]; x[d2 % ND0][j] = x2 * cs[j] + x1 * sn[j]; } } }
      } else {
#pragma unroll
        for (int ax = 0; ax < 2; ++ax) { const int pos = ax ? (t & 63) : (t >> 6); const float* cp = A.ropeT + 4096 + pos * 16 + 8 * hi;
          const f32x4q c0 = *(const GASQ f32x4q*)(cp), c1 = *(const GASQ f32x4q*)(cp + 4), s0 = *(const GASQ f32x4q*)(cp + 1024), s1 = *(const GASQ f32x4q*)(cp + 1024 + 4);
          const float cs[8] = {c0.x, c0.y, c0.z, c0.w, c1.x, c1.y, c1.z, c1.w}, sn[8] = {s0.x, s0.y, s0.z, s0.w, s1.x, s1.y, s1.z, s1.w};
          const int d1 = (2 * ax) % ND0, d2 = (2 * ax + 1) % ND0;
#pragma unroll
          for (int j = 0; j < 8; ++j) { const float x1 = x[d1][j], x2 = x[d2][j]; x[d1][j] = x1 * cs[j] - x2 * sn[j]; x[d2][j] = x2 * cs[j] + x1 * sn[j]; } }
      }
    }
#pragma unroll
    for (int d0 = 0; d0 < ND0; ++d0) { u32x4 w = {cvtpk(x[d0][0], x[d0][1]), cvtpk(x[d0][2], x[d0][3]), cvtpk(x[d0][4], x[d0][5]), cvtpk(x[d0][6], x[d0][7])};
      if constexpr (QLDS) *reinterpret_cast<u32x4*>(qs + d0 * 1024) = w; else qr[d0] = *reinterpret_cast<bf16x8*>(&w); }
  }
  f32x16 pA0, pA1, pB0, pB1; float mnA, mnB, alA, alB; bf16x8 pa0, pa1, pa2, pa3;
  SLOAD(SE, KOFF(0)); asm volatile("s_waitcnt vmcnt(0)" ::: "memory"); SWRITE(0, SE); __syncthreads();
  qkt<MODE, QLDS>(pA0, pA1, K_lds, qr, qs, r32, hi, comp); MASKT(pA0, pA1, 0); partialSM<MODE>(pA0, pA1, m_reg, mnA, alA);
  SLOAD(SO, KOFF(1)); if constexpr (SDEPTH == 2) { if (2 < NT) SLOAD(SE, KOFF(2)); }
  SWAIT(); SWRITE(1, SO); __syncthreads();
  for (int j = 1; j + 1 < NT; j += 2) {
    SBAR(); qkt<MODE, QLDS>(pB0, pB1, K_lds + SHM_K, qr, qs, r32, hi, comp);
    finishSM(pA0, pA1, alA, l_reg, pa0, pa1, pa2, pa3); SBAR();
    SLOAD(SO, KOFF(j + SDEPTH)); SBAR();
    pv_d0(o, vb0, pa0, pa1, pa2, pa3); MASKT(pB0, pB1, j); partialSM<MODE>(pB0, pB1, m_reg, mnB, alB);
    __syncthreads(); SWAIT(); SWRITE(0, SE);
    RESC(alB); __syncthreads();
    SBAR(); qkt<MODE, QLDS>(pA0, pA1, K_lds, qr, qs, r32, hi, comp);
    finishSM(pB0, pB1, alB, l_reg, pa0, pa1, pa2, pa3); SBAR();
    if (SDEPTH == 1 || j + 3 < NT) SLOAD(SE, KOFF(j + 1 + SDEPTH)); SBAR();
    pv_d0(o, vb0 + SHM_V, pa0, pa1, pa2, pa3); MASKT(pA0, pA1, j + 1); partialSM<MODE>(pA0, pA1, m_reg, mnA, alA);
    __syncthreads(); SWAIT(); SWRITE(1, SO);
    RESC(alA); __syncthreads();
  }
  SBAR(); qkt<MODE, QLDS>(pB0, pB1, K_lds + SHM_K, qr, qs, r32, hi, comp);
  finishSM(pA0, pA1, alA, l_reg, pa0, pa1, pa2, pa3); SBAR();
  pv_d0(o, vb0, pa0, pa1, pa2, pa3); MASKT(pB0, pB1, NT - 1); partialSM<MODE>(pB0, pB1, m_reg, mnB, alB);
  __syncthreads(); RESC(alB);
  finishSM(pB0, pB1, alB, l_reg, pa0, pa1, pa2, pa3); SBAR();
  pv_d0(o, vb0 + SHM_V, pa0, pa1, pa2, pa3);
  if (MODE == 0) l_reg += __builtin_amdgcn_exp2f(A.sinkl2 - m_reg * C);
  if (hi == 0) li_l[r32] = l_reg;
  asm volatile("s_waitcnt lgkmcnt(0)" ::: "memory");
  float rli[16];
#pragma unroll
  for (int r = 0; r < 16; ++r) rli[r] = __builtin_amdgcn_rcpf(li_l[crow(r, hi)]);
  bf16_t* Ow = A.Ob + (long)(wq * 32) * A.ldo;
  const int odd = lane & 1;
  int t2_ = threadIdx.x; asm volatile("" : "+v"(t2_));
  const int lane2 = t2_ & 63, r32b = lane2 & 31, hib = lane2 >> 5;
  char* stg = lds + LDS_X + ((MODE == 0) ? (t2_ >> 6) * 8192 : ((t2_ >> 6) & 3) * 16384);
  if (MODE == 0) {
#pragma unroll
    for (int d0 = 0; d0 < 4; ++d0)
#pragma unroll
      for (int rp = 0; rp < 8; ++rp) {
        const float a = o[d0][2 * rp] * rli[2 * rp], b = o[d0][2 * rp + 1] * rli[2 * rp + 1];
        const float send = odd ? a : b; const float recv = __shfl_xor(send, 1);
        const float lo = odd ? recv : a, hh = odd ? b : recv;
        const int row = crow(2 * rp + odd, hib);
        *(unsigned*)(stg + row * 256 + (d0 * 32 + (r32b & ~1)) * 2) = cvtpk(lo, hh);
      }
  } else {
    float* X = (float*)(lds + LDS_X) + wq * (32 * 128);
    if (comp == 1) {
      const float lam = A.lam;
#pragma unroll
      for (int d0 = 0; d0 < 4; ++d0)
#pragma unroll
        for (int r = 0; r < 16; ++r) X[crow(r, hi) * 128 + d0 * 32 + r32] = o[d0][r] * rli[r] * lam;
    }
    __syncthreads();
    if (comp == 0) {
      float rs[16];
#pragma unroll
      for (int r = 0; r < 16; ++r) { float ss = 0.f;
#pragma unroll
        for (int d0 = 0; d0 < 4; ++d0) { const float v = o[d0][r] * rli[r] - X[crow(r, hi) * 128 + d0 * 32 + r32]; o[d0][r] = v; ss += v * v; }
        ss += __shfl_xor(ss, 1); ss += __shfl_xor(ss, 2); ss += __shfl_xor(ss, 4); ss += __shfl_xor(ss, 8); ss += __shfl_xor(ss, 16);
        rs[r] = __builtin_amdgcn_rsqf(ss * (1.f / 128.f) + 1e-6f) * 0.8f; }
      asm volatile("s_waitcnt lgkmcnt(0)" ::: "memory");
#pragma unroll
      for (int d0 = 0; d0 < 4; ++d0) { const float g = A.subg[d0 * 32 + r32];
#pragma unroll
        for (int rp = 0; rp < 8; ++rp) {
          const float a = o[d0][2 * rp] * rs[2 * rp] * g, b = o[d0][2 * rp + 1] * rs[2 * rp + 1] * g;
          const float send = odd ? a : b; const float recv = __shfl_xor(send, 1);
          const float lo = odd ? recv : a, hh = odd ? b : recv;
          const int row = crow(2 * rp + odd, hib);
          *(unsigned*)(stg + row * 256 + (d0 * 32 + (r32b & ~1)) * 2) = cvtpk(lo, hh);
        } }
    }
  }
  if (MODE == 0 || comp == 0) {
    asm volatile("s_waitcnt lgkmcnt(0)" ::: "memory");
    const int srow = lane2 >> 4, sch = lane2 & 15;
#pragma unroll
    for (int i = 0; i < 8; ++i) { const int row = srow + 4 * i; const u32x4 v = *(const u32x4*)(stg + row * 256 + sch * 16);
      *(u32x4*)(Ow + (long)row * A.ldo + sch * 8) = v; }
  }
#undef KOFF
#undef SLOAD
#undef SWRITE
#undef SWAIT
#undef RESC
#undef MASKT
}
#undef KSWZ
#undef GASQ
#undef SBAR
}

#define GAS __attribute__((address_space(1)))
#define LAS __attribute__((address_space(3)))
typedef unsigned short bf16;
typedef unsigned v4u __attribute__((ext_vector_type(4)));
typedef float f32x4 __attribute__((ext_vector_type(4)));
typedef short bf16x8 __attribute__((ext_vector_type(8)));
typedef GAS unsigned gu32;
typedef GAS unsigned long long gu64;
#define RLX_AGENT __ATOMIC_RELAXED, __HIP_MEMORY_SCOPE_AGENT
#define LDS_WAIT() asm volatile("s_waitcnt lgkmcnt(0)" ::: "memory")
#define VM_WAIT() asm volatile("s_waitcnt vmcnt(0)" ::: "memory")
__device__ __forceinline__ unsigned long long rt() { return __builtin_amdgcn_s_memrealtime(); }
__device__ __forceinline__ unsigned f2bf(float f) { unsigned u = __builtin_bit_cast(unsigned, f); return (u + 0x7fffu + ((u >> 16) & 1u)) >> 16; }
__device__ __forceinline__ unsigned pk2(float lo, float hi) { return f2bf(lo) | (f2bf(hi) << 16); }

#define XB_TMO      128
#define XB_XCNT(j)  (256  + 64 * (j))
#define XB_XSUB(j)  (1280 + 64 * (j))
#define XB_XGEN(j)  (2304 + 64 * (j))
#define XB_TOP      3328
#define XB_TOPGEN   3392
#define XCD_BAR_WORDS 3456
#define XB_SPIN_CAP (1u << 18)

__device__ __forceinline__ unsigned xb_ld(unsigned* p)              { return __hip_atomic_load(p, __ATOMIC_RELAXED, __HIP_MEMORY_SCOPE_AGENT); }
__device__ __forceinline__ unsigned xb_add(unsigned* p, unsigned v) { return __hip_atomic_fetch_add(p, v, __ATOMIC_RELAXED, __HIP_MEMORY_SCOPE_AGENT); }
__device__ __forceinline__ unsigned xb_xcc_id() { return (unsigned)__builtin_amdgcn_s_getreg((3 << 11) | 20) & 0xFu; }
#define XB_SPIN(cond, bar) do { unsigned _sp = 0; while (cond) { __builtin_amdgcn_s_sleep(1); \
    if ((++_sp & 255u) == 0u) { if (xb_ld(&(bar)[XB_TMO])) break; if (_sp > XB_SPIN_CAP) { atomicAdd(&(bar)[XB_TMO], 1u); break; } } } } while (0)

struct XcdBarrier {
    unsigned* bar; unsigned x;
    volatile LAS unsigned* st;
};

__device__ __forceinline__ XcdBarrier xcd_barrier_post(unsigned* bar, volatile LAS unsigned* st) {
    XcdBarrier b; b.bar = bar; b.x = xb_xcc_id(); b.st = st;
    if (threadIdx.x == 0) (void)xb_add(&bar[XB_XCNT(b.x)], 1u);
    return b;
}
__device__ __forceinline__ void xcd_barrier_complete(unsigned* bar, unsigned x, unsigned& nloc, unsigned& nx) {
    const unsigned G = gridDim.x * gridDim.y * gridDim.z;
    unsigned sum, cnt, mine, sp = 0u;
    for (;;) {
        sum = 0u; cnt = 0u; mine = 0u;
#pragma unroll
        for (unsigned j = 0; j < 16; ++j) { const unsigned c = xb_ld(&bar[XB_XCNT(j)]); sum += c; cnt += (c > 0u) ? 1u : 0u; mine = (j == x) ? c : mine; }
        if (sum == G) break;
        __builtin_amdgcn_s_sleep(1);
        if ((++sp & 255u) == 0u) { if (xb_ld(&bar[XB_TMO])) break; if (sp > XB_SPIN_CAP) { atomicAdd(&bar[XB_TMO], 1u); break; } }
    }
    nloc = mine > 0u ? mine : 1u; nx = cnt > 0u ? cnt : 1u;
}

__device__ __forceinline__ void xcd_barrier(const XcdBarrier& b) {
    asm volatile("s_waitcnt vmcnt(0)" ::: "memory");
    __syncthreads();
    if (threadIdx.x == 0) {
        unsigned* bar = b.bar;
        __builtin_amdgcn_s_waitcnt(0);
        unsigned nloc = b.st[0], nx = b.st[1];
        if (nloc == 0u) { xcd_barrier_complete(bar, b.x, nloc, nx); b.st[0] = nloc; b.st[1] = nx; }
        const unsigned old = xb_add(&bar[XB_XSUB(b.x)], 1u);
        const unsigned gen = old / nloc;
        if (old + 1u == (gen + 1u) * nloc) {
            __builtin_amdgcn_fence(__ATOMIC_RELEASE, "agent");
            asm volatile("s_waitcnt vmcnt(0)" ::: "memory");
            const unsigned og = xb_add(&bar[XB_TOP], 1u);
            const unsigned tg = og / nx;
            if (og + 1u == (tg + 1u) * nx) xb_add(&bar[XB_TOPGEN], 1u);
            else XB_SPIN(xb_ld(&bar[XB_TOPGEN]) == tg, bar);
            __builtin_amdgcn_fence(__ATOMIC_ACQUIRE, "agent");
            xb_add(&bar[XB_XGEN(b.x)], 1u);
            asm volatile("s_waitcnt vmcnt(0)" ::: "memory");
        } else {
            XB_SPIN(xb_ld(&bar[XB_XGEN(b.x)]) == gen, bar);
            __builtin_amdgcn_fence(__ATOMIC_ACQUIRE, "agent");
            asm volatile("s_waitcnt vmcnt(0)" ::: "memory");
        }
    }
    __syncthreads();
}
#ifndef MK_N_LAUNCHES
#define MK_N_LAUNCHES 1
#endif
constexpr int NPH = 9;
constexpr int N_LAUNCHES = MK_N_LAUNCHES;
constexpr int NWAVES = 8;

constexpr int DM = 4096, DIN = 6144, DFF = 16384, NMOD = 6 * DM;
constexpr int NB_P = 16, T_P = 256, NB_S = 8, T_S = 1024, LCTX = 512;
constexpr int M_P = NB_P * T_P, M_S = NB_S * T_S, MTOK = M_P + M_S;
constexpr int KSPLIT = 8;
constexpr int KVL = LCTX + T_S;
constexpr float EPS = 1e-6f;

constexpr size_t MiB = 1u << 20;
constexpr size_t WS_CTL = 0, CTL_ZERO_BYTES = 64 * 1024;
constexpr size_t WS_MODP = 1 * MiB;
constexpr size_t WS_MODF = 8 * MiB;
constexpr size_t WS_ROPE = 9 * MiB;
constexpr size_t WS_WIN = 16 * MiB, WS_WOUT = 64 * MiB, WS_WFC1 = 96 * MiB, WS_WFC2 = 224 * MiB;
constexpr size_t WS_H = 352 * MiB;
constexpr size_t WS_P = 448 * MiB;
constexpr size_t WS_O = 592 * MiB;
constexpr size_t WS_KVL = 688 * MiB, KVL_SZ = (size_t)NB_S * 4 * KVL * 128 * 2;
constexpr size_t WS_KVP = 736 * MiB, KVP_SZ = (size_t)NB_P * 4 * T_P * 128 * 2;
constexpr size_t WS_U = 752 * MiB;
constexpr size_t WS_X1B = 1136 * MiB;
constexpr size_t WS_END = 1232 * MiB;
static_assert(WS_MODP + (size_t)KSPLIT * 9 * NMOD * 4 <= WS_MODF && WS_MODF + (size_t)9 * NMOD * 4 <= WS_WIN, "ws map");
static_assert(KVL_SZ == 12 * MiB && KVP_SZ == 4 * MiB && WS_U + (size_t)MTOK * DFF * 2 == WS_X1B && WS_X1B + (size_t)MTOK * DM * 2 == WS_END, "ws map");
constexpr int CW_Q = 64;
constexpr int CW_BAR = 4096;
static_assert((CW_BAR + 3456) * 4 <= (int)CTL_ZERO_BYTES, "barrier words inside the per-call memset");

constexpr int RING_BYTES = 131072;
constexpr int MISC_OFF = 143360;
constexpr int LDS_BYTES = 147456;
static_assert(att::LDS_BYTES <= MISC_OFF && RING_BYTES <= MISC_OFF && MISC_OFF + 128 <= LDS_BYTES && 8 * 64 * 68 * 4 <= MISC_OFF, "LDS map");

__device__ __forceinline__ float wave_sum(float v) {
#pragma unroll
    for (int o = 1; o < 64; o <<= 1) v += __shfl_xor(v, o);
    return v;
}
__device__ __forceinline__ float bf2f(unsigned short b) { return __uint_as_float(((unsigned)b) << 16); }

__device__ __forceinline__ int fresh_tid() { int t = threadIdx.x; asm volatile("" : "+v"(t)); return t; }
struct Args { const float* in[26]; float* out; unsigned char* ws; int ph_lo, ph_hi; };

constexpr int TR_LDS = 64 * 68 * 4;
__device__ __forceinline__ unsigned cvtpk_rne(float lo, float hi) { unsigned r; asm volatile("v_cvt_pk_bf16_f32 %0, %1, %2" : "=v"(r) : "v"(lo), "v"(hi)); return r; }
__device__ __forceinline__ void p0_transpose_item(const float* W, int K, int N, bf16* WT, LAS float* scr, int item, int lane) {
    const int nblk = N / 64, kb = item / nblk, nb = item - kb * nblk, k0 = 64 * kb, n0 = 64 * nb;
    const int lr = lane >> 4, lc = (lane & 15) * 4;
    const GAS f32x4* src = (const GAS f32x4*)(W + (size_t)(k0 + lr) * N + n0 + lc);
    f32x4 v[16];
#pragma unroll
    for (int i = 0; i < 16; ++i) v[i] = src[(size_t)i * N];
#pragma unroll
    for (int i = 0; i < 16; ++i) { const int k = lr + 4 * i; *(LAS f32x4*)(scr + k * 68 + (lc ^ ((k >> 3) << 2))) = v[i]; }
    LDS_WAIT(); asm volatile("" ::: "memory");
    const int kc = lane & 7, nl = lane >> 3;
#pragma unroll
    for (int j = 0; j < 8; ++j) { const int n = nl + 8 * j; const LAS float* s = scr + (8 * kc) * 68 + (n ^ (kc << 2));
        v4u o; o.x = cvtpk_rne(s[0 * 68], s[1 * 68]); o.y = cvtpk_rne(s[2 * 68], s[3 * 68]); o.z = cvtpk_rne(s[4 * 68], s[5 * 68]); o.w = cvtpk_rne(s[6 * 68], s[7 * 68]);
        *(GAS v4u*)(WT + (size_t)(n0 + n) * K + k0 + 8 * kc) = o; }
    LDS_WAIT(); asm volatile("" ::: "memory");
}
__device__ __forceinline__ void mod_block_item(const Args& a, LAS unsigned char* ldsl, int cc, int kq8, int tid, int lane, int wave) {
    const float* cmat = a.in[6]; const float* cctx = a.in[7]; const float* Wm = a.in[8]; float* part = (float*)(a.ws + WS_MODP);
    f32x4 acc[9];
#pragma unroll
    for (int r = 0; r < 9; ++r) acc[r] = (f32x4){0.f, 0.f, 0.f, 0.f};
    const int krow = kq8 * 512 + wave * 64;
    const GAS f32x4* wp = (const GAS f32x4*)(Wm + (size_t)krow * NMOD + cc * 256) + lane;
    float sv[9];
#pragma unroll
    for (int r = 0; r < 9; ++r) { const float cv = (r < 8) ? cmat[r * DM + krow + lane] : cctx[krow + lane]; sv[r] = cv / (1.f + __expf(-cv)); }
    for (int i0 = 0; i0 < 64; i0 += 16) {
        f32x4 w[16];
#pragma unroll
        for (int i = 0; i < 16; ++i) w[i] = wp[(size_t)(i0 + i) * (NMOD / 4)];
#pragma unroll
        for (int i = 0; i < 16; ++i)
#pragma unroll
            for (int r = 0; r < 9; ++r) { const float s = __uint_as_float(__builtin_amdgcn_readlane(__float_as_uint(sv[r]), i0 + i)); acc[r] += w[i] * s; }
    }
    LAS f32x4* red = (LAS f32x4*)ldsl;
    __syncthreads();
#pragma unroll
    for (int r = 0; r < 9; ++r) red[(wave * 9 + r) * 64 + lane] = acc[r];
    __syncthreads();
    for (int o = tid; o < 9 * 64; o += NWAVES * 64) { const int r = o >> 6, l = o & 63; f32x4 s = red[r * 64 + l];
#pragma unroll
        for (int w2 = 1; w2 < NWAVES; ++w2) s += red[(w2 * 9 + r) * 64 + l];
        *((GAS f32x4*)(part + (size_t)(kq8 * 9 + r) * NMOD + cc * 256) + l) = s; }
    __syncthreads();
}
constexpr int BG_MOD = 64 * KSPLIT, BG_TR = ((DM / 64) * (DM / 64) + (DM / 64) * (DFF / 64) + (DFF / 64) * (DM / 64)) / 8, N_BG = BG_MOD + BG_TR;
#ifndef BG_Q2
#define BG_Q2 512
#endif
__device__ __forceinline__ void bg_items(const Args& a, LAS unsigned char* ldsl, int lo, int hi, int start, int stride, int tid, int lane, int wave) {
    constexpr int I_OUT = (DM / 64) * (DM / 64), I_FC1 = (DM / 64) * (DFF / 64);
    LAS float* scr = (LAS float*)(ldsl + wave * TR_LDS);
    for (int bi = lo + start; bi < hi; bi += stride) {
        if (bi < BG_MOD) { mod_block_item(a, ldsl, 32 + (bi & 63), bi >> 6, tid, lane, wave); continue; }
        int r = (bi - BG_MOD) * 8 + wave;
        if (r < I_OUT) { p0_transpose_item(a.in[22], DM, DM, (bf16*)(a.ws + WS_WOUT), scr, r, lane); continue; } r -= I_OUT;
        if (r < I_FC1) { p0_transpose_item(a.in[24], DM, DFF, (bf16*)(a.ws + WS_WFC1), scr, r, lane); continue; } r -= I_FC1;
        p0_transpose_item(a.in[25], DFF, DM, (bf16*)(a.ws + WS_WFC2), scr, r, lane);
    }
}

template <int WHICH>
__device__ __forceinline__ void norm_phase(const Args& a, LAS unsigned char* lds, int vcu, int G, int wave) {
    const int tid = fresh_tid(), lane = tid & 63;
    LAS float* Gv = (LAS float*)lds; LAS float* Sv = Gv + DM;
    const float* bmod = a.in[9]; const float* part = (const float*)(a.ws + WS_MODP); float* modf = (float*)(a.ws + WS_MODF);
    const float* gn = WHICH == 0 ? a.in[10] : a.in[23];
    bf16* H = (bf16*)(a.ws + WS_H);
    const int rows_per = (MTOK + G - 1) / G; int m = vcu * rows_per; const int mend = (m + rows_per < MTOK) ? m + rows_per : MTOK;
    while (m < mend) {
        const int r = (m < M_P) ? 8 : (m - M_P) / T_S;
        const int bnd = (m < M_P) ? M_P : M_P + (r + 1) * T_S; const int send = bnd < mend ? bnd : mend;
        __syncthreads();
        for (int c4 = tid; c4 < DM / 4; c4 += NWAVES * 64) {
            const int c = 4 * c4; f32x4 sh, sc;
            if (WHICH == 0) { sh = *(const GAS f32x4*)(bmod + c); sc = *(const GAS f32x4*)(bmod + DM + c);
                f32x4 ph[KSPLIT], pc[KSPLIT];
#pragma unroll
                for (int p = 0; p < KSPLIT; ++p) { ph[p] = *(const GAS f32x4*)(part + ((size_t)p * 9 + r) * NMOD + c); pc[p] = *(const GAS f32x4*)(part + ((size_t)p * 9 + r) * NMOD + DM + c); }
#pragma unroll
                for (int p = 0; p < KSPLIT; ++p) { sh += ph[p]; sc += pc[p]; } }
            else { sh = *(const GAS f32x4*)(modf + (size_t)r * NMOD + 3 * DM + c); sc = *(const GAS f32x4*)(modf + (size_t)r * NMOD + 4 * DM + c); }
            const f32x4 gg = *(const GAS f32x4*)(gn + c);
            *(LAS f32x4*)(Gv + c) = gg * (sc + 1.f); *(LAS f32x4*)(Sv + c) = sh; }
        __syncthreads();
        for (int mm = m + wave; mm < send; mm += NWAVES) {
            if (WHICH == 0) {
                const float* xrow = (mm < M_P) ? a.in[0] + (size_t)mm * DM : a.in[1] + (size_t)(mm - M_P) * DM;
                const GAS f32x4* xr = (const GAS f32x4*)xrow + 2 * lane;
                f32x4 v[16]; float s = 0.f;
#pragma unroll
                for (int j = 0; j < 8; ++j) { v[2 * j] = xr[128 * j]; v[2 * j + 1] = xr[128 * j + 1]; }
#pragma unroll
                for (int j = 0; j < 16; ++j) s += (v[j].x * v[j].x + v[j].y * v[j].y) + (v[j].z * v[j].z + v[j].w * v[j].w);
                const float rstd = __builtin_amdgcn_rsqf(wave_sum(s) * (1.f / DM) + EPS);
                GAS v4u* o16 = (GAS v4u*)(H + (size_t)mm * DM) + lane;
#pragma unroll
                for (int j = 0; j < 8; ++j) { const int c0 = 8 * (lane + 64 * j);
                    const f32x4 g0 = *(const LAS f32x4*)(Gv + c0), g1 = *(const LAS f32x4*)(Gv + c0 + 4), s0 = *(const LAS f32x4*)(Sv + c0), s1 = *(const LAS f32x4*)(Sv + c0 + 4);
                    const f32x4 y0 = v[2 * j] * rstd * g0 + s0, y1 = v[2 * j + 1] * rstd * g1 + s1;
                    v4u o; o.x = pk2(y0.x, y0.y); o.y = pk2(y0.z, y0.w); o.z = pk2(y1.x, y1.y); o.w = pk2(y1.z, y1.w);
                    o16[64 * j] = o; }
            } else {
                const GAS v4u* xr = (const GAS v4u*)((const bf16*)(a.ws + WS_X1B) + (size_t)mm * DM) + lane;
                v4u v[8]; float s = 0.f;
#pragma unroll
                for (int j = 0; j < 8; ++j) { v[j] = xr[64 * j];
#pragma unroll
                    for (int e = 0; e < 4; ++e) { const float lo = __uint_as_float(v[j][e] << 16), hi = __uint_as_float(v[j][e] & 0xffff0000u); s += lo * lo + hi * hi; } }
                const float rstd = __builtin_amdgcn_rsqf(wave_sum(s) * (1.f / DM) + EPS);
                GAS v4u* o16 = (GAS v4u*)(H + (size_t)mm * DM) + lane;
#pragma unroll
                for (int j = 0; j < 8; ++j) { const int c0 = 8 * (lane + 64 * j); v4u o;
                    const f32x4 g0 = *(const LAS f32x4*)(Gv + c0), g1 = *(const LAS f32x4*)(Gv + c0 + 4), s0 = *(const LAS f32x4*)(Sv + c0), s1 = *(const LAS f32x4*)(Sv + c0 + 4);
                    const float x0 = __uint_as_float(v[j].x << 16), x1 = __uint_as_float(v[j].x & 0xffff0000u), x2 = __uint_as_float(v[j].y << 16), x3 = __uint_as_float(v[j].y & 0xffff0000u);
                    const float x4 = __uint_as_float(v[j].z << 16), x5 = __uint_as_float(v[j].z & 0xffff0000u), x6 = __uint_as_float(v[j].w << 16), x7 = __uint_as_float(v[j].w & 0xffff0000u);
                    o.x = pk2(x0 * rstd * g0.x + s0.x, x1 * rstd * g0.y + s0.y); o.y = pk2(x2 * rstd * g0.z + s0.z, x3 * rstd * g0.w + s0.w);
                    o.z = pk2(x4 * rstd * g1.x + s1.x, x5 * rstd * g1.y + s1.y); o.w = pk2(x6 * rstd * g1.z + s1.z, x7 * rstd * g1.w + s1.w);
                    o16[64 * j] = o; }
            }
        }
        m = send;
    }
    __syncthreads();
}

__device__ __forceinline__ void qk_item(const Args& a, const v4u raw, int it, int lane, bf16* P, float* onew, const LAS float* c128, const LAS float* s128, const LAS float* c64, const LAS float* s64) {
    const int sub = lane & 15, sg = lane >> 4;
    const int m = it >> 2, gi = it & 3, grp = (gi == 0) ? 4 : (gi == 1) ? 5 : (gi == 2) ? 10 : 11; bf16* src = P + (size_t)m * DIN + grp * 512 + lane * 8;
        float x[8];
        x[0] = __uint_as_float(raw.x << 16); x[1] = __uint_as_float(raw.x & 0xffff0000u); x[2] = __uint_as_float(raw.y << 16); x[3] = __uint_as_float(raw.y & 0xffff0000u);
        x[4] = __uint_as_float(raw.z << 16); x[5] = __uint_as_float(raw.z & 0xffff0000u); x[6] = __uint_as_float(raw.w << 16); x[7] = __uint_as_float(raw.w & 0xffff0000u);
        const bool lat = m >= M_P; const int t = lat ? (m - M_P) % T_S : m % T_P; const int b = lat ? (m - M_P) / T_S : m / T_P;
        const bool is_v = (grp == 5 || grp == 11);
        const bool is_a = grp < 6;
        if (!is_v) {
            float ss = 0.f;
#pragma unroll
            for (int e = 0; e < 8; ++e) ss += x[e] * x[e];
            ss += __shfl_xor(ss, 1); ss += __shfl_xor(ss, 2); ss += __shfl_xor(ss, 4);
            if (is_a) ss += __shfl_xor(ss, 8);
            const float rstd = __builtin_amdgcn_rsqf(ss * (is_a ? (1.f / 128.f) : (1.f / 64.f)) + EPS);
            const float* gp = (grp < 4) ? a.in[12] : (grp == 4) ? a.in[13] : (grp < 10) ? a.in[14] : a.in[15];
            const int goff = is_a ? sub * 8 : (sub & 7) * 8;
            const f32x4 g0 = *(const GAS f32x4*)(gp + goff), g1 = *(const GAS f32x4*)(gp + goff + 4);
            x[0] *= rstd * g0.x; x[1] *= rstd * g0.y; x[2] *= rstd * g0.z; x[3] *= rstd * g0.w; x[4] *= rstd * g1.x; x[5] *= rstd * g1.y; x[6] *= rstd * g1.z; x[7] *= rstd * g1.w;
            if (lat) {
                float px[8];
                if (is_a) {
#pragma unroll
                    for (int e = 0; e < 8; ++e) px[e] = __shfl_xor(x[e], 4);
                    const int axis = (sub >> 3) & 1, half = (sub >> 2) & 1, i0 = (sub & 3) * 8, pos = axis ? (t & 63) : (t >> 6);
#pragma unroll
                    for (int e = 0; e < 8; ++e) { const float cs = c128[pos * 32 + i0 + e], sn = s128[pos * 32 + i0 + e]; x[e] = half ? (x[e] * cs + px[e] * sn) : (x[e] * cs - px[e] * sn); }
                } else {
#pragma unroll
                    for (int e = 0; e < 8; ++e) px[e] = __shfl_xor(x[e], 2);
                    const int s8 = sub & 7, axis = (s8 >> 2) & 1, half = (s8 >> 1) & 1, i0 = (s8 & 1) * 8, pos = axis ? (t & 63) : (t >> 6);
#pragma unroll
                    for (int e = 0; e < 8; ++e) { const float cs = c64[pos * 16 + i0 + e], sn = s64[pos * 16 + i0 + e]; x[e] = half ? (x[e] * cs + px[e] * sn) : (x[e] * cs - px[e] * sn); }
                }
            }
        }
        v4u ob; ob.x = pk2(x[0], x[1]); ob.y = pk2(x[2], x[3]); ob.z = pk2(x[4], x[5]); ob.w = pk2(x[6], x[7]);
        const bool is_q = (grp < 4) || (grp >= 6 && grp < 10);
        if (is_q) { *(GAS v4u*)src = ob; }
        else {
            const int which = (grp == 4) ? 0 : (grp == 5) ? 1 : (grp == 10) ? 2 : 3;
            const int kv = sg;
            if (lat) { *(GAS v4u*)((bf16*)(a.ws + WS_KVL + (size_t)which * KVL_SZ) + ((size_t)(b * 4 + kv) * KVL + LCTX + t) * 128 + sub * 8) = ob; }
            else { *(GAS v4u*)((bf16*)(a.ws + WS_KVP + (size_t)which * KVP_SZ) + ((size_t)(b * 4 + kv) * T_P + t) * 128 + sub * 8) = ob;
                GAS f32x4* of = (GAS f32x4*)(onew + (size_t)which * M_P * 512 + (size_t)m * 512 + kv * 128 + sub * 8);
                of[0] = (f32x4){x[0], x[1], x[2], x[3]}; of[1] = (f32x4){x[4], x[5], x[6], x[7]}; }
        }

}
__device__ __forceinline__ void qk_phase(const Args& a, LAS unsigned char* lds, int vcu, int G, int wave) {
    const int tid = fresh_tid(), lane = tid & 63;
    LAS float* c128 = (LAS float*)lds; LAS float* s128 = c128 + 2048; LAS float* c64 = s128 + 2048; LAS float* s64 = c64 + 1024;
    for (int e = tid; e < 2048; e += NWAVES * 64) { const int pos = e >> 5, i = e & 31; const float f = exp2f(-(float)i * (13.287712379549449f / 32.f)); float sn, cs; sincosf((float)pos * f, &sn, &cs); c128[e] = cs; s128[e] = sn; }
    for (int e = tid; e < 1024; e += NWAVES * 64) { const int pos = e >> 4, i = e & 15; const float f = exp2f(-(float)i * (13.287712379549449f / 16.f)); float sn, cs; sincosf((float)pos * f, &sn, &cs); c64[e] = cs; s64[e] = sn; }
    __syncthreads();
    bf16* P = (bf16*)(a.ws + WS_P);
    float* onew = a.out + (size_t)MTOK * DM;
    const int gw = vcu * NWAVES + wave, NGW = G * NWAVES;
#define QK_GRP(gi_) ((gi_) == 0 ? 4 : (gi_) == 1 ? 5 : (gi_) == 2 ? 10 : 11)
#define QK_SRC(it_) (P + (size_t)((it_) >> 2) * DIN + QK_GRP((it_) & 3) * 512 + lane * 8)
    for (int it = gw; it < MTOK * 4; it += 4 * NGW) {
        const int it1 = it + NGW, it2 = it + 2 * NGW, it3 = it + 3 * NGW;
        v4u r0, r1 = {0u, 0u, 0u, 0u}, r2 = {0u, 0u, 0u, 0u}, r3 = {0u, 0u, 0u, 0u};
        r0 = *(const GAS v4u*)QK_SRC(it);
        if (it1 < MTOK * 4) r1 = *(const GAS v4u*)QK_SRC(it1);
        if (it2 < MTOK * 4) r2 = *(const GAS v4u*)QK_SRC(it2);
        if (it3 < MTOK * 4) r3 = *(const GAS v4u*)QK_SRC(it3);
        qk_item(a, r0, it, lane, P, onew, c128, s128, c64, s64);
        if (it1 < MTOK * 4) qk_item(a, r1, it1, lane, P, onew, c128, s128, c64, s64);
        if (it2 < MTOK * 4) qk_item(a, r2, it2, lane, P, onew, c128, s128, c64, s64);
        if (it3 < MTOK * 4) qk_item(a, r3, it3, lane, P, onew, c128, s128, c64, s64);
    }
#undef QK_SRC
#undef QK_GRP
    __syncthreads();
}

#ifndef ST_CLS
#define ST_CLS 0
#endif
__device__ __forceinline__ void attn_phase(const Args& a, unsigned char* lds_g, int G, int wave, int vcu = 0, bool with_copies = false) {
    const int lane = fresh_tid() & 63;
    const bf16* P = (const bf16*)(a.ws + WS_P); bf16* O = (bf16*)(a.ws + WS_O);
    const bf16* KA_l = (const bf16*)(a.ws + WS_KVL); const bf16* VA_l = (const bf16*)(a.ws + WS_KVL + KVL_SZ); const bf16* KB_l = (const bf16*)(a.ws + WS_KVL + 2 * KVL_SZ); const bf16* VB_l = (const bf16*)(a.ws + WS_KVL + 3 * KVL_SZ);
    const bf16* KA_p = (const bf16*)(a.ws + WS_KVP); const bf16* VA_p = (const bf16*)(a.ws + WS_KVP + KVP_SZ); const bf16* KB_p = (const bf16*)(a.ws + WS_KVP + 2 * KVP_SZ); const bf16* VB_p = (const bf16*)(a.ws + WS_KVP + 3 * KVP_SZ);
    float* misc = (float*)(lds_g + att::LDS_MISC);
    if (wave == 0) { const float p1 = a.in[17][lane] * a.in[18][lane], p2 = a.in[19][lane] * a.in[20][lane];
        const float s1 = wave_sum(p1), s2 = wave_sum(p2); if (lane == 0) misc[0] = __expf(s1) - __expf(s2) + 0.2f; }
    __syncthreads();
    const float lam = misc[0];
    const int nper = G / 8;
    const int c = blockIdx.x, x = c % 8, j = c / 8;
    att::UnitArgs U;
#ifndef ATT_NO_MODE1
    for (int u = c; u < NB_S * 16 * 8 + NB_P * 16 * 2; u += G) {
        const bool lat = u < NB_S * 16 * 8; const int uu = lat ? u : u - NB_S * 16 * 8; const int i = uu / G;
#if ST_CLS > 0
        if (with_copies && lat && i == ((c / 8) % ST_CLS) * (4 / ST_CLS)) { const int t2 = fresh_tid();
            __syncthreads(); bg_items(a, (LAS unsigned char*)lds_g, BG_MOD, N_BG, vcu, G, t2, t2 & 63, wave); __syncthreads(); }
#endif
        int gid, g, qb;
        if (lat) { if (G == 256) { gid = i * 8 + x; g = j >> 3; qb = j & 7; } else { gid = uu >> 5; g = (uu >> 3) & 3; qb = uu & 7; } }
        else     { if (G == 256) { gid = (i * 8 + x) * 4 + (j >> 3); g = (j >> 1) & 3; qb = j & 1; } else { gid = uu >> 3; g = (uu >> 1) & 3; qb = uu & 1; } }
        const int b = gid >> 2, kv = gid & 3, h = kv * 4 + g; const int m0 = lat ? M_P + b * T_S + qb * 128 : b * T_P + qb * 128;
        const size_t kvoff = lat ? (size_t)(b * 4 + kv) * KVL * 128 : (size_t)(b * 4 + kv) * T_P * 128;
        U.Qb = P + (size_t)m0 * DIN + 3072 + h * 128; U.ldq = DIN; U.Kh = (lat ? KB_l : KB_p) + kvoff; U.Vh = (lat ? VB_l : VB_p) + kvoff;
        U.Ob = O + (size_t)m0 * DM + 2048 + h * 128; U.ldo = DM; U.NT = lat ? KVL / 64 : T_P / 64; U.jwin = 1 << 30; U.wadd = 0; U.masked = 0; U.t0 = 0; U.sinkl2 = 0.f; U.lam = lam; U.subg = a.in[21]; U.qg = a.in[14]; U.ropeT = (const float*)(a.ws + WS_ROPE); U.rope = lat ? 1 : 0; U.t0 = lat ? qb * 128 : 0;
        att::attn_unit<1>(U, (char*)lds_g);
    }
#endif
#ifndef ATT_NO_MODE0
    for (int u = c; u < NB_S * 16 * 4 + NB_P * 16; u += G) {
        const bool lat = u < NB_S * 16 * 4; const int uu = lat ? u : u - NB_S * 16 * 4; const int i = uu / G;
        int gid, g, qb2;
        if (lat) { if (G == 256) { gid = (i * 8 + x) * 2 + (j >> 4); g = (j >> 2) & 3; qb2 = (j & 3) ^ (i & 1); } else { gid = uu >> 4; g = (uu >> 2) & 3; qb2 = uu & 3; } }
        else     { if (G == 256) { gid = x * 8 + (j >> 2); g = j & 3; qb2 = 0; } else { gid = uu >> 2; g = uu & 3; qb2 = 0; } }
        const int b = gid >> 2, kv = gid & 3, h = kv * 4 + g; const int t0 = qb2 * 256, m0 = lat ? M_P + b * T_S + t0 : b * T_P;
        const int wstart = (t0 - 128 > 0) ? t0 - 128 : 0, wend = (t0 + 384 < T_S) ? t0 + 384 : T_S;
        const size_t kvoff = lat ? (size_t)(b * 4 + kv) * KVL * 128 : (size_t)(b * 4 + kv) * T_P * 128;
        U.Qb = P + (size_t)m0 * DIN + h * 128; U.ldq = DIN; U.Kh = (lat ? KA_l : KA_p) + kvoff; U.Vh = (lat ? VA_l : VA_p) + kvoff;
        U.Ob = O + (size_t)m0 * DM + h * 128; U.ldo = DM; U.NT = lat ? 8 + (wend - wstart) / 64 : T_P / 64; U.jwin = lat ? 8 : (1 << 30); U.wadd = lat ? wstart : 0; U.masked = lat ? 1 : 0; U.t0 = t0;
        U.sinkl2 = a.in[16][h] * att::LOG2E; U.lam = 0.f; U.subg = nullptr; U.qg = a.in[12]; U.ropeT = (const float*)(a.ws + WS_ROPE); U.rope = lat ? 1 : 0;
        att::attn_unit<0>(U, (char*)lds_g);
    }
#endif
    __syncthreads();
}


__device__ __forceinline__ void p0_phase(const Args& args, LAS unsigned char* ldsl, int vcu, int G, int wave) {
    const int tid = fresh_tid(), lane = tid & 63;
    for (int it = vcu; it < 32 * KSPLIT; it += G) mod_block_item(args, ldsl, it & 31, it >> 5, tid, lane, wave);
}
__device__ __forceinline__ void p1_extras(const Args& args, LAS unsigned char* ldsl, int vcu, int G, int wave) {
    const int lane = fresh_tid() & 63;
    LAS float* scr = (LAS float*)(ldsl + wave * TR_LDS);
    constexpr int I_IN = (DM / 64) * (DIN / 64);
    if (vcu == 0) { float* rt = (float*)(args.ws + WS_ROPE); const int tid = wave * 64 + lane;
        for (int e = tid; e < 2048; e += NWAVES * 64) { const int pos = e >> 5, i = e & 31; const float fq_ = exp2f(-(float)i * (13.287712379549449f / 32.f)); float sn, cs; sincosf((float)pos * fq_, &sn, &cs); rt[e] = cs; rt[2048 + e] = sn; }
        for (int e = tid; e < 1024; e += NWAVES * 64) { const int pos = e >> 4, i = e & 15; const float fq_ = exp2f(-(float)i * (13.287712379549449f / 16.f)); float sn, cs; sincosf((float)pos * fq_, &sn, &cs); rt[4096 + e] = cs; rt[5120 + e] = sn; } }
    for (int r = vcu * NWAVES + wave; r < I_IN; r += G * NWAVES) p0_transpose_item(args.in[11], DM, DIN, (bf16*)(args.ws + WS_WIN), scr, r, lane);
    for (int it = vcu * NWAVES + wave; it < 4 * 4096; it += G * NWAVES) {
        const int tsr = it >> 12, w = it & 4095; const size_t e = ((size_t)w * 64 + lane) * 8;
        const float* src = args.in[2 + tsr] + e; const f32x4 v0 = *(const GAS f32x4*)src, v1 = *(const GAS f32x4*)(src + 4);
        const int d = (int)(e & 127), kv = (int)((e >> 7) & 3), key = (int)((e >> 9) & 511), b = (int)(e >> 18);
        v4u o; o.x = pk2(v0.x, v0.y); o.y = pk2(v0.z, v0.w); o.z = pk2(v1.x, v1.y); o.w = pk2(v1.z, v1.w);
        *(GAS v4u*)((bf16*)(args.ws + WS_KVL + tsr * KVL_SZ) + ((size_t)(b * 4 + kv) * KVL + key) * 128 + d) = o; }
}
__device__ __forceinline__ void p3_extras(const Args& args, LAS unsigned char* ldsl, int vcu, int G, int q2, int hi, int wave) {
    const int tid = fresh_tid(), lane = tid & 63;
    bg_items(args, ldsl, q2, hi, vcu, G, tid, lane, wave);
    __syncthreads();
}
__device__ __forceinline__ void modf_rest(const Args& args, int vcu, int G) {
    const int tid = fresh_tid();
    const float* bmod = args.in[9]; const float* part = (const float*)(args.ws + WS_MODP); float* modf = (float*)(args.ws + WS_MODF);
    for (int e = vcu * (NWAVES * 64) + tid; e < 9 * 4 * DM; e += G * NWAVES * 64) { const int r = e / (4 * DM), n = 2 * DM + e % (4 * DM);
        float s = bmod[n];
#pragma unroll
        for (int p = 0; p < KSPLIT; ++p) s += part[((size_t)p * 9 + r) * NMOD + n];
        modf[(size_t)r * NMOD + n] = s; }
}
#ifndef ORDER_P5
#define ORDER_P5 GEMM_ORDER
#endif
#ifndef ORDER_P7
#define ORDER_P7 GEMM_ORDER
#endif
#ifndef ORDER_P8
#define ORDER_P8 GEMM_ORDER
#endif
#ifndef GEMM_ORDER
#define GEMM_ORDER pg8::BlockOrder
#endif
#ifndef GEMM_ALIGN
#define GEMM_ALIGN true
#endif
#ifndef GEMM_SP2
#define GEMM_SP2 true
#endif
#ifndef U_TILED
#define U_TILED true
#endif
#ifndef U_NT
#define U_NT true
#endif
constexpr int P2_G = 232;
__device__ __forceinline__ void p2_phase(const Args& args, LAS unsigned char* ldsl, int G, int bx, int wave) {
    const bool split = (G == 256);
    if (!split || bx < P2_G) {
        pg8::Gemm g{(const pg8::bf16_t*)(args.ws + WS_H), (const pg8::bf16_t*)(args.ws + WS_WIN), MTOK, DIN, DM, 0}; pg8::StaticOrder S; S.init(MTOK, DIN, split ? P2_G : G, bx);
        pg8::EpiBf16<0> E{(pg8::bf16_t*)(args.ws + WS_P), DIN};
        pg8::gemm_phase<pg8::EpiBf16<0>, pg8::StaticOrder, GEMM_ALIGN, GEMM_SP2>(ldsl, g, S, E);
    } else {
        const int tid = fresh_tid(), lane = tid & 63;
        bg_items(args, ldsl, 0, BG_Q2, bx - P2_G, G - P2_G, tid, lane, wave);
    }
}
__device__ __forceinline__ void p5_phase(const Args& args, LAS unsigned char* ldsl, int G, int bx) {
    pg8::Gemm g{(const pg8::bf16_t*)(args.ws + WS_O), (const pg8::bf16_t*)(args.ws + WS_WOUT), MTOK, DM, DM, 0}; ORDER_P5 S; S.init(MTOK, DM, G, bx);
    const float* modf = (const float*)(args.ws + WS_MODF);
    pg8::EpiResidB E{args.in[0], args.in[1], (pg8::bf16_t*)(args.ws + WS_X1B), DM, M_P / 256, modf + 2 * DM, NMOD, modf + (size_t)8 * NMOD + 2 * DM};
    pg8::gemm_phase<pg8::EpiResidB, ORDER_P5, GEMM_ALIGN, GEMM_SP2>(ldsl, g, S, E);
}
__device__ __forceinline__ void p7_phase(const Args& args, LAS unsigned char* ldsl, int G, int bx) {
    pg8::Gemm g{(const pg8::bf16_t*)(args.ws + WS_H), (const pg8::bf16_t*)(args.ws + WS_WFC1), MTOK, DFF, DM, 0}; ORDER_P7 S; S.init(MTOK, DFF, G, bx);
    pg8::EpiBf16<1, U_NT, U_TILED> E{(pg8::bf16_t*)(args.ws + WS_U), DFF};
    pg8::gemm_phase<pg8::EpiBf16<1, U_NT, U_TILED>, ORDER_P7, GEMM_ALIGN, GEMM_SP2>(ldsl, g, S, E);
}
__device__ __forceinline__ void p7_null_phase(const Args& args, LAS unsigned char* ldsl, int G, int bx) {
    pg8::Gemm g{(const pg8::bf16_t*)(args.ws + WS_H), (const pg8::bf16_t*)(args.ws + WS_WFC1), MTOK, DFF, DM, 0}; pg8::StaticOrder S; S.init(MTOK, DFF, G, bx);
    pg8::EpiNull E{};
    pg8::gemm_phase<pg8::EpiNull, pg8::StaticOrder, GEMM_ALIGN, GEMM_SP2>(ldsl, g, S, E);
}
__device__ __forceinline__ void p8_null_phase(const Args& args, LAS unsigned char* ldsl, int G, int bx) {
    pg8::Gemm g{(const pg8::bf16_t*)(args.ws + WS_U), (const pg8::bf16_t*)(args.ws + WS_WFC2), MTOK, DM, DFF, U_TILED ? 1 : 0}; pg8::StaticOrder S; S.init(MTOK, DM, G, bx);
    pg8::EpiNull E{};
    pg8::gemm_phase<pg8::EpiNull, pg8::StaticOrder, GEMM_ALIGN, GEMM_SP2>(ldsl, g, S, E);
}
__device__ __forceinline__ void p8_phase(const Args& args, LAS unsigned char* ldsl, int G, int bx) {
    pg8::Gemm g{(const pg8::bf16_t*)(args.ws + WS_U), (const pg8::bf16_t*)(args.ws + WS_WFC2), MTOK, DM, DFF, U_TILED ? 1 : 0}; ORDER_P8 S; S.init(MTOK, DM, G, bx);
    const float* modf = (const float*)(args.ws + WS_MODF);
    pg8::EpiResid E{(const pg8::bf16_t*)(args.ws + WS_X1B), args.out, DM, M_P / 256, modf + 5 * DM, NMOD, modf + (size_t)8 * NMOD + 5 * DM};
    pg8::gemm_phase<pg8::EpiResid, ORDER_P8, GEMM_ALIGN, GEMM_SP2>(ldsl, g, S, E);
}

__global__ void __launch_bounds__(NWAVES * 64, 2) fwd_kernel(Args args) {
    extern __shared__ __attribute__((aligned(16))) unsigned char lds[];
    LAS unsigned char* ldsl = (LAS unsigned char*)lds;
    volatile LAS unsigned* MISC = (volatile LAS unsigned*)(ldsl + MISC_OFF);
    const int tid = threadIdx.x, wave = __builtin_amdgcn_readfirstlane(tid >> 6);
    const int G = gridDim.x; const int bx = blockIdx.x; const int vcu = (G % 8 == 0) ? (bx % 8) * (G / 8) + bx / 8 : bx;
    gu32* ctl = (gu32*)(args.ws + WS_CTL);
    for (int u = tid; u < (LDS_BYTES - MISC_OFF) / 4; u += NWAVES * 64) ((LAS unsigned*)(ldsl + MISC_OFF))[u] = 0u;
    __syncthreads();
    XcdBarrier bar; bar.bar = (unsigned*)(ctl + CW_BAR); bar.x = 0; bar.st = nullptr;
    if (N_LAUNCHES == 1) bar = xcd_barrier_post((unsigned*)(ctl + CW_BAR), MISC + 8);
    const int lo = args.ph_lo, hi = args.ph_hi;
#ifndef PHASE_MASK
#define PHASE_MASK 0x1ff
#endif
#define IN(k) ((((PHASE_MASK) >> (k)) & 1) && lo <= (k) && (k) < hi)
#define SEAM(k) do { if (IN(k) && IN((k) + 1)) xcd_barrier(bar); } while (0)

#ifndef PROBE_REPEAT
#define PROBE_REPEAT (-1)
#endif
#if defined(PROBE_TIME)
    unsigned long long pt0 = 0, pt1 = 0;
#define PT_STAMP(v) asm volatile("s_waitcnt vmcnt(0) lgkmcnt(0)\n\ts_memrealtime %0\n\ts_waitcnt lgkmcnt(0)" : "=s"(v) :: "memory")
#define PT_BEGIN(k) do { if (PROBE_TIME == (k)) PT_STAMP(pt0); } while (0)
#define PT_END(k) do { if (PROBE_TIME == (k)) PT_STAMP(pt1); } while (0)
#else
#define PT_BEGIN(k) do { } while (0)
#define PT_END(k) do { } while (0)
#endif
#define REP(k, call) do { if (PROBE_REPEAT == (k)) { call; xcd_barrier(bar); } } while (0)
    PT_BEGIN(0);
#if defined(PROBE_WRITE)
    {
        GAS v4u* wp = (GAS v4u*)(args.ws + WS_P); const size_t n16 = ((size_t)304 << 20) / 16; v4u acc = {0u, 0u, 0u, 0u};
        for (size_t i = (size_t)bx * (NWAVES * 64) + tid; i < n16; i += (size_t)G * NWAVES * 64) { if (PROBE_WRITE == 1) wp[i] = (v4u){1u, 2u, 3u, 4u}; else { const v4u t = wp[i]; acc.x ^= t.x; acc.y ^= t.y; acc.z ^= t.z; acc.w ^= t.w; } }
        if (PROBE_WRITE == 2) asm volatile("" :: "v"(acc));
        xcd_barrier(bar);
    }
#endif
    if (IN(0)) p0_phase(args, ldsl, vcu, G, wave);
    SEAM(0); PT_END(0);
    PT_BEGIN(1);
    if (IN(1)) { norm_phase<0>(args, ldsl, vcu, G, wave); p1_extras(args, ldsl, vcu, G, wave); }
    SEAM(1); PT_END(1);
    PT_BEGIN(2);
    if (IN(2)) p2_phase(args, ldsl, G, bx, wave);
    SEAM(2); PT_END(2);
    PT_BEGIN(3);
    const bool st_copies = (ST_CLS > 0) && (G == 256) && (BG_Q2 >= BG_MOD);
    if (IN(3)) { p3_extras(args, ldsl, vcu, G, (G == 256) ? BG_Q2 : 0, st_copies ? BG_MOD : N_BG, wave); qk_phase(args, ldsl, vcu, G, wave); }
    SEAM(3); PT_END(3);
    PT_BEGIN(4);
    if (IN(4)) { modf_rest(args, vcu, G); attn_phase(args, lds, G, wave, vcu, st_copies); }
    SEAM(4); PT_END(4); REP(4, attn_phase(args, lds, G, wave));
    PT_BEGIN(5);
    if (IN(5)) p5_phase(args, ldsl, G, bx);
    SEAM(5); PT_END(5); REP(5, p5_phase(args, ldsl, G, bx));
    PT_BEGIN(6);
    if (IN(6)) norm_phase<1>(args, ldsl, vcu, G, wave);
    SEAM(6); PT_END(6); REP(6, norm_phase<1>(args, ldsl, vcu, G, wave));
#if defined(PROBE_CLOCK)
    unsigned long long pc0 = 0, pr0 = 0, pc1 = 0, pr1 = 0;
    if (PROBE_CLOCK == 7) { pc0 = clock64(); pr0 = wall_clock64(); }
#endif
    PT_BEGIN(7);
    if (IN(7)) p7_phase(args, ldsl, G, bx);
#if defined(PROBE_CLOCK)
    if (PROBE_CLOCK == 7) { pc1 = clock64(); pr1 = wall_clock64(); }
#endif
    SEAM(7); PT_END(7); REP(7, p7_phase(args, ldsl, G, bx)); REP(17, p7_null_phase(args, ldsl, G, bx)); REP(18, p8_null_phase(args, ldsl, G, bx));
    PT_BEGIN(8);
    if (IN(8)) p8_phase(args, ldsl, G, bx);
#if defined(PROBE_XCC)
    {
        unsigned* xr = (unsigned*)(args.ws + WS_MODP);
        if (tid == 0) __hip_atomic_store(xr + bx, xb_xcc_id() + 1u, __ATOMIC_RELAXED, __HIP_MEMORY_SCOPE_AGENT);
        xcd_barrier(bar);
        if (bx == 0 && tid == 0) { unsigned bad = 0;
            for (int b = 8; b < G; ++b) bad += (__hip_atomic_load(xr + b, __ATOMIC_RELAXED, __HIP_MEMORY_SCOPE_AGENT) != __hip_atomic_load(xr + (b & 7), __ATOMIC_RELAXED, __HIP_MEMORY_SCOPE_AGENT)) ? 1u : 0u;
            const unsigned long long t0 = wall_clock64(); while (wall_clock64() - t0 < (unsigned long long)bad * 1000ull) __builtin_amdgcn_s_sleep(8); }
    }
#endif
#if defined(PROBE_TIME)
    PT_END(8);
    xcd_barrier(bar);
    if (bx == 0 && tid == 0) { const unsigned long long t0 = wall_clock64(); while (wall_clock64() - t0 < (pt1 - pt0)) __builtin_amdgcn_s_sleep(8); }
#endif
#if defined(PROBE_CLOCK)
    if (bx == 0 && tid == 0) {
        const unsigned long long ticks = (pc1 - pc0) * 1000ull / (pr1 - pr0);
        const unsigned long long t0 = wall_clock64(); while (wall_clock64() - t0 < ticks) __builtin_amdgcn_s_sleep(8);
    }
#endif
#undef REP
#undef IN
#undef SEAM
}

extern "C" void kernel_launch(void* const* d_in, const int* in_sizes, int n_in, void* d_out, int out_size, void* d_ws, size_t ws_size, hipStream_t stream) {
    static int grid = 0;
    if (grid == 0) {
        if (n_in != 26 || in_sizes[0] != M_P * DM || in_sizes[1] != M_S * DM || out_size != MTOK * DM + 4 * M_P * 512 || ws_size < WS_END) {
            fprintf(stderr, "kernel_launch: shape mismatch (n_in %d in0 %d in1 %d out %d ws %zu, need ws >= %zu); nothing launched\n", n_in, n_in > 0 ? in_sizes[0] : -1, n_in > 1 ? in_sizes[1] : -1, out_size, ws_size, (size_t)WS_END); grid = -1; return; }
        int dev = 0, cus = 0, per_cu = 0;
        if (hipGetDevice(&dev) != hipSuccess || hipDeviceGetAttribute(&cus, hipDeviceAttributeMultiprocessorCount, dev) != hipSuccess) { grid = -1; return; }
        if (hipFuncSetAttribute((const void*)fwd_kernel, hipFuncAttributeMaxDynamicSharedMemorySize, LDS_BYTES) != hipSuccess) { fprintf(stderr, "kernel_launch: hipFuncSetAttribute failed\n"); grid = -1; return; }
        if (hipOccupancyMaxActiveBlocksPerMultiprocessor(&per_cu, (const void*)fwd_kernel, NWAVES * 64, LDS_BYTES) != hipSuccess || per_cu < 1) { fprintf(stderr, "kernel_launch: occupancy query says %d blocks per CU\n", per_cu); }
        (void)hipGetLastError();
        grid = cus;
    }
    if (grid < 0) return;
    if (hipMemsetAsync((char*)d_ws + WS_CTL, 0, CTL_ZERO_BYTES, stream) != hipSuccess) return;
    Args a{};
    for (int i = 0; i < 26; ++i) a.in[i] = (const float*)d_in[i];
    a.out = (float*)d_out; a.ws = (unsigned char*)d_ws;
    if (N_LAUNCHES == 1) { a.ph_lo = 0; a.ph_hi = NPH; hipLaunchKernelGGL(fwd_kernel, dim3(grid), dim3(NWAVES * 64), LDS_BYTES, stream, a); }
    else { for (int p = 0; p < NPH; ++p) { a.ph_lo = p; a.ph_hi = p + 1; hipLaunchKernelGGL(fwd_kernel, dim3(grid), dim3(NWAVES * 64), LDS_BYTES, stream, a); } }
    const hipError_t le = hipPeekAtLastError();
    if (le != hipSuccess) fprintf(stderr, "kernel_launch: launch failed: %s\n", hipGetErrorName(le));
}
```
